# Optimizing an MI355X kernel written in HIP

```python
import math
import jax, jax.numpy as jnp
from jax import lax
import numpy as np

D_MODEL = 1024
BATCH = 8
SEQ = 4096
DEPTH = 1

CHUNK = 64
PLE_DIM = 256
EPS = 1e-6

RW_HEADS = 8
RW_HEAD_DIM = 64
RW_DIM = RW_HEADS * RW_HEAD_DIM
RW_LORA_W = 64
RW_LORA_A = 64
RW_LORA_G = 128
RW_GN_EPS = 64e-5

MLA_HEADS = 8
QK_NOPE = 64
QK_ROPE = 32
V_HEAD = 64
Q_LORA = 384
KV_LORA = 256
MLA_DIM = MLA_HEADS * V_HEAD
ROPE_THETA = 10000.0
Q_BLOCK = 128
NEG_INF = -1e30

PEER_HEADS = 8
N_KEYS = 128
N_EXPERTS = N_KEYS * N_KEYS
PEER_TOPK = 16
D_QUERY = 256
HALF_Q = D_QUERY // 2
PEER_TOKEN_BLOCK = 128

RW_COLS = 3 * RW_DIM + RW_LORA_W + RW_LORA_A + RW_LORA_G
MLA_COLS = Q_LORA + KV_LORA + QK_ROPE
GATE_COLS = 2 * D_MODEL
IN_COLS = RW_COLS + MLA_COLS + GATE_COLS

kernel_name = 'hybrid_rwkv7_mla_peer_block'


def rms_norm(x, gain, eps=EPS):
    xf = x.astype(jnp.float32)
    y = xf * lax.rsqrt(jnp.mean(xf * xf, axis=-1, keepdims=True) + eps)
    return (y * gain.astype(jnp.float32)).astype(x.dtype)


def rwkv7_scan(r, decay, k, v, a, b):
    def step(state, inp):
        r_t, w_t, k_t, v_t, a_t, b_t = inp
        sa = jnp.einsum('bhvk,bhk->bhv', state, a_t)
        state = (state * w_t[:, :, None, :] + sa[..., None] * b_t[:, :, None, :]
                 + v_t[..., None] * k_t[:, :, None, :])
        return state, jnp.einsum('bhvk,bhk->bhv', state, r_t)
    xs = tuple(jnp.moveaxis(t.astype(jnp.float32), 1, 0) for t in (r, decay, k, v, a, b))
    bsz, _, heads, n = r.shape
    s0 = jnp.zeros((bsz, heads, n, n), jnp.float32)
    _, ys = lax.scan(step, s0, xs)
    return jnp.moveaxis(ys, 0, 1)


def rwkv7_branch(z, mu, w0, w2, a0, a2, g2, k_k, k_a, r_k, gn_w, gn_b, w_o):
    bsz, seq = z.shape[:2]
    z_prev = jnp.pad(z, ((0, 0), (1, 0), (0, 0)))[:, :-1]
    z = z + mu * (z_prev - z)
    o1, o2, o3 = RW_DIM, 2 * RW_DIM, 3 * RW_DIM
    o4, o5 = o3 + RW_LORA_W, o3 + RW_LORA_W + RW_LORA_A
    r, k, v = z[..., :o1], z[..., o1:o2], z[..., o2:o3]
    zw, za, zg = z[..., o3:o4], z[..., o4:o5], z[..., o5:]
    w = -jax.nn.softplus(-(w0 + jnp.tanh(zw) @ w2)) - 0.5
    iclr = jax.nn.sigmoid(a0 + za @ a2)
    g = jax.nn.sigmoid(zg) @ g2
    hd = lambda t: t.reshape(bsz, seq, RW_HEADS, RW_HEAD_DIM)
    kk = hd(k * k_k).astype(jnp.float32)
    kk = kk / jnp.maximum(jnp.sqrt(jnp.sum(kk * kk, axis=-1, keepdims=True)), 1e-12)
    k = k * (1 + (iclr - 1) * k_a)
    decay = jnp.exp(-jnp.exp(w.astype(jnp.float32)))
    r_h, k_h, v_h, iclr_h = hd(r), hd(k), hd(v), hd(iclr).astype(jnp.float32)
    y = rwkv7_scan(r_h, hd(decay), k_h, v_h, -kk, kk * iclr_h)
    mean = jnp.mean(y, axis=-1, keepdims=True)
    var = jnp.mean(jnp.square(y - mean), axis=-1, keepdims=True)
    y = ((y - mean) * lax.rsqrt(var + RW_GN_EPS)).reshape(bsz, seq, RW_DIM) * gn_w + gn_b
    bonus = jnp.sum(r_h * k_h * r_k, axis=-1, keepdims=True) * v_h
    y = y + bonus.reshape(bsz, seq, RW_DIM)
    return (y * g).astype(z.dtype) @ w_o


def rope_tables(positions):
    inv_freq = ROPE_THETA ** (-jnp.arange(0, QK_ROPE, 2, dtype=jnp.float32) / QK_ROPE)
    ang = positions.astype(jnp.float32)[..., None] * inv_freq
    return jnp.cos(ang), jnp.sin(ang)


def apply_rope(x, cos, sin):
    half = x.shape[-1] // 2
    xf = x.astype(jnp.float32)
    x1, x2 = xf[..., :half], xf[..., half:]
    return jnp.concatenate([x1 * cos - x2 * sin, x2 * cos + x1 * sin], axis=-1).astype(x.dtype)


def chunk_causal_attention(q_nope, q_rope, k_nope, k_rope, v):
    bsz, seq, heads, _ = q_nope.shape
    n_blk = seq // Q_BLOCK
    scale = 1.0 / math.sqrt(QK_NOPE + QK_ROPE)
    key_chunk = jnp.arange(seq) // CHUNK

    def to_blocks(t):
        return jnp.moveaxis(t.reshape(bsz, n_blk, Q_BLOCK, *t.shape[2:]), 1, 0)

    def one_block(args):
        qn, qr, blk = args
        s = (jnp.einsum('bqhd,bkhd->bhqk', qn, k_nope)
             + jnp.einsum('bqhr,bkr->bhqk', qr, k_rope)).astype(jnp.float32) * scale
        q_chunk = (blk * Q_BLOCK + jnp.arange(Q_BLOCK)) // CHUNK
        mask = key_chunk[None, :] <= q_chunk[:, None]
        s = jnp.where(mask, s, NEG_INF)
        prob = jax.nn.softmax(s, axis=-1).astype(v.dtype)
        return jnp.einsum('bhqk,bkhd->bqhd', prob, v)

    out = lax.map(one_block, (to_blocks(q_nope), to_blocks(q_rope), jnp.arange(n_blk)))
    return jnp.moveaxis(out, 0, 1).reshape(bsz, seq, heads, V_HEAD)


def mla_branch(z, positions, q_norm, w_uq, kv_norm, w_ukv, w_o):
    bsz, seq = z.shape[:2]
    c_q = rms_norm(z[..., :Q_LORA], q_norm)
    c_kv = rms_norm(z[..., Q_LORA:Q_LORA + KV_LORA], kv_norm)
    k_rope = z[..., Q_LORA + KV_LORA:]
    q = (c_q @ w_uq).reshape(bsz, seq, MLA_HEADS, QK_NOPE + QK_ROPE)
    kv = (c_kv @ w_ukv).reshape(bsz, seq, MLA_HEADS, QK_NOPE + V_HEAD)
    q_nope, q_rope = q[..., :QK_NOPE], q[..., QK_NOPE:]
    k_nope, v = kv[..., :QK_NOPE], kv[..., QK_NOPE:]
    cos, sin = rope_tables(positions)
    q_rope = apply_rope(q_rope, cos[:, :, None, :], sin[:, :, None, :])
    k_rope = apply_rope(k_rope, cos, sin)
    o = chunk_causal_attention(q_nope, q_rope, k_nope, k_rope, v)
    return o.reshape(bsz, seq, MLA_DIM) @ w_o


def peer_ffn(h, w_q, sub_keys, u_tab, v_tab):
    bsz, seq, d = h.shape
    hb = h.reshape(bsz * seq // PEER_TOKEN_BLOCK, PEER_TOKEN_BLOCK, d)

    def one_block(xb):
        t = xb.shape[0]
        q = (xb @ w_q).reshape(t, PEER_HEADS, 2, HALF_Q)
        s = jnp.einsum('thcd,hcnd->thcn', q, sub_keys).astype(jnp.float32)
        top_s, top_i = lax.top_k(s, PEER_TOPK)
        cand_s = (top_s[:, :, 0, :, None] + top_s[:, :, 1, None, :]).reshape(t, PEER_HEADS, PEER_TOPK * PEER_TOPK)
        cand_i = (top_i[:, :, 0, :, None] * N_KEYS + top_i[:, :, 1, None, :]).reshape(t, PEER_HEADS, PEER_TOPK * PEER_TOPK)
        best_s, best_pos = lax.top_k(cand_s, PEER_TOPK)
        idx = jnp.take_along_axis(cand_i, best_pos, axis=-1)
        gate = jax.nn.softmax(best_s, axis=-1).astype(xb.dtype)
        act = jax.nn.gelu(jnp.einsum('td,thkd->thk', xb, u_tab[idx]), approximate=False)
        return jnp.einsum('thk,thkd->td', gate * act, v_tab[idx])

    return lax.map(one_block, hb).reshape(bsz, seq, d)


def setup_inputs(seed: int = 0) -> dict:
    key = jax.random.key(seed)
    ks = iter(jax.random.split(key, 40))
    nrm = lambda shape, scale: jax.random.normal(next(ks), shape, jnp.float32) * scale
    gain = lambda shape: 1.0 + nrm(shape, 0.02)
    L = DEPTH
    offset = jax.random.randint(next(ks), (BATCH, 1), 0, 10000, jnp.int32)
    return {
        'x': nrm((BATCH, SEQ, D_MODEL), 1.0),
        'p': nrm((DEPTH, BATCH, SEQ, PLE_DIM), 1.0),
        'positions': offset + jnp.arange(SEQ, dtype=jnp.int32)[None, :],
        'norm_mix': gain((L, D_MODEL)),
        'w_in': nrm((L, D_MODEL, IN_COLS), D_MODEL ** -0.5),
        'rw_mu': jax.random.uniform(next(ks), (L, RW_COLS), jnp.float32),
        'rw_w0': jax.random.uniform(next(ks), (L, RW_DIM), jnp.float32, -6.0, -1.0),
        'rw_w2': nrm((L, RW_LORA_W, RW_DIM), 0.1),
        'rw_a0': nrm((L, RW_DIM), 0.1),
        'rw_a2': nrm((L, RW_LORA_A, RW_DIM), RW_LORA_A ** -0.5),
        'rw_g2': nrm((L, RW_LORA_G, RW_DIM), RW_LORA_G ** -0.5),
        'rw_k_k': 0.85 + nrm((L, RW_DIM), 0.02),
        'rw_k_a': gain((L, RW_DIM)),
        'rw_r_k': nrm((L, RW_HEADS, RW_HEAD_DIM), 0.1),
        'rw_gn_w': gain((L, RW_DIM)),
        'rw_gn_b': nrm((L, RW_DIM), 0.01),
        'rw_w_o': nrm((L, RW_DIM, D_MODEL), RW_DIM ** -0.5),
        'mla_q_norm': gain((L, Q_LORA)),
        'mla_w_uq': nrm((L, Q_LORA, MLA_HEADS * (QK_NOPE + QK_ROPE)), Q_LORA ** -0.5),
        'mla_kv_norm': gain((L, KV_LORA)),
        'mla_w_ukv': nrm((L, KV_LORA, MLA_HEADS * (QK_NOPE + V_HEAD)), KV_LORA ** -0.5),
        'mla_w_o': nrm((L, MLA_DIM, D_MODEL), MLA_DIM ** -0.5),
        'w_out': nrm((L, D_MODEL, D_MODEL), D_MODEL ** -0.5),
        'norm_ffn': gain((L, D_MODEL)),
        'peer_w_q': nrm((L, D_MODEL, PEER_HEADS * D_QUERY), D_MODEL ** -0.5),
        'peer_sub_keys': nrm((L, PEER_HEADS, 2, N_KEYS, HALF_Q), HALF_Q ** -0.5),
        'peer_u': nrm((L, N_EXPERTS, D_MODEL), D_MODEL ** -0.5),
        'peer_v': nrm((L, N_EXPERTS, D_MODEL), D_MODEL ** -0.5),
        'norm_ple': gain((L, D_MODEL)),
        'ple_w_gate': nrm((L, D_MODEL, D_MODEL), D_MODEL ** -0.5),
        'ple_w_proj': nrm((L, PLE_DIM, D_MODEL), 0.5 * PLE_DIM ** -0.5),
        'norm_final': gain((D_MODEL,)),
    }


def reference(x, p, positions, norm_mix, w_in, rw_mu, rw_w0, rw_w2, rw_a0, rw_a2, rw_g2,
              rw_k_k, rw_k_a, rw_r_k, rw_gn_w, rw_gn_b, rw_w_o, mla_q_norm, mla_w_uq,
              mla_kv_norm, mla_w_ukv, mla_w_o, w_out, norm_ffn, peer_w_q, peer_sub_keys,
              peer_u, peer_v, norm_ple, ple_w_gate, ple_w_proj, norm_final):
    for i in range(DEPTH):
        h = rms_norm(x, norm_mix[i])
        z = h @ w_in[i]
        z_rw = z[..., :RW_COLS]
        z_mla = z[..., RW_COLS:RW_COLS + MLA_COLS]
        gates = jax.nn.sigmoid(z[..., RW_COLS + MLA_COLS:])
        gate_a, gate_b = gates[..., :D_MODEL], gates[..., D_MODEL:]
        y_a = rwkv7_branch(z_rw, rw_mu[i], rw_w0[i], rw_w2[i], rw_a0[i], rw_a2[i], rw_g2[i],
                           rw_k_k[i], rw_k_a[i], rw_r_k[i], rw_gn_w[i], rw_gn_b[i], rw_w_o[i])
        y_b = mla_branch(z_mla, positions, mla_q_norm[i], mla_w_uq[i], mla_kv_norm[i],
                         mla_w_ukv[i], mla_w_o[i])
        x = x + (gate_a * y_a + gate_b * y_b) @ w_out[i]
        x = x + peer_ffn(rms_norm(x, norm_ffn[i]), peer_w_q[i], peer_sub_keys[i], peer_u[i], peer_v[i])
        x = x + jax.nn.sigmoid(rms_norm(x, norm_ple[i]) @ ple_w_gate[i]) * (p[i] @ ple_w_proj[i])
    return rms_norm(x, norm_final)
```

```cpp
#include <hip/hip_runtime.h>
#include <hip/hip_cooperative_groups.h>
#include <stdint.h>
#include <stdio.h>
namespace cg = cooperative_groups;

typedef __bf16 bf16;
typedef __attribute__((ext_vector_type(8))) __bf16 bf16x8;
typedef __attribute__((ext_vector_type(4))) __bf16 bf16x4;
typedef __attribute__((ext_vector_type(2))) __bf16 bf16x2;
typedef __attribute__((ext_vector_type(16))) float f32x16;
typedef __attribute__((ext_vector_type(4))) float f32x4;
typedef __attribute__((ext_vector_type(2))) float f32x2;
typedef __attribute__((ext_vector_type(4))) unsigned u32x4;
typedef __attribute__((ext_vector_type(2))) unsigned u32x2;
typedef __attribute__((ext_vector_type(4))) int i32x4;

#define DEVI __device__ __forceinline__
#ifndef ABL
#define ABL 0
#endif

constexpr int T_TOK = 32768;
constexpr int SEQ = 4096;
constexpr int DM = 1024;
constexpr int IN_COLS = 4512;
constexpr int RWC = 1792;
constexpr int MLC = 672;
constexpr int NTHREADS = 256;

constexpr size_t MiB = 1ull << 20;
constexpr size_t OFF_WIN_T = 0;
constexpr size_t OFF_WG_T = 5 * MiB;
constexpr size_t OFF_W2_T = 9 * MiB;
constexpr size_t OFF_A2_T = 9 * MiB + 65536;
constexpr size_t OFF_G2_T = 9 * MiB + 131072;
constexpr size_t OFF_RWO_T = 10 * MiB;
constexpr size_t OFF_MLO_T = 11 * MiB;
constexpr size_t OFF_WUQ_T = 12 * MiB;
constexpr size_t OFF_WUKV_T = 13 * MiB;
constexpr size_t OFF_PP_T = 13 * MiB + 524288;
constexpr size_t OFF_WOUT_T = 14 * MiB;
constexpr size_t OFF_PG_T = 16 * MiB;
constexpr size_t OFF_WQ_T = 18 * MiB;
constexpr size_t OFF_SK = 22 * MiB;
constexpr size_t OFF_CNT = 22 * MiB + 524288;
constexpr size_t OFF_CS = 23 * MiB;
constexpr size_t OFF_SN = 25 * MiB;
constexpr size_t OFF_RK = 27 * MiB;
constexpr size_t OFF_PBF = 28 * MiB;
constexpr size_t OFF_UBF = 44 * MiB;
constexpr size_t OFF_VBF = 76 * MiB;
constexpr size_t OFF_H1 = 108 * MiB;
constexpr size_t OFF_ZRW = 172 * MiB;
constexpr size_t OFF_ZMLA = 284 * MiB;
constexpr size_t OFF_LORA = 326 * MiB;
constexpr size_t OFF_CQ = 342 * MiB;
constexpr size_t OFF_CKV = 366 * MiB;
constexpr size_t OFF_E = 382 * MiB;
constexpr size_t OFF_ICLR = 446 * MiB;
constexpr size_t OFF_G = 478 * MiB;
constexpr size_t OFF_O = 284 * MiB;
constexpr size_t OFF_YRAW = 326 * MiB;
constexpr size_t OFF_YAPRE = 358 * MiB;
constexpr size_t OFF_M = 172 * MiB;
constexpr size_t OFF_H2 = 382 * MiB;
constexpr size_t OFF_TOPK = 236 * MiB;
constexpr size_t OFF_IDX = 446 * MiB;
constexpr size_t OFF_GATE = 462 * MiB;
constexpr size_t OFF_H3 = 172 * MiB;
constexpr size_t OFF_Q = 0;
constexpr size_t OFF_K = 48 * MiB;
constexpr size_t OFF_VT = 96 * MiB;

struct Params {
  const float* x; const float* p; const int* pos; const float* norm_mix; const float* w_in; const float* rw_mu;
  const float* rw_w0; const float* rw_w2; const float* rw_a0; const float* rw_a2; const float* rw_g2; const float* rw_k_k;
  const float* rw_k_a; const float* rw_r_k; const float* rw_gn_w; const float* rw_gn_b; const float* rw_w_o;
  const float* mla_q_norm; const float* mla_w_uq; const float* mla_kv_norm; const float* mla_w_ukv; const float* mla_w_o;
  const float* w_out; const float* norm_ffn; const float* peer_w_q; const float* peer_sub_keys; const float* peer_u;
  const float* peer_v; const float* norm_ple; const float* ple_w_gate; const float* ple_w_proj; const float* norm_final;
  float* out; unsigned char* ws;
};

DEVI u32x4 mk_u4(unsigned a, unsigned b, unsigned c, unsigned d) { u32x4 v; v.x = a; v.y = b; v.z = c; v.w = d; return v; }
DEVI u32x2 mk_u2(unsigned a, unsigned b) { u32x2 v; v.x = a; v.y = b; return v; }
DEVI f32x4 mk_f4(float a, float b, float c, float d) { f32x4 v; v.x = a; v.y = b; v.z = c; v.w = d; return v; }
DEVI i32x4 mk_i4(int a, int b, int c, int d) { i32x4 v; v.x = a; v.y = b; v.z = c; v.w = d; return v; }
DEVI float wave_sum(float v) {
#pragma unroll
  for (int o = 32; o > 0; o >>= 1) v += __shfl_xor(v, o, 64);
  return v;
}
template <int CTRL> DEVI float dpp_f(float v) {
  return __int_as_float(__builtin_amdgcn_update_dpp(0, __float_as_int(v), CTRL, 0xf, 0xf, true));
}
DEVI float row16_allsum(float v) {
  v += dpp_f<0xB1>(v);
  v += dpp_f<0x4E>(v);
  v += dpp_f<0x141>(v);
  v += dpp_f<0x140>(v);
  return v;
}
DEVI float row8_allsum(float v) {
  v += dpp_f<0xB1>(v);
  v += dpp_f<0x4E>(v);
  v += dpp_f<0x141>(v);
  return v;
}
DEVI float sigmoid_f(float x) { return 1.f / (1.f + __expf(-x)); }
DEVI float bflo(unsigned u) { return __uint_as_float(u << 16); }
DEVI float bfhi(unsigned u) { return __uint_as_float(u & 0xffff0000u); }
DEVI unsigned pack2(float a, float b) {
  bf16x2 v; v[0] = (bf16)a; v[1] = (bf16)b;
  return __builtin_bit_cast(unsigned, v);
}
DEVI float dot2bf(unsigned a, unsigned b, float c) {
  return __builtin_amdgcn_fdot2_f32_bf16(__builtin_bit_cast(bf16x2, a), __builtin_bit_cast(bf16x2, b), c, false);
}

struct GemmSmem { bf16 a[128][72]; bf16 b[128][72]; };

template <int MT, int NT>
DEVI void gemm_mainloop(f32x16 (&acc)[MT][NT], const bf16* __restrict__ A, int lda, const bf16* __restrict__ B, int ldb,
                        int K, GemmSmem& sm, int wrow0, int wcol0) {
  const int tid = threadIdx.x, lane = tid & 63;
  const int lr = tid >> 3, lc = (tid & 7) * 8;
  u32x4 ra[4], rb[4];
  const bf16* ap = A + (size_t)lr * lda + lc;
  const bf16* bp = B + (size_t)lr * ldb + lc;
#pragma unroll
  for (int i = 0; i < 4; ++i) {
    ra[i] = *(const u32x4*)(ap + (size_t)(32 * i) * lda);
    rb[i] = *(const u32x4*)(bp + (size_t)(32 * i) * ldb);
  }
  const int fr = lane & 31, fk = (lane >> 5) * 8;
  for (int k0 = 0; k0 < K; k0 += 64) {
    __syncthreads();
#pragma unroll
    for (int i = 0; i < 4; ++i) {
      *(u32x4*)&sm.a[lr + 32 * i][lc] = ra[i];
      *(u32x4*)&sm.b[lr + 32 * i][lc] = rb[i];
    }
    __syncthreads();
    if (k0 + 64 < K) {
#pragma unroll
      for (int i = 0; i < 4; ++i) {
        ra[i] = *(const u32x4*)(ap + (size_t)(32 * i) * lda + k0 + 64);
        rb[i] = *(const u32x4*)(bp + (size_t)(32 * i) * ldb + k0 + 64);
      }
    }
#pragma unroll
    for (int ks = 0; ks < 4; ++ks) {
      bf16x8 af[MT], bfr[NT];
#pragma unroll
      for (int mt = 0; mt < MT; ++mt) af[mt] = *(const bf16x8*)&sm.a[wrow0 + mt * 32 + fr][ks * 16 + fk];
#pragma unroll
      for (int nt = 0; nt < NT; ++nt) bfr[nt] = *(const bf16x8*)&sm.b[wcol0 + nt * 32 + fr][ks * 16 + fk];
#pragma unroll
      for (int mt = 0; mt < MT; ++mt)
#pragma unroll
        for (int nt = 0; nt < NT; ++nt)
          acc[mt][nt] = __builtin_amdgcn_mfma_f32_32x32x16_bf16(af[mt], bfr[nt], acc[mt][nt], 0, 0, 0);
    }
  }
}

template <int MT, int NT> DEVI void acc_zero(f32x16 (&acc)[MT][NT]) {
#pragma unroll
  for (int mt = 0; mt < MT; ++mt)
#pragma unroll
    for (int nt = 0; nt < NT; ++nt)
#pragma unroll
      for (int r = 0; r < 16; ++r) acc[mt][nt][r] = 0.f;
}

DEVI int acc_row(int wrow0, int mt, int r, int lane) { return wrow0 + mt * 32 + (r & 3) + 8 * (r >> 2) + 4 * (lane >> 5); }
DEVI int acc_col(int wcol0, int nt, int lane) { return wcol0 + nt * 32 + (lane & 31); }

DEVI void transpose_tile(const float* __restrict__ src, int ld, int n0, int nvalid, int K, bf16* __restrict__ dst, int tile,
                         float* sm) {
  const int ktiles = K >> 6;
  const int nb = (tile / ktiles) << 6, kb = (tile % ktiles) << 6;
  const int tid = threadIdx.x;
  const int ty = tid >> 4, tx = tid & 15;
#pragma unroll
  for (int i = 0; i < 4; ++i) {
    const int k = kb + ty + 16 * i, n = nb + tx * 4;
    f32x4 v = mk_f4(0.f, 0.f, 0.f, 0.f);
    if (n < nvalid) v = *(const f32x4*)(src + (size_t)k * ld + n0 + n);
    float* s = sm + (ty + 16 * i) * 65 + tx * 4;
    s[0] = v.x; s[1] = v.y; s[2] = v.z; s[3] = v.w;
  }
  __syncthreads();
  const int n = tid >> 2, kq = tid & 3;
  bf16x8 o0, o1;
#pragma unroll
  for (int j = 0; j < 8; ++j) {
    o0[j] = (bf16)sm[(kq * 16 + j) * 65 + n];
    o1[j] = (bf16)sm[(kq * 16 + 8 + j) * 65 + n];
  }
  bf16* d = dst + (size_t)(nb + n) * K + kb + kq * 16;
  *(bf16x8*)d = o0;
  *(bf16x8*)(d + 8) = o1;
  __syncthreads();
}

DEVI void convert_job(const float* __restrict__ src, bf16* __restrict__ dst, size_t n) {
  const size_t n4 = n >> 2;
  for (size_t i = (size_t)blockIdx.x * NTHREADS + threadIdx.x; i < n4; i += (size_t)gridDim.x * NTHREADS) {
    const f32x4 v = ((const f32x4*)src)[i];
    bf16x4 o; o[0] = (bf16)v.x; o[1] = (bf16)v.y; o[2] = (bf16)v.z; o[3] = (bf16)v.w;
    ((bf16x4*)dst)[i] = o;
  }
}

DEVI void rmsnorm_rows_bf16(const float* src, const float* __restrict__ gain, bf16* __restrict__ dst) {
  const int lane = threadIdx.x & 63;
  const int gw = blockIdx.x * 4 + (threadIdx.x >> 6), nw = gridDim.x * 4;
  f32x4 gn[4];
#pragma unroll
  for (int i = 0; i < 4; ++i) gn[i] = *(const f32x4*)(gain + i * 256 + lane * 4);
  for (int t = gw; t < T_TOK; t += nw) {
    const float* xr = src + (size_t)t * DM;
    f32x4 v[4];
    float ss = 0.f;
#pragma unroll
    for (int i = 0; i < 4; ++i) {
      v[i] = *(const f32x4*)(xr + i * 256 + lane * 4);
      ss += v[i].x * v[i].x + v[i].y * v[i].y + v[i].z * v[i].z + v[i].w * v[i].w;
    }
    ss = wave_sum(ss);
    const float rs = rsqrtf(ss * (1.f / DM) + 1e-6f);
#pragma unroll
    for (int i = 0; i < 4; ++i) {
      bf16x4 o;
      o[0] = (bf16)(v[i].x * rs * gn[i].x); o[1] = (bf16)(v[i].y * rs * gn[i].y);
      o[2] = (bf16)(v[i].z * rs * gn[i].z); o[3] = (bf16)(v[i].w * rs * gn[i].w);
      *(bf16x4*)(dst + (size_t)t * DM + i * 256 + lane * 4) = o;
    }
  }
}

DEVI void phase0(const Params& p, unsigned char* smem) {
  unsigned char* ws = p.ws;
  float* smf = (float*)smem;
#define TJOB(SRC, LD, N0, NVALID, NPAD, KK, OFF)                                              \
  for (int tile = blockIdx.x; tile < ((NPAD) >> 6) * ((KK) >> 6); tile += gridDim.x)         \
    transpose_tile((SRC), (LD), (N0), (NVALID), (KK), (bf16*)(ws + (OFF)), tile, smf);
  TJOB(p.w_in, IN_COLS, 0, 2464, 2560, 1024, OFF_WIN_T)
  TJOB(p.w_in, IN_COLS, 2464, 2048, 2048, 1024, OFF_WG_T)
  TJOB(p.rw_w2, 512, 0, 512, 512, 64, OFF_W2_T)
  TJOB(p.rw_a2, 512, 0, 512, 512, 64, OFF_A2_T)
  TJOB(p.rw_g2, 512, 0, 512, 512, 128, OFF_G2_T)
  TJOB(p.rw_w_o, 1024, 0, 1024, 1024, 512, OFF_RWO_T)
  TJOB(p.mla_w_o, 1024, 0, 1024, 1024, 512, OFF_MLO_T)
  TJOB(p.mla_w_uq, 768, 0, 768, 768, 384, OFF_WUQ_T)
  TJOB(p.mla_w_ukv, 1024, 0, 1024, 1024, 256, OFF_WUKV_T)
  TJOB(p.w_out, 1024, 0, 1024, 1024, 1024, OFF_WOUT_T)
  TJOB(p.peer_w_q, 2048, 0, 2048, 2048, 1024, OFF_WQ_T)
  TJOB(p.ple_w_gate, 1024, 0, 1024, 1024, 1024, OFF_PG_T)
  TJOB(p.ple_w_proj, 1024, 0, 1024, 1024, 256, OFF_PP_T)
#undef TJOB
  convert_job(p.peer_sub_keys, (bf16*)(ws + OFF_SK), (size_t)8 * 2 * 128 * 128);
  convert_job(p.peer_u, (bf16*)(ws + OFF_UBF), (size_t)16384 * 1024);
  convert_job(p.peer_v, (bf16*)(ws + OFF_VBF), (size_t)16384 * 1024);
  convert_job(p.p, (bf16*)(ws + OFF_PBF), (size_t)T_TOK * 256);
  rmsnorm_rows_bf16(p.x, p.norm_mix, (bf16*)(ws + OFF_H1));
  {
    float* cs = (float*)(ws + OFF_CS);
    float* sn = (float*)(ws + OFF_SN);
    for (int i = blockIdx.x * NTHREADS + threadIdx.x; i < T_TOK * 16; i += gridDim.x * NTHREADS) {
      const int t = i >> 4, f = i & 15;
      const float inv = powf(10000.f, -(float)(2 * f) / 32.f);
      const float ang = (float)p.pos[t] * inv;
      double s, c;
      sincos((double)ang, &s, &c);
      cs[i] = (float)c; sn[i] = (float)s;
    }
  }
  if (blockIdx.x == 0 && threadIdx.x < 64) ((unsigned*)(ws + OFF_CNT))[threadIdx.x] = 0u;
}

DEVI void phase1(const Params& p, unsigned char* smem) {
  GemmSmem& sm = *(GemmSmem*)smem;
  const bf16* H1 = (const bf16*)(p.ws + OFF_H1);
  const bf16* W = (const bf16*)(p.ws + OFF_WIN_T);
  bf16* zrw = (bf16*)(p.ws + OFF_ZRW);
  bf16* zmla = (bf16*)(p.ws + OFF_ZMLA);
  const int lane = threadIdx.x & 63, w = threadIdx.x >> 6;
  const int wrow0 = (w >> 1) * 64, wcol0 = (w & 1) * 64;
  for (int tile = blockIdx.x; tile < 256 * 20; tile += gridDim.x) {
    const int mt0 = (tile / 20) * 128, nt0 = (tile % 20) * 128;
    f32x16 acc[2][2];
    acc_zero(acc);
    gemm_mainloop<2, 2>(acc, H1 + (size_t)mt0 * DM, DM, W + (size_t)nt0 * DM, DM, DM, sm, wrow0, wcol0);
#pragma unroll
    for (int mt = 0; mt < 2; ++mt)
#pragma unroll
      for (int nt = 0; nt < 2; ++nt) {
        const int n = nt0 + acc_col(wcol0, nt, lane);
#pragma unroll
        for (int r = 0; r < 16; ++r) {
          const int m = mt0 + acc_row(wrow0, mt, r, lane);
          const float v = acc[mt][nt][r];
          if (n < RWC) zrw[(size_t)m * RWC + n] = (bf16)v;
          else if (n < RWC + MLC) zmla[(size_t)m * MLC + (n - RWC)] = (bf16)v;
        }
      }
  }
}

DEVI void phase2a(const Params& p) {
  const int lane = threadIdx.x & 63;
  const int gw = blockIdx.x * 4 + (threadIdx.x >> 6), nw = gridDim.x * 4;
  const bf16* zrw = (const bf16*)(p.ws + OFF_ZRW);
  const bf16* zmla = (const bf16*)(p.ws + OFF_ZMLA);
  bf16* lora = (bf16*)(p.ws + OFF_LORA);
  bf16* cq = (bf16*)(p.ws + OFF_CQ);
  bf16* ckv = (bf16*)(p.ws + OFF_CKV);
  bf16* Kd = (bf16*)((unsigned char*)p.out + OFF_K);
  const float* cs = (const float*)(p.ws + OFF_CS);
  const float* sn = (const float*)(p.ws + OFF_SN);
  const f32x4 mu = *(const f32x4*)(p.rw_mu + 1536 + lane * 4);
  const f32x4 qg0 = *(const f32x4*)(p.mla_q_norm + lane * 4);
  const f32x2 qg1 = *(const f32x2*)(p.mla_q_norm + 256 + lane * 2);
  const f32x4 kg = *(const f32x4*)(p.mla_kv_norm + lane * 4);
  const float mua[4] = {mu.x, mu.y, mu.z, mu.w};
  for (int t = gw; t < T_TOK; t += nw) {
    const int s = t & (SEQ - 1), b = t >> 12;
    {
      const bf16* zp = zrw + (size_t)t * RWC + 1536 + lane * 4;
      const bf16x4 zc = *(const bf16x4*)zp;
      bf16x4 zv;
      if (s > 0) zv = *(const bf16x4*)(zp - RWC);
      else { zv[0] = (bf16)0.f; zv[1] = (bf16)0.f; zv[2] = (bf16)0.f; zv[3] = (bf16)0.f; }
      bf16x4 o;
#pragma unroll
      for (int j = 0; j < 4; ++j) {
        const float c = (float)zc[j], pv = (float)zv[j];
        const float zs = c + mua[j] * (pv - c);
        float val;
        if (lane < 16) val = tanhf(zs);
        else if (lane < 32) val = zs;
        else val = sigmoid_f(zs);
        o[j] = (bf16)val;
      }
      *(bf16x4*)(lora + (size_t)t * 256 + lane * 4) = o;
    }
    {
      const bf16* zq = zmla + (size_t)t * MLC;
      const bf16x4 q0 = *(const bf16x4*)(zq + lane * 4);
      const bf16x2 q1 = *(const bf16x2*)(zq + 256 + lane * 2);
      float f[6] = {(float)q0[0], (float)q0[1], (float)q0[2], (float)q0[3], (float)q1[0], (float)q1[1]};
      float ss = 0.f;
#pragma unroll
      for (int j = 0; j < 6; ++j) ss += f[j] * f[j];
      ss = wave_sum(ss);
      const float rs = rsqrtf(ss * (1.f / 384.f) + 1e-6f);
      bf16x4 o0; bf16x2 o1;
      o0[0] = (bf16)(f[0] * rs * qg0.x); o0[1] = (bf16)(f[1] * rs * qg0.y);
      o0[2] = (bf16)(f[2] * rs * qg0.z); o0[3] = (bf16)(f[3] * rs * qg0.w);
      o1[0] = (bf16)(f[4] * rs * qg1.x); o1[1] = (bf16)(f[5] * rs * qg1.y);
      *(bf16x4*)(cq + (size_t)t * 384 + lane * 4) = o0;
      *(bf16x2*)(cq + (size_t)t * 384 + 256 + lane * 2) = o1;
    }
    {
      const bf16x4 k0 = *(const bf16x4*)(zmla + (size_t)t * MLC + 384 + lane * 4);
      float f[4] = {(float)k0[0], (float)k0[1], (float)k0[2], (float)k0[3]};
      float ss = f[0] * f[0] + f[1] * f[1] + f[2] * f[2] + f[3] * f[3];
      ss = wave_sum(ss);
      const float rs = rsqrtf(ss * (1.f / 256.f) + 1e-6f);
      bf16x4 o;
      o[0] = (bf16)(f[0] * rs * kg.x); o[1] = (bf16)(f[1] * rs * kg.y);
      o[2] = (bf16)(f[2] * rs * kg.z); o[3] = (bf16)(f[3] * rs * kg.w);
      *(bf16x4*)(ckv + (size_t)t * 256 + lane * 4) = o;
    }
    {
      const float xr = (float)zmla[(size_t)t * MLC + 640 + (lane & 31)];
      const float xp = __shfl_xor(xr, 16, 64);
      const int f = lane & 15;
      const float c = cs[t * 16 + f], sv = sn[t * 16 + f];
      const float o = (lane & 16) ? (xr * c + xp * sv) : (xr * c - xp * sv);
      if (lane < 32) {
        const bf16 ob = (bf16)o;
#pragma unroll
        for (int h = 0; h < 8; ++h) Kd[((size_t)(b * 8 + h) * SEQ + s) * 96 + 64 + lane] = ob;
      }
    }
  }
}

constexpr float QSCALE = 0.14724444f;
DEVI void phase2b(const Params& p, unsigned char* smem) {
  GemmSmem& sm = *(GemmSmem*)smem;
  unsigned char* ws = p.ws;
  const bf16* lora = (const bf16*)(ws + OFF_LORA);
  const bf16* cq = (const bf16*)(ws + OFF_CQ);
  const bf16* ckv = (const bf16*)(ws + OFF_CKV);
  float* E = (float*)(ws + OFF_E);
  bf16* ICLR = (bf16*)(ws + OFF_ICLR);
  bf16* G = (bf16*)(ws + OFF_G);
  bf16* Qd = (bf16*)((unsigned char*)p.out + OFF_Q);
  bf16* Kd = (bf16*)((unsigned char*)p.out + OFF_K);
  bf16* Vd = (bf16*)((unsigned char*)p.out + OFF_VT);
  const float* cs = (const float*)(ws + OFF_CS);
  const float* sn = (const float*)(ws + OFF_SN);
  const int lane = threadIdx.x & 63, w = threadIdx.x >> 6;
  const int wrow0 = (w >> 1) * 64, wcol0 = (w & 1) * 64;
  for (int tile = blockIdx.x; tile < 256 * 26; tile += gridDim.x) {
    const int m0 = (tile / 26) * 128, j = tile % 26;
    const bf16* A; const bf16* Bm; int lda, K, kind, n0;
    if (j < 4) { kind = 0; n0 = j * 128; A = lora + (size_t)m0 * 256; lda = 256; K = 64; Bm = (const bf16*)(ws + OFF_W2_T) + (size_t)n0 * 64; }
    else if (j < 8) { kind = 1; n0 = (j - 4) * 128; A = lora + (size_t)m0 * 256 + 64; lda = 256; K = 64; Bm = (const bf16*)(ws + OFF_A2_T) + (size_t)n0 * 64; }
    else if (j < 12) { kind = 2; n0 = (j - 8) * 128; A = lora + (size_t)m0 * 256 + 128; lda = 256; K = 128; Bm = (const bf16*)(ws + OFF_G2_T) + (size_t)n0 * 128; }
    else if (j < 18) { kind = 3; n0 = (j - 12) * 128; A = cq + (size_t)m0 * 384; lda = 384; K = 384; Bm = (const bf16*)(ws + OFF_WUQ_T) + (size_t)n0 * 384; }
    else { kind = 4; n0 = (j - 18) * 128; A = ckv + (size_t)m0 * 256; lda = 256; K = 256; Bm = (const bf16*)(ws + OFF_WUKV_T) + (size_t)n0 * 256; }
    f32x16 acc[2][2];
    acc_zero(acc);
    gemm_mainloop<2, 2>(acc, A, lda, Bm, K, K, sm, wrow0, wcol0);
    if (kind <= 2) {
#pragma unroll
      for (int mt = 0; mt < 2; ++mt)
#pragma unroll
        for (int nt = 0; nt < 2; ++nt) {
          const int n = n0 + acc_col(wcol0, nt, lane);
          const float bias = (kind == 0) ? p.rw_w0[n] : ((kind == 1) ? p.rw_a0[n] : 0.f);
#pragma unroll
          for (int r = 0; r < 16; ++r) {
            const int m = m0 + acc_row(wrow0, mt, r, lane);
            const float v = acc[mt][nt][r];
            if (kind == 0) E[(size_t)m * 512 + n] = 0.60653066f * sigmoid_f(bias + v);
            else if (kind == 1) ICLR[(size_t)m * 512 + n] = (bf16)sigmoid_f(bias + v);
            else G[(size_t)m * 512 + n] = (bf16)v;
          }
        }
    } else if (kind == 3) {
#pragma unroll
      for (int nt = 0; nt < 2; ++nt) {
        const int blk = (n0 + wcol0 + nt * 32) >> 5;
        const int head = blk / 3, part = blk % 3;
        const int d = part * 32 + (lane & 31);
#pragma unroll
        for (int mt = 0; mt < 2; ++mt)
#pragma unroll
          for (int r = 0; r < 16; ++r) {
            const int m = m0 + acc_row(wrow0, mt, r, lane);
            const int s = m & (SEQ - 1), b = m >> 12;
            float v = acc[mt][nt][r] * QSCALE;
            if (part == 2) {
              const float pv = __shfl_xor(v, 16, 64);
              const int f = lane & 15;
              const float c = cs[m * 16 + f], sv = sn[m * 16 + f];
              v = (lane & 16) ? (v * c + pv * sv) : (v * c - pv * sv);
            }
            Qd[((size_t)(b * 8 + head) * SEQ + s) * 96 + d] = (bf16)v;
          }
      }
    } else {
      const int head = n0 >> 7;
      if ((w & 1) == 0) {
#pragma unroll
        for (int nt = 0; nt < 2; ++nt) {
          const int d = nt * 32 + (lane & 31);
#pragma unroll
          for (int mt = 0; mt < 2; ++mt)
#pragma unroll
            for (int r = 0; r < 16; ++r) {
              const int m = m0 + acc_row(wrow0, mt, r, lane);
              const int s = m & (SEQ - 1), b = m >> 12;
              Kd[((size_t)(b * 8 + head) * SEQ + s) * 96 + d] = (bf16)acc[mt][nt][r];
            }
        }
      } else {
#pragma unroll
        for (int nt = 0; nt < 2; ++nt) {
          const int vdim = nt * 32 + (lane & 31);
#pragma unroll
          for (int mt = 0; mt < 2; ++mt)
#pragma unroll
            for (int rg = 0; rg < 4; ++rg) {
              const int m = m0 + wrow0 + mt * 32 + 8 * rg + 4 * (lane >> 5);
              const int s = m & (SEQ - 1), b = m >> 12;
              bf16x4 o;
              o[0] = (bf16)acc[mt][nt][4 * rg + 0]; o[1] = (bf16)acc[mt][nt][4 * rg + 1];
              o[2] = (bf16)acc[mt][nt][4 * rg + 2]; o[3] = (bf16)acc[mt][nt][4 * rg + 3];
              *(bf16x4*)(Vd + (((size_t)(b * 8 + head) * 64 + (s >> 6)) * 64 + vdim) * 64 + (s & 63)) = o;
            }
        }
      }
    }
  }
}

struct ScanBuf { float A[16][64], B[16][64], W[16][64], K2[16][64], R[16][64]; float V[16][16]; };
DEVI void phase3a(const Params& p, unsigned char* smem) {
  ScanBuf* sb = (ScanBuf*)smem;
  const bf16* zrw = (const bf16*)(p.ws + OFF_ZRW);
  const float* E = (const float*)(p.ws + OFF_E);
  const bf16* ICLR = (const bf16*)(p.ws + OFF_ICLR);
  bf16* YRAW = (bf16*)(p.ws + OFF_YRAW);
  float* RK = (float*)(p.ws + OFF_RK);
  const int tid = threadIdx.x, lane = tid & 63, w = tid >> 6;
  const int pi = tid >> 4, kq = tid & 15;
  const int rloc = 4 * w + (lane >> 4), kg = lane & 15;
  for (int item = blockIdx.x; item < 256; item += gridDim.x) {
    const int bh = item >> 2, quarter = item & 3, b = bh >> 3, h = bh & 7;
    const int c0 = h * 64 + 4 * kq;
    const f32x4 mur = *(const f32x4*)(p.rw_mu + c0);
    const f32x4 muk = *(const f32x4*)(p.rw_mu + 512 + c0);
    const f32x4 muv = *(const f32x4*)(p.rw_mu + 1024 + c0);
    const f32x4 kkw = *(const f32x4*)(p.rw_k_k + c0);
    const f32x4 kaw = *(const f32x4*)(p.rw_k_a + c0);
    const f32x4 rkw = *(const f32x4*)(p.rw_r_k + c0);
    const float mur_[4] = {mur.x, mur.y, mur.z, mur.w}, muk_[4] = {muk.x, muk.y, muk.z, muk.w},
                muv_[4] = {muv.x, muv.y, muv.z, muv.w}, kkw_[4] = {kkw.x, kkw.y, kkw.z, kkw.w},
                kaw_[4] = {kaw.x, kaw.y, kaw.z, kaw.w}, rkw_[4] = {rkw.x, rkw.y, rkw.z, rkw.w};
    bf16x4 zr, zk, zv, pr, pk, pv, ic;
    f32x4 ee;
    auto load_raw = [&](int c) {
      const int s = c * 16 + pi;
      const size_t t = (size_t)b * SEQ + s;
      const bf16* zp = zrw + t * RWC + c0;
      zr = *(const bf16x4*)zp; zk = *(const bf16x4*)(zp + 512); zv = *(const bf16x4*)(zp + 1024);
      if (s > 0) {
        pr = *(const bf16x4*)(zp - RWC); pk = *(const bf16x4*)(zp - RWC + 512); pv = *(const bf16x4*)(zp - RWC + 1024);
      } else {
#pragma unroll
        for (int j = 0; j < 4; ++j) { pr[j] = (bf16)0.f; pk[j] = (bf16)0.f; pv[j] = (bf16)0.f; }
      }
      ee = *(const f32x4*)(E + t * 512 + c0);
      ic = *(const bf16x4*)(ICLR + t * 512 + c0);
    };
    load_raw(0);
    float s0 = 0.f, s1 = 0.f, s2 = 0.f, s3 = 0.f;
    for (int c = 0; c < 256; ++c) {
      ScanBuf& bf = sb[c & 1];
      {
        const float ee_[4] = {ee.x, ee.y, ee.z, ee.w};
        float r[4], k[4], v[4], kx[4], icl[4];
        float n2 = 0.f;
#pragma unroll
        for (int j = 0; j < 4; ++j) {
          const float zrj = (float)zr[j], zkj = (float)zk[j], zvj = (float)zv[j];
          r[j] = zrj + mur_[j] * ((float)pr[j] - zrj);
          k[j] = zkj + muk_[j] * ((float)pk[j] - zkj);
          v[j] = zvj + muv_[j] * ((float)pv[j] - zvj);
          kx[j] = k[j] * kkw_[j];
          n2 += kx[j] * kx[j];
          icl[j] = (float)ic[j];
        }
        n2 = row16_allsum(n2);
        const float inv = 1.f / fmaxf(sqrtf(n2), 1e-12f);
        f32x4 a4, b4, w4, k4, r4;
        float av[4], bv[4], wv[4], k2[4];
        float rkp = 0.f;
#pragma unroll
        for (int j = 0; j < 4; ++j) {
          float kkn = kx[j] * inv;
#if ABL == 5
          kkn = (float)(bf16)kkn;
#endif
          k2[j] = k[j] * (1.f + (icl[j] - 1.f) * kaw_[j]);
          av[j] = -kkn;
          bv[j] = kkn * icl[j];
#if ABL == 6
          wv[j] = __expf(-(float)(bf16)ee_[j]);
#else
          wv[j] = __expf(-ee_[j]);
#endif
          rkp += r[j] * k2[j] * rkw_[j];
        }
        rkp = row16_allsum(rkp);
        a4 = mk_f4(av[0], av[1], av[2], av[3]);
        b4 = mk_f4(bv[0], bv[1], bv[2], bv[3]);
        w4 = mk_f4(wv[0], wv[1], wv[2], wv[3]);
        k4 = mk_f4(k2[0], k2[1], k2[2], k2[3]);
        r4 = mk_f4(r[0], r[1], r[2], r[3]);
        *(f32x4*)&bf.A[pi][4 * kq] = a4;
        *(f32x4*)&bf.B[pi][4 * kq] = b4;
        *(f32x4*)&bf.W[pi][4 * kq] = w4;
        *(f32x4*)&bf.K2[pi][4 * kq] = k4;
        *(f32x4*)&bf.R[pi][4 * kq] = r4;
        if ((kq >> 2) == quarter) *(f32x4*)&bf.V[pi][(kq & 3) * 4] = mk_f4(v[0], v[1], v[2], v[3]);
        if (quarter == 0 && kq == 0) RK[((size_t)b * SEQ + c * 16 + pi) * 8 + h] = rkp;
      }
      __syncthreads();
      if (c + 1 < 256) load_raw(c + 1);
      float yv = 0.f;
#pragma unroll
      for (int i = 0; i < 16; ++i) {
        const f32x4 A4 = *(const f32x4*)&bf.A[i][4 * kg];
        const f32x4 B4 = *(const f32x4*)&bf.B[i][4 * kg];
        const f32x4 W4 = *(const f32x4*)&bf.W[i][4 * kg];
        const f32x4 K4 = *(const f32x4*)&bf.K2[i][4 * kg];
        const f32x4 R4 = *(const f32x4*)&bf.R[i][4 * kg];
        const float vv = bf.V[i][rloc];
        float pd = s0 * A4.x + s1 * A4.y + s2 * A4.z + s3 * A4.w;
        const float sa = row16_allsum(pd);
        s0 = s0 * W4.x + vv * K4.x + sa * B4.x;
        s1 = s1 * W4.y + vv * K4.y + sa * B4.y;
        s2 = s2 * W4.z + vv * K4.z + sa * B4.z;
        s3 = s3 * W4.w + vv * K4.w + sa * B4.w;
        float yp = s0 * R4.x + s1 * R4.y + s2 * R4.z + s3 * R4.w;
        const float y = row16_allsum(yp);
        yv = (kg == i) ? y : yv;
      }
      YRAW[((size_t)b * SEQ + c * 16 + kg) * 512 + h * 64 + quarter * 16 + rloc] = (bf16)yv;
    }
    __syncthreads();
  }
}

struct AttnSmem { bf16 k[64][104]; bf16 v[64][68]; int tile; };
DEVI void phase3b(const Params& p, unsigned char* smem) {
  AttnSmem& sm = *(AttnSmem*)smem;
  const bf16* Qd = (const bf16*)((const unsigned char*)p.out + OFF_Q);
  const bf16* Kd = (const bf16*)((const unsigned char*)p.out + OFF_K);
  const bf16* Vd = (const bf16*)((const unsigned char*)p.out + OFF_VT);
  bf16* O = (bf16*)(p.ws + OFF_O);
  unsigned* cnt = (unsigned*)(p.ws + OFF_CNT);
  const int tid = threadIdx.x, lane = tid & 63, w = tid >> 6;
  const int q = lane & 31, hh = lane >> 5;
  for (;;) {
    if (tid == 0) sm.tile = (int)atomicAdd(cnt, 1u);
    __syncthreads();
    const int tile = sm.tile;
    __syncthreads();
    if (tile >= 2048) break;
    const int qt = 31 - (tile >> 6), bh = tile & 63;
    const int s0 = qt * 128;
    const int nkt = 2 * qt + 2;
    const int my_nkt = 2 * qt + 1 + (w >> 1);
    bf16x8 qf[6];
    {
      const bf16* qp = Qd + ((size_t)bh * SEQ + s0 + w * 32 + q) * 96 + hh * 8;
#pragma unroll
      for (int ks = 0; ks < 6; ++ks) qf[ks] = *(const bf16x8*)(qp + ks * 16);
    }
    f32x16 ot[2];
#pragma unroll
    for (int vb = 0; vb < 2; ++vb)
#pragma unroll
      for (int r = 0; r < 16; ++r) ot[vb][r] = 0.f;
    float mrun = -1e30f, lsum = 0.f;
    u32x4 kr[3], vr[2];
    auto gload = [&](int kt) {
      const bf16* kb = Kd + ((size_t)bh * SEQ + kt * 64) * 96;
#pragma unroll
      for (int i = 0; i < 3; ++i) kr[i] = *(const u32x4*)(kb + (size_t)(tid + 256 * i) * 8);
      const bf16* vb = Vd + ((size_t)bh * 64 + kt) * 4096;
#pragma unroll
      for (int i = 0; i < 2; ++i) vr[i] = *(const u32x4*)(vb + (size_t)(tid + 256 * i) * 8);
    };
    gload(0);
    for (int kt = 0; kt < nkt; ++kt) {
      __syncthreads();
#pragma unroll
      for (int i = 0; i < 3; ++i) {
        const int id = tid + 256 * i;
        const int row = id / 12, cc = id % 12;
        *(u32x4*)&sm.k[row][cc * 8] = kr[i];
      }
#pragma unroll
      for (int i = 0; i < 2; ++i) {
        const int id = tid + 256 * i;
        const int row = id >> 3, cc = id & 7;
        u32x2* d = (u32x2*)&sm.v[row][cc * 8];
        d[0] = mk_u2(vr[i].x, vr[i].y);
        d[1] = mk_u2(vr[i].z, vr[i].w);
      }
      __syncthreads();
      if (kt + 1 < nkt) gload(kt + 1);
      if (kt < my_nkt) {
        f32x16 st[2];
#pragma unroll
        for (int kb2 = 0; kb2 < 2; ++kb2) {
#pragma unroll
          for (int r = 0; r < 16; ++r) st[kb2][r] = 0.f;
#pragma unroll
          for (int ks = 0; ks < 6; ++ks) {
            const bf16x8 a = *(const bf16x8*)&sm.k[kb2 * 32 + q][ks * 16 + hh * 8];
            st[kb2] = __builtin_amdgcn_mfma_f32_32x32x16_bf16(a, qf[ks], st[kb2], 0, 0, 0);
          }
        }
        float mx = st[0][0];
#pragma unroll
        for (int kb2 = 0; kb2 < 2; ++kb2)
#pragma unroll
          for (int r = 0; r < 16; ++r) mx = fmaxf(mx, st[kb2][r]);
        mx = fmaxf(mx, __shfl_xor(mx, 32, 64));
        const float mnew = fmaxf(mrun, mx);
        const float alpha = __builtin_amdgcn_exp2f(mrun - mnew);
        mrun = mnew;
        float ps = 0.f;
#pragma unroll
        for (int kb2 = 0; kb2 < 2; ++kb2)
#pragma unroll
          for (int r = 0; r < 16; ++r) {
            const float pv = __builtin_amdgcn_exp2f(st[kb2][r] - mnew);
            st[kb2][r] = pv;
            ps += pv;
          }
        lsum = lsum * alpha + ps;
#pragma unroll
        for (int vb = 0; vb < 2; ++vb)
#pragma unroll
          for (int r = 0; r < 16; ++r) ot[vb][r] *= alpha;
#pragma unroll
        for (int kb2 = 0; kb2 < 2; ++kb2)
#pragma unroll
          for (int s2 = 0; s2 < 2; ++s2) {
            bf16x8 pf;
#pragma unroll
            for (int j = 0; j < 8; ++j) pf[j] = (bf16)st[kb2][8 * s2 + j];
#pragma unroll
            for (int vb = 0; vb < 2; ++vb) {
              const bf16x4 lo = *(const bf16x4*)&sm.v[vb * 32 + q][kb2 * 32 + 16 * s2 + 4 * hh];
              const bf16x4 hi = *(const bf16x4*)&sm.v[vb * 32 + q][kb2 * 32 + 16 * s2 + 8 + 4 * hh];
              bf16x8 a;
              a[0] = lo[0]; a[1] = lo[1]; a[2] = lo[2]; a[3] = lo[3];
              a[4] = hi[0]; a[5] = hi[1]; a[6] = hi[2]; a[7] = hi[3];
              ot[vb] = __builtin_amdgcn_mfma_f32_32x32x16_bf16(a, pf, ot[vb], 0, 0, 0);
            }
          }
      }
    }
    const float ltot = lsum + __shfl_xor(lsum, 32, 64);
    const float inv = 1.f / ltot;
    const int b = bh >> 3, h = bh & 7;
    bf16* op = O + ((size_t)b * SEQ + s0 + w * 32 + q) * 512 + h * 64;
#pragma unroll
    for (int vb = 0; vb < 2; ++vb)
#pragma unroll
      for (int rg = 0; rg < 4; ++rg) {
        bf16x4 o;
        o[0] = (bf16)(ot[vb][4 * rg + 0] * inv); o[1] = (bf16)(ot[vb][4 * rg + 1] * inv);
        o[2] = (bf16)(ot[vb][4 * rg + 2] * inv); o[3] = (bf16)(ot[vb][4 * rg + 3] * inv);
        *(bf16x4*)(op + vb * 32 + 8 * rg + 4 * hh) = o;
      }
  }
}

DEVI void phase3c(const Params& p) {
  const int lane = threadIdx.x & 63;
  const int gw = blockIdx.x * 4 + (threadIdx.x >> 6), nw = gridDim.x * 4;
  const bf16* zrw = (const bf16*)(p.ws + OFF_ZRW);
  const bf16* YRAW = (const bf16*)(p.ws + OFF_YRAW);
  const bf16* G = (const bf16*)(p.ws + OFF_G);
  const float* RK = (const float*)(p.ws + OFF_RK);
  bf16* YA = (bf16*)(p.ws + OFF_YAPRE);
  const int c0 = lane * 8, head = lane >> 3;
  float gw_[8], gb_[8], mu_[8];
#pragma unroll
  for (int j = 0; j < 8; ++j) { gw_[j] = p.rw_gn_w[c0 + j]; gb_[j] = p.rw_gn_b[c0 + j]; mu_[j] = p.rw_mu[1024 + c0 + j]; }
  for (int t = gw; t < T_TOK; t += nw) {
    const int s = t & (SEQ - 1);
    const bf16x8 y8 = *(const bf16x8*)(YRAW + (size_t)t * 512 + c0);
    float y[8];
    float sm = 0.f;
#pragma unroll
    for (int j = 0; j < 8; ++j) { y[j] = (float)y8[j]; sm += y[j]; }
    const float mean = row8_allsum(sm) * (1.f / 64.f);
    float sq = 0.f;
#pragma unroll
    for (int j = 0; j < 8; ++j) { y[j] -= mean; sq += y[j] * y[j]; }
    const float var = row8_allsum(sq) * (1.f / 64.f);
    const float rstd = rsqrtf(var + 64e-5f);
    const bf16* vp = zrw + (size_t)t * RWC + 1024 + c0;
    const bf16x8 vc = *(const bf16x8*)vp;
    bf16x8 vq;
    if (s > 0) vq = *(const bf16x8*)(vp - RWC);
    else {
#pragma unroll
      for (int j = 0; j < 8; ++j) vq[j] = (bf16)0.f;
    }
    const bf16x8 g8 = *(const bf16x8*)(G + (size_t)t * 512 + c0);
    const float rk = RK[(size_t)t * 8 + head];
    bf16x8 o;
#pragma unroll
    for (int j = 0; j < 8; ++j) {
      const float vcur = (float)vc[j];
      const float vs = vcur + mu_[j] * ((float)vq[j] - vcur);
      const float yn = y[j] * rstd * gw_[j] + gb_[j];
      o[j] = (bf16)((yn + rk * vs) * (float)g8[j]);
    }
    *(bf16x8*)(YA + (size_t)t * 512 + c0) = o;
  }
}

DEVI void phase4(const Params& p, unsigned char* smem) {
  GemmSmem& sm = *(GemmSmem*)smem;
  unsigned char* ws = p.ws;
  const bf16* H1 = (const bf16*)(ws + OFF_H1);
  const bf16* WG = (const bf16*)(ws + OFF_WG_T);
  const bf16* YA = (const bf16*)(ws + OFF_YAPRE);
  const bf16* OO = (const bf16*)(ws + OFF_O);
  const bf16* RWO = (const bf16*)(ws + OFF_RWO_T);
  const bf16* MLO = (const bf16*)(ws + OFF_MLO_T);
  bf16* M = (bf16*)(ws + OFF_M);
  const int lane = threadIdx.x & 63, w = threadIdx.x >> 6;
  const int wrow0 = (w >> 1) * 64, wcol0 = (w & 1) * 64;
  for (int tile = blockIdx.x; tile < 256 * 8; tile += gridDim.x) {
    const int m0 = (tile >> 3) * 128, n0 = (tile & 7) * 128;
    unsigned pk[2][2][8];
#pragma nounroll
    for (int g = 0; g < 4; ++g) {
      const bf16* A; const bf16* Bm; int ld;
      if (g == 0) { A = YA + (size_t)m0 * 512; Bm = RWO + (size_t)n0 * 512; ld = 512; }
      else if (g == 1) { A = H1 + (size_t)m0 * DM; Bm = WG + (size_t)n0 * DM; ld = DM; }
      else if (g == 2) { A = OO + (size_t)m0 * 512; Bm = MLO + (size_t)n0 * 512; ld = 512; }
      else { A = H1 + (size_t)m0 * DM; Bm = WG + (size_t)(1024 + n0) * DM; ld = DM; }
      f32x16 acc[2][2];
      acc_zero(acc);
      gemm_mainloop<2, 2>(acc, A, ld, Bm, ld, ld, sm, wrow0, wcol0);
      if (g == 0 || g == 2) {
#pragma unroll
        for (int a = 0; a < 2; ++a)
#pragma unroll
          for (int b = 0; b < 2; ++b)
#pragma unroll
            for (int r = 0; r < 8; ++r) pk[a][b][r] = pack2(acc[a][b][2 * r], acc[a][b][2 * r + 1]);
      } else {
#pragma unroll
        for (int a = 0; a < 2; ++a)
#pragma unroll
          for (int b = 0; b < 2; ++b) {
            const int n = n0 + acc_col(wcol0, b, lane);
#pragma unroll
            for (int r = 0; r < 16; ++r) {
              const int m = m0 + acc_row(wrow0, a, r, lane);
              const unsigned u = pk[a][b][r >> 1];
              const float y = (r & 1) ? bfhi(u) : bflo(u);
              float val = y * sigmoid_f(acc[a][b][r]);
#if ABL == 2
              if (g == 3) val = 0.f;
#elif ABL == 3
              if (g == 1) val = 0.f;
#endif
              bf16* dst = M + (size_t)m * DM + n;
              if (g == 3) val += (float)(*dst);
              *dst = (bf16)val;
            }
          }
      }
    }
  }
}

DEVI void phase5(const Params& p, unsigned char* smem) {
  GemmSmem& sm = *(GemmSmem*)smem;
  const bf16* M = (const bf16*)(p.ws + OFF_M);
  const bf16* WO = (const bf16*)(p.ws + OFF_WOUT_T);
  const int lane = threadIdx.x & 63, w = threadIdx.x >> 6;
  const int wrow0 = (w >> 1) * 64, wcol0 = (w & 1) * 64;
  for (int tile = blockIdx.x; tile < 256 * 8; tile += gridDim.x) {
    const int m0 = (tile >> 3) * 128, n0 = (tile & 7) * 128;
    f32x16 acc[2][2];
    acc_zero(acc);
    gemm_mainloop<2, 2>(acc, M + (size_t)m0 * DM, DM, WO + (size_t)n0 * DM, DM, DM, sm, wrow0, wcol0);
#pragma unroll
    for (int a = 0; a < 2; ++a)
#pragma unroll
      for (int b = 0; b < 2; ++b) {
        const int n = n0 + acc_col(wcol0, b, lane);
#pragma unroll
        for (int r = 0; r < 16; ++r) {
          const int m = m0 + acc_row(wrow0, a, r, lane);
          const size_t idx = (size_t)m * DM + n;
          p.out[idx] = p.x[idx] + acc[a][b][r];
        }
      }
  }
}

DEVI unsigned pack_key(float s, int n) {
  unsigned u = __float_as_uint(s);
  u = (u & 0x80000000u) ? ~u : (u | 0x80000000u);
  return (u & 0xFFFFFF80u) | (unsigned)n;
}
DEVI float key_score(unsigned k) {
  unsigned u = k & 0xFFFFFF80u;
  u = (u & 0x80000000u) ? (u & 0x7FFFFFFFu) : ~u;
  return __uint_as_float(u);
}
template <int N> DEVI void bitonic_sort_desc(unsigned (&v)[N]) {
#pragma unroll
  for (int k = 2; k <= N; k <<= 1) {
#pragma unroll
    for (int j = k >> 1; j > 0; j >>= 1) {
#pragma unroll
      for (int i = 0; i < N; ++i) {
        const int l = i ^ j;
        if (l > i) {
          const bool desc = ((i & k) == 0);
          const unsigned a = v[i], b = v[l];
          const unsigned mx = a > b ? a : b, mn = a > b ? b : a;
          v[i] = desc ? mx : mn;
          v[l] = desc ? mn : mx;
        }
      }
    }
  }
}
template <int N> DEVI void bitonic_merge_desc(unsigned (&v)[N]) {
#pragma unroll
  for (int j = N >> 1; j > 0; j >>= 1) {
#pragma unroll
    for (int i = 0; i < N; ++i) {
      const int l = i ^ j;
      if (l > i) {
        const unsigned a = v[i], b = v[l];
        v[i] = a > b ? a : b;
        v[l] = a > b ? b : a;
      }
    }
  }
}

DEVI void phase7(const Params& p, unsigned char* smem) {
  GemmSmem& sm = *(GemmSmem*)smem;
  const bf16* H2 = (const bf16*)(p.ws + OFF_H2);
  const bf16* WQ = (const bf16*)(p.ws + OFF_WQ_T);
  const bf16* SK = (const bf16*)(p.ws + OFF_SK);
  unsigned* TOPK = (unsigned*)(p.ws + OFF_TOPK);
  const int lane = threadIdx.x & 63, w = threadIdx.x >> 6;
  const int hh = lane >> 5;
  for (int tile = blockIdx.x; tile < 256 * 16; tile += gridDim.x) {
    const int m0 = (tile >> 4) * 128, hc = tile & 15;
    f32x16 acc[4][1];
    acc_zero(acc);
    gemm_mainloop<4, 1>(acc, WQ + (size_t)(hc * 128) * DM, DM, H2 + (size_t)m0 * DM, DM, DM, sm, 0, w * 32);
    bf16x8 qf[4][2];
#pragma unroll
    for (int db = 0; db < 4; ++db)
#pragma unroll
      for (int s2 = 0; s2 < 2; ++s2)
#pragma unroll
        for (int j = 0; j < 8; ++j) qf[db][s2][j] = (bf16)acc[db][0][8 * s2 + j];
    unsigned key[64];
    const bf16* skb = SK + (size_t)hc * 128 * 128;
#pragma unroll
    for (int nb = 0; nb < 4; ++nb) {
      f32x16 sc;
#pragma unroll
      for (int r = 0; r < 16; ++r) sc[r] = 0.f;
      const bf16* rowp = skb + (size_t)(nb * 32 + (lane & 31)) * 128 + 4 * hh;
#pragma unroll
      for (int db = 0; db < 4; ++db)
#pragma unroll
        for (int s2 = 0; s2 < 2; ++s2) {
          const bf16x4 lo = *(const bf16x4*)(rowp + db * 32 + 16 * s2);
          const bf16x4 hi = *(const bf16x4*)(rowp + db * 32 + 16 * s2 + 8);
          bf16x8 a;
          a[0] = lo[0]; a[1] = lo[1]; a[2] = lo[2]; a[3] = lo[3];
          a[4] = hi[0]; a[5] = hi[1]; a[6] = hi[2]; a[7] = hi[3];
          sc = __builtin_amdgcn_mfma_f32_32x32x16_bf16(a, qf[db][s2], sc, 0, 0, 0);
        }
#pragma unroll
      for (int r = 0; r < 16; ++r) key[nb * 16 + r] = pack_key(sc[r], nb * 32 + (r & 3) + 8 * (r >> 2) + 4 * hh);
    }
    bitonic_sort_desc<64>(key);
    unsigned top[16];
#pragma unroll
    for (int i = 0; i < 16; ++i) {
      const unsigned o = (unsigned)__shfl_xor((int)key[15 - i], 32, 64);
      top[i] = key[i] > o ? key[i] : o;
    }
    bitonic_merge_desc<16>(top);
    if (hh == 0) {
      const int t = m0 + w * 32 + (lane & 31);
      u32x4* dst = (u32x4*)(TOPK + ((size_t)t * 16 + hc) * 16);
      dst[0] = mk_u4(top[0], top[1], top[2], top[3]);
      dst[1] = mk_u4(top[4], top[5], top[6], top[7]);
      dst[2] = mk_u4(top[8], top[9], top[10], top[11]);
      dst[3] = mk_u4(top[12], top[13], top[14], top[15]);
    }
  }
}

DEVI void phase7b(const Params& p, unsigned char* smem) {
  unsigned* ka = (unsigned*)smem;
  unsigned* kb = ka + 16 * 256;
  const unsigned* TOPK = (const unsigned*)(p.ws + OFF_TOPK);
  int* IDX = (int*)(p.ws + OFF_IDX);
  float* GATE = (float*)(p.ws + OFF_GATE);
  const int tid = threadIdx.x;
  for (int grp = blockIdx.x; grp < (T_TOK * 8) / NTHREADS; grp += gridDim.x) {
    const int item = grp * NTHREADS + tid;
    const u32x4* src = (const u32x4*)(TOPK + (size_t)item * 32);
#pragma unroll
    for (int i = 0; i < 4; ++i) {
      const u32x4 va = src[i], vb = src[4 + i];
      ka[(4 * i + 0) * 256 + tid] = va.x; ka[(4 * i + 1) * 256 + tid] = va.y;
      ka[(4 * i + 2) * 256 + tid] = va.z; ka[(4 * i + 3) * 256 + tid] = va.w;
      kb[(4 * i + 0) * 256 + tid] = vb.x; kb[(4 * i + 1) * 256 + tid] = vb.y;
      kb[(4 * i + 2) * 256 + tid] = vb.z; kb[(4 * i + 3) * 256 + tid] = vb.w;
    }
    unsigned long long jp = 0ull;
    float sc[16];
    int ex[16];
#pragma unroll
    for (int r = 0; r < 16; ++r) {
      float best = -3.0e38f;
      int bi = 0, bj = 0;
      for (int i = 0; i < 16; ++i) {
        const int ji = (int)((jp >> (4 * i)) & 15ull);
        const float cand = key_score(ka[i * 256 + tid]) + key_score(kb[ji * 256 + tid]);
        if (cand > best) { best = cand; bi = i; bj = ji; }
      }
      sc[r] = best;
      ex[r] = (int)(ka[bi * 256 + tid] & 127u) * 128 + (int)(kb[bj * 256 + tid] & 127u);
      jp += 1ull << (4 * bi);
    }
    float den = 0.f;
    const float smax = sc[0];
#pragma unroll
    for (int r = 0; r < 16; ++r) { sc[r] = __expf(sc[r] - smax); den += sc[r]; }
    const float inv = 1.f / den;
    i32x4* di = (i32x4*)(IDX + (size_t)item * 16);
    f32x4* dg = (f32x4*)(GATE + (size_t)item * 16);
#pragma unroll
    for (int i = 0; i < 4; ++i) {
      di[i] = mk_i4(ex[4 * i], ex[4 * i + 1], ex[4 * i + 2], ex[4 * i + 3]);
      dg[i] = mk_f4(sc[4 * i] * inv, sc[4 * i + 1] * inv, sc[4 * i + 2] * inv, sc[4 * i + 3] * inv);
    }
  }
}

DEVI void phase8(const Params& p) {
  const int lane = threadIdx.x & 63;
  const int gw = blockIdx.x * 4 + (threadIdx.x >> 6), nw = gridDim.x * 4;
  const bf16* H2 = (const bf16*)(p.ws + OFF_H2);
  const bf16* U = (const bf16*)(p.ws + OFF_UBF);
  const bf16* V = (const bf16*)(p.ws + OFF_VBF);
  const int* IDX = (const int*)(p.ws + OFF_IDX);
  const float* GATE = (const float*)(p.ws + OFF_GATE);
  bf16* H3 = (bf16*)(p.ws + OFF_H3);
  const int g = lane >> 4, j = lane & 15;
  float gpl[16];
#pragma unroll
  for (int i = 0; i < 8; ++i) { gpl[i] = p.norm_ple[lane * 8 + i]; gpl[8 + i] = p.norm_ple[512 + lane * 8 + i]; }
  for (int t = gw; t < T_TOK; t += nw) {
    u32x4 hq[8];
#pragma unroll
    for (int i = 0; i < 8; ++i) hq[i] = *(const u32x4*)(H2 + (size_t)t * DM + i * 128 + j * 8);
    float acc[16];
#pragma unroll
    for (int i = 0; i < 16; ++i) acc[i] = 0.f;
#if ABL == 1
    for (int it = 0; it < 0; ++it) {
#else
    for (int it = 0; it < 32; ++it) {
#endif
      const int e = IDX[(size_t)t * 128 + it * 4 + g];
      const float gt = GATE[(size_t)t * 128 + it * 4 + g];
      const bf16* up = U + (size_t)e * DM + j * 8;
      u32x4 uq[8];
#pragma unroll
      for (int i = 0; i < 8; ++i) uq[i] = *(const u32x4*)(up + i * 128);
      const int e0 = __builtin_amdgcn_readlane(e, 0), e1 = __builtin_amdgcn_readlane(e, 16),
                e2 = __builtin_amdgcn_readlane(e, 32), e3 = __builtin_amdgcn_readlane(e, 48);
      u32x4 vq[4][2];
      {
        const bf16* v0 = V + (size_t)e0 * DM + lane * 8; vq[0][0] = *(const u32x4*)v0; vq[0][1] = *(const u32x4*)(v0 + 512);
        const bf16* v1 = V + (size_t)e1 * DM + lane * 8; vq[1][0] = *(const u32x4*)v1; vq[1][1] = *(const u32x4*)(v1 + 512);
        const bf16* v2 = V + (size_t)e2 * DM + lane * 8; vq[2][0] = *(const u32x4*)v2; vq[2][1] = *(const u32x4*)(v2 + 512);
        const bf16* v3 = V + (size_t)e3 * DM + lane * 8; vq[3][0] = *(const u32x4*)v3; vq[3][1] = *(const u32x4*)(v3 + 512);
      }
      float d0 = 0.f, d1 = 0.f, d2 = 0.f, d3 = 0.f;
#pragma unroll
      for (int i = 0; i < 8; ++i) {
        d0 = dot2bf(hq[i].x, uq[i].x, d0);
        d1 = dot2bf(hq[i].y, uq[i].y, d1);
        d2 = dot2bf(hq[i].z, uq[i].z, d2);
        d3 = dot2bf(hq[i].w, uq[i].w, d3);
      }
      float d = (d0 + d1) + (d2 + d3);
      d = row16_allsum(d);
      const float act = 0.5f * d * (1.f + erff(d * 0.70710678f));
      const float cf = gt * act;
      float c[4];
      const int cfi = __float_as_int(cf);
      c[0] = __int_as_float(__builtin_amdgcn_readlane(cfi, 0)); c[1] = __int_as_float(__builtin_amdgcn_readlane(cfi, 16));
      c[2] = __int_as_float(__builtin_amdgcn_readlane(cfi, 32)); c[3] = __int_as_float(__builtin_amdgcn_readlane(cfi, 48));
#pragma unroll
      for (int qd = 0; qd < 4; ++qd) {
        const float cc = c[qd];
        const u32x4 a = vq[qd][0], b = vq[qd][1];
        acc[0] += cc * bflo(a.x); acc[1] += cc * bfhi(a.x); acc[2] += cc * bflo(a.y); acc[3] += cc * bfhi(a.y);
        acc[4] += cc * bflo(a.z); acc[5] += cc * bfhi(a.z); acc[6] += cc * bflo(a.w); acc[7] += cc * bfhi(a.w);
        acc[8] += cc * bflo(b.x); acc[9] += cc * bfhi(b.x); acc[10] += cc * bflo(b.y); acc[11] += cc * bfhi(b.y);
        acc[12] += cc * bflo(b.z); acc[13] += cc * bfhi(b.z); acc[14] += cc * bflo(b.w); acc[15] += cc * bfhi(b.w);
      }
    }
    float* xo = p.out + (size_t)t * DM;
    f32x4 x0 = *(f32x4*)(xo + lane * 8), x1 = *(f32x4*)(xo + lane * 8 + 4);
    f32x4 x2 = *(f32x4*)(xo + 512 + lane * 8), x3 = *(f32x4*)(xo + 512 + lane * 8 + 4);
    x0.x += acc[0]; x0.y += acc[1]; x0.z += acc[2]; x0.w += acc[3];
    x1.x += acc[4]; x1.y += acc[5]; x1.z += acc[6]; x1.w += acc[7];
    x2.x += acc[8]; x2.y += acc[9]; x2.z += acc[10]; x2.w += acc[11];
    x3.x += acc[12]; x3.y += acc[13]; x3.z += acc[14]; x3.w += acc[15];
    *(f32x4*)(xo + lane * 8) = x0; *(f32x4*)(xo + lane * 8 + 4) = x1;
    *(f32x4*)(xo + 512 + lane * 8) = x2; *(f32x4*)(xo + 512 + lane * 8 + 4) = x3;
    float ss = x0.x * x0.x + x0.y * x0.y + x0.z * x0.z + x0.w * x0.w + x1.x * x1.x + x1.y * x1.y + x1.z * x1.z + x1.w * x1.w +
               x2.x * x2.x + x2.y * x2.y + x2.z * x2.z + x2.w * x2.w + x3.x * x3.x + x3.y * x3.y + x3.z * x3.z + x3.w * x3.w;
    ss = wave_sum(ss);
    const float rs = rsqrtf(ss * (1.f / DM) + 1e-6f);
    bf16x8 o0, o1;
    o0[0] = (bf16)(x0.x * rs * gpl[0]); o0[1] = (bf16)(x0.y * rs * gpl[1]); o0[2] = (bf16)(x0.z * rs * gpl[2]); o0[3] = (bf16)(x0.w * rs * gpl[3]);
    o0[4] = (bf16)(x1.x * rs * gpl[4]); o0[5] = (bf16)(x1.y * rs * gpl[5]); o0[6] = (bf16)(x1.z * rs * gpl[6]); o0[7] = (bf16)(x1.w * rs * gpl[7]);
    o1[0] = (bf16)(x2.x * rs * gpl[8]); o1[1] = (bf16)(x2.y * rs * gpl[9]); o1[2] = (bf16)(x2.z * rs * gpl[10]); o1[3] = (bf16)(x2.w * rs * gpl[11]);
    o1[4] = (bf16)(x3.x * rs * gpl[12]); o1[5] = (bf16)(x3.y * rs * gpl[13]); o1[6] = (bf16)(x3.z * rs * gpl[14]); o1[7] = (bf16)(x3.w * rs * gpl[15]);
    *(bf16x8*)(H3 + (size_t)t * DM + lane * 8) = o0;
    *(bf16x8*)(H3 + (size_t)t * DM + 512 + lane * 8) = o1;
  }
}

DEVI void phase10(const Params& p, unsigned char* smem) {
  GemmSmem& sm = *(GemmSmem*)smem;
  const bf16* H3 = (const bf16*)(p.ws + OFF_H3);
  const bf16* PG = (const bf16*)(p.ws + OFF_PG_T);
  const bf16* PB = (const bf16*)(p.ws + OFF_PBF);
  const bf16* PP = (const bf16*)(p.ws + OFF_PP_T);
  const int lane = threadIdx.x & 63, w = threadIdx.x >> 6;
  const int wrow0 = (w >> 1) * 64, wcol0 = (w & 1) * 64;
  for (int tile = blockIdx.x; tile < 256 * 8; tile += gridDim.x) {
    const int m0 = (tile >> 3) * 128, n0 = (tile & 7) * 128;
    unsigned pk[2][2][8];
    {
      f32x16 acc2[2][2];
      acc_zero(acc2);
      gemm_mainloop<2, 2>(acc2, PB + (size_t)m0 * 256, 256, PP + (size_t)n0 * 256, 256, 256, sm, wrow0, wcol0);
#pragma unroll
      for (int a = 0; a < 2; ++a)
#pragma unroll
        for (int b = 0; b < 2; ++b)
#pragma unroll
          for (int r = 0; r < 8; ++r) pk[a][b][r] = pack2(acc2[a][b][2 * r], acc2[a][b][2 * r + 1]);
    }
    f32x16 acc[2][2];
    acc_zero(acc);
    gemm_mainloop<2, 2>(acc, H3 + (size_t)m0 * DM, DM, PG + (size_t)n0 * DM, DM, DM, sm, wrow0, wcol0);
#pragma unroll
    for (int a = 0; a < 2; ++a)
#pragma unroll
      for (int b = 0; b < 2; ++b) {
        const int n = n0 + acc_col(wcol0, b, lane);
#pragma unroll
        for (int r = 0; r < 16; ++r) {
          const int m = m0 + acc_row(wrow0, a, r, lane);
          const size_t idx = (size_t)m * DM + n;
          const unsigned u = pk[a][b][r >> 1];
          const float pp = (r & 1) ? bfhi(u) : bflo(u);
          p.out[idx] = p.out[idx] + sigmoid_f(acc[a][b][r]) * pp;
        }
      }
  }
}

DEVI void phase11(const Params& p) {
  const int lane = threadIdx.x & 63;
  const int gw = blockIdx.x * 4 + (threadIdx.x >> 6), nw = gridDim.x * 4;
  f32x4 gn[4];
#pragma unroll
  for (int i = 0; i < 4; ++i) gn[i] = *(const f32x4*)(p.norm_final + i * 256 + lane * 4);
  for (int t = gw; t < T_TOK; t += nw) {
    float* xr = p.out + (size_t)t * DM;
    f32x4 v[4];
    float ss = 0.f;
#pragma unroll
    for (int i = 0; i < 4; ++i) {
      v[i] = *(const f32x4*)(xr + i * 256 + lane * 4);
      ss += v[i].x * v[i].x + v[i].y * v[i].y + v[i].z * v[i].z + v[i].w * v[i].w;
    }
    ss = wave_sum(ss);
    const float rs = rsqrtf(ss * (1.f / DM) + 1e-6f);
#pragma unroll
    for (int i = 0; i < 4; ++i) {
      f32x4 o;
      o.x = v[i].x * rs * gn[i].x; o.y = v[i].y * rs * gn[i].y; o.z = v[i].z * rs * gn[i].z; o.w = v[i].w * rs * gn[i].w;
      *(f32x4*)(xr + i * 256 + lane * 4) = o;
    }
  }
}

constexpr int N_PHASES = 15;
__global__ void __launch_bounds__(NTHREADS, 2) hybrid_block_kernel(Params p, int ph0, int ph1) {
  __shared__ __attribute__((aligned(16))) unsigned char smem[49152];
  cg::grid_group grid = cg::this_grid();
#define RUN_PHASE(K, CALL) if (ph0 <= (K) && (K) < ph1) { CALL; if ((K) + 1 < ph1) grid.sync(); }
  RUN_PHASE(0, phase0(p, smem))
  RUN_PHASE(1, phase1(p, smem))
  RUN_PHASE(2, phase2a(p))
  RUN_PHASE(3, phase2b(p, smem))
  RUN_PHASE(4, phase3a(p, smem))
  RUN_PHASE(5, phase3b(p, smem))
  RUN_PHASE(6, phase3c(p))
  RUN_PHASE(7, phase4(p, smem))
  RUN_PHASE(8, phase5(p, smem))
  RUN_PHASE(9, rmsnorm_rows_bf16(p.out, p.norm_ffn, (bf16*)(p.ws + OFF_H2)))
  RUN_PHASE(10, phase7(p, smem))
  RUN_PHASE(11, phase7b(p, smem))
  RUN_PHASE(12, phase8(p))
  RUN_PHASE(13, phase10(p, smem))
  RUN_PHASE(14, phase11(p))
#undef RUN_PHASE
}

extern "C" void kernel_launch(void* const* d_in, const int* in_sizes, int n_in, void* d_out, int out_size, void* d_ws,
                              size_t ws_size, hipStream_t stream) {
  static int grid_blocks = 0;
  if (!grid_blocks) {
    int dev = 0, cus = 0, per_cu = 0;
    hipGetDevice(&dev);
    hipDeviceGetAttribute(&cus, hipDeviceAttributeMultiprocessorCount, dev);
    hipOccupancyMaxActiveBlocksPerMultiprocessor(&per_cu, hybrid_block_kernel, NTHREADS, 0);
    if (per_cu > 2) per_cu = 2;
    if (per_cu < 1) per_cu = 1;
    grid_blocks = cus * per_cu;
  }
  Params p{};
  const float** fp = (const float**)&p;
  for (int i = 0; i < 32; ++i) fp[i] = (const float*)d_in[i];
  p.pos = (const int*)d_in[2];
  p.out = (float*)d_out;
  p.ws = (unsigned char*)d_ws;
#ifndef MULTI_LAUNCH
  int ph0 = 0, ph1 = N_PHASES;
  void* args[] = {&p, &ph0, &ph1};
  hipError_t e = hipLaunchCooperativeKernel((void*)hybrid_block_kernel, dim3(grid_blocks), dim3(NTHREADS), args, 0, stream);
  if (e != hipSuccess) fprintf(stderr, "cooperative launch failed: %s (grid %d)\n", hipGetErrorString(e), grid_blocks);
#else
  for (int ph = 0; ph < N_PHASES; ++ph)
    hipLaunchKernelGGL(hybrid_block_kernel, dim3(grid_blocks), dim3(NTHREADS), 0, stream, p, ph, ph + 1);
#endif
}
```

```cpp
#include <hip/hip_runtime.h>
#include <hip/hip_cooperative_groups.h>
#include <stdint.h>
#include <stdio.h>
namespace cg = cooperative_groups;

typedef __bf16 bf16;
typedef __attribute__((ext_vector_type(8))) __bf16 bf16x8;
typedef __attribute__((ext_vector_type(4))) __bf16 bf16x4;
typedef __attribute__((ext_vector_type(2))) __bf16 bf16x2;
typedef __attribute__((ext_vector_type(16))) float f32x16;
typedef __attribute__((ext_vector_type(4))) float f32x4;
typedef __attribute__((ext_vector_type(2))) float f32x2;
typedef __attribute__((ext_vector_type(4))) unsigned u32x4;
typedef __attribute__((ext_vector_type(2))) unsigned u32x2;
typedef __attribute__((ext_vector_type(4))) int i32x4;

#define DEVI __device__ __forceinline__
#ifndef ABL
#define ABL 0
#endif

constexpr int T_TOK = 32768;
constexpr int SEQ = 4096;
constexpr int DM = 1024;
constexpr int IN_COLS = 4512;
constexpr int RWC = 1792;
constexpr int MLC = 672;
constexpr int NTHREADS = 256;

constexpr size_t MiB = 1ull << 20;
constexpr size_t OFF_WIN_T = 0;
constexpr size_t OFF_WG_T = 5 * MiB;
constexpr size_t OFF_W2_T = 9 * MiB;
constexpr size_t OFF_A2_T = 9 * MiB + 65536;
constexpr size_t OFF_G2_T = 9 * MiB + 131072;
constexpr size_t OFF_RWO_T = 10 * MiB;
constexpr size_t OFF_MLO_T = 11 * MiB;
constexpr size_t OFF_WUQ_T = 12 * MiB;
constexpr size_t OFF_WUKV_T = 13 * MiB;
constexpr size_t OFF_PP_T = 13 * MiB + 524288;
constexpr size_t OFF_WOUT_T = 14 * MiB;
constexpr size_t OFF_PG_T = 16 * MiB;
constexpr size_t OFF_WQ_T = 18 * MiB;
constexpr size_t OFF_SK = 22 * MiB;
constexpr size_t OFF_CNT = 22 * MiB + 524288;
constexpr size_t OFF_BAR = 22 * MiB + 524288 + 65536;
constexpr size_t OFF_CS = 23 * MiB;
constexpr size_t OFF_SN = 25 * MiB;
constexpr size_t OFF_RK = 27 * MiB;
constexpr size_t OFF_PBF = 28 * MiB;
constexpr size_t OFF_U8 = 44 * MiB;
constexpr size_t OFF_V8 = 60 * MiB;
constexpr size_t OFF_IUS = 76 * MiB;
constexpr size_t OFF_IVS = 76 * MiB + 65536;
constexpr size_t OFF_H1 = 108 * MiB;
constexpr size_t OFF_ZRW = 172 * MiB;
constexpr size_t OFF_ZMLA = 284 * MiB;
constexpr size_t OFF_LORA = 326 * MiB;
constexpr size_t OFF_CQ = 342 * MiB;
constexpr size_t OFF_CKV = 366 * MiB;
constexpr size_t OFF_E = 382 * MiB;
constexpr size_t OFF_ICLR = 446 * MiB;
constexpr size_t OFF_G = 478 * MiB;
constexpr size_t OFF_O = 284 * MiB;
constexpr size_t OFF_YRAW = 326 * MiB;
constexpr size_t OFF_YAPRE = 358 * MiB;
constexpr size_t OFF_M = 172 * MiB;
constexpr size_t OFF_H2 = 382 * MiB;
constexpr size_t OFF_TOPK = 236 * MiB;
constexpr size_t OFF_IDX = 446 * MiB;
constexpr size_t OFF_GATE = 462 * MiB;
constexpr size_t OFF_H3 = 172 * MiB;
constexpr size_t OFF_Q = 0;
constexpr size_t OFF_K = 48 * MiB;
constexpr size_t OFF_VT = 96 * MiB;

struct Params {
  const float* x; const float* p; const int* pos; const float* norm_mix; const float* w_in; const float* rw_mu;
  const float* rw_w0; const float* rw_w2; const float* rw_a0; const float* rw_a2; const float* rw_g2; const float* rw_k_k;
  const float* rw_k_a; const float* rw_r_k; const float* rw_gn_w; const float* rw_gn_b; const float* rw_w_o;
  const float* mla_q_norm; const float* mla_w_uq; const float* mla_kv_norm; const float* mla_w_ukv; const float* mla_w_o;
  const float* w_out; const float* norm_ffn; const float* peer_w_q; const float* peer_sub_keys; const float* peer_u;
  const float* peer_v; const float* norm_ple; const float* ple_w_gate; const float* ple_w_proj; const float* norm_final;
  float* out; unsigned char* ws;
};

DEVI u32x4 mk_u4(unsigned a, unsigned b, unsigned c, unsigned d) { u32x4 v; v.x = a; v.y = b; v.z = c; v.w = d; return v; }
DEVI u32x2 mk_u2(unsigned a, unsigned b) { u32x2 v; v.x = a; v.y = b; return v; }
DEVI f32x4 mk_f4(float a, float b, float c, float d) { f32x4 v; v.x = a; v.y = b; v.z = c; v.w = d; return v; }
DEVI i32x4 mk_i4(int a, int b, int c, int d) { i32x4 v; v.x = a; v.y = b; v.z = c; v.w = d; return v; }
DEVI float wave_sum(float v) {
#pragma unroll
  for (int o = 32; o > 0; o >>= 1) v += __shfl_xor(v, o, 64);
  return v;
}
template <int CTRL> DEVI float dpp_f(float v) {
  return __int_as_float(__builtin_amdgcn_update_dpp(0, __float_as_int(v), CTRL, 0xf, 0xf, true));
}
DEVI float row16_allsum(float v) {
  v += dpp_f<0xB1>(v);
  v += dpp_f<0x4E>(v);
  v += dpp_f<0x141>(v);
  v += dpp_f<0x140>(v);
  return v;
}
DEVI float row8_allsum(float v) {
  v += dpp_f<0xB1>(v);
  v += dpp_f<0x4E>(v);
  v += dpp_f<0x141>(v);
  return v;
}
DEVI float sigmoid_f(float x) { return 1.f / (1.f + __expf(-x)); }
DEVI float bflo(unsigned u) { return __uint_as_float(u << 16); }
DEVI float bfhi(unsigned u) { return __uint_as_float(u & 0xffff0000u); }
DEVI unsigned pack2(float a, float b) {
  bf16x2 v; v[0] = (bf16)a; v[1] = (bf16)b;
  return __builtin_bit_cast(unsigned, v);
}
DEVI float dot2bf(unsigned a, unsigned b, float c) {
  return __builtin_amdgcn_fdot2_f32_bf16(__builtin_bit_cast(bf16x2, a), __builtin_bit_cast(bf16x2, b), c, false);
}


#define XB_TMO      128
#define XB_XCNT(j)  (256  + 64 * (j))
#define XB_XSUB(j)  (1280 + 64 * (j))
#define XB_XGEN(j)  (2304 + 64 * (j))
#define XB_TOP      3328
#define XB_TOPGEN   3392
#define XCD_BAR_WORDS 3456
#define XB_SPIN_CAP (1u << 22)
#define LAS __attribute__((address_space(3)))
DEVI unsigned xb_ld(unsigned* p) { return __hip_atomic_load(p, __ATOMIC_RELAXED, __HIP_MEMORY_SCOPE_AGENT); }
DEVI unsigned xb_add(unsigned* p, unsigned v) { return __hip_atomic_fetch_add(p, v, __ATOMIC_RELAXED, __HIP_MEMORY_SCOPE_AGENT); }
DEVI unsigned xb_xcc_id() { return (unsigned)__builtin_amdgcn_s_getreg((3 << 11) | 20) & 0xFu; }
#define XB_SPIN(cond, bar) do { unsigned _sp = 0; while (cond) { __builtin_amdgcn_s_sleep(1); \
    if ((++_sp & 255u) == 0u) { if (xb_ld(&(bar)[XB_TMO])) break; if (_sp > XB_SPIN_CAP) { atomicAdd(&(bar)[XB_TMO], 1u); break; } } } } while (0)
struct XcdBarrier { unsigned* bar; unsigned x; volatile LAS unsigned* st; };
DEVI XcdBarrier xcd_barrier_post(unsigned* bar, volatile LAS unsigned* st) {
  XcdBarrier b; b.bar = bar; b.x = xb_xcc_id(); b.st = st;
  if (threadIdx.x == 0) (void)xb_add(&bar[XB_XCNT(b.x)], 1u);
  return b;
}
DEVI void xcd_barrier_complete(unsigned* bar, unsigned x, unsigned& nloc, unsigned& nx) {
  const unsigned G = gridDim.x * gridDim.y * gridDim.z;
  unsigned sum, cnt, mine, sp = 0u;
  for (;;) {
    sum = 0u; cnt = 0u; mine = 0u;
#pragma unroll
    for (unsigned j = 0; j < 16; ++j) { const unsigned c = xb_ld(&bar[XB_XCNT(j)]); sum += c; cnt += (c > 0u) ? 1u : 0u; mine = (j == x) ? c : mine; }
    if (sum == G) break;
    __builtin_amdgcn_s_sleep(1);
    if ((++sp & 255u) == 0u) { if (xb_ld(&bar[XB_TMO])) break; if (sp > XB_SPIN_CAP) { atomicAdd(&bar[XB_TMO], 1u); break; } }
  }
  nloc = mine > 0u ? mine : 1u; nx = cnt > 0u ? cnt : 1u;
}
DEVI void xcd_barrier(const XcdBarrier& b) {
  asm volatile("s_waitcnt vmcnt(0)" ::: "memory");
  __syncthreads();
  if (threadIdx.x == 0) {
    unsigned* bar = b.bar;
    __builtin_amdgcn_s_waitcnt(0);
    unsigned nloc = b.st[0], nx = b.st[1];
    if (nloc == 0u) { xcd_barrier_complete(bar, b.x, nloc, nx); b.st[0] = nloc; b.st[1] = nx; }
    const unsigned old = xb_add(&bar[XB_XSUB(b.x)], 1u);
    const unsigned gen = old / nloc;
    if (old + 1u == (gen + 1u) * nloc) {
      __builtin_amdgcn_fence(__ATOMIC_RELEASE, "agent");
      asm volatile("s_waitcnt vmcnt(0)" ::: "memory");
      const unsigned og = xb_add(&bar[XB_TOP], 1u);
      const unsigned tg = og / nx;
      if (og + 1u == (tg + 1u) * nx) xb_add(&bar[XB_TOPGEN], 1u);
      else XB_SPIN(xb_ld(&bar[XB_TOPGEN]) == tg, bar);
      __builtin_amdgcn_fence(__ATOMIC_ACQUIRE, "agent");
      xb_add(&bar[XB_XGEN(b.x)], 1u);
      asm volatile("s_waitcnt vmcnt(0)" ::: "memory");
    } else {
      XB_SPIN(xb_ld(&bar[XB_XGEN(b.x)]) == gen, bar);
      __builtin_amdgcn_fence(__ATOMIC_ACQUIRE, "agent");
      asm volatile("s_waitcnt vmcnt(0)" ::: "memory");
    }
  }
  __syncthreads();
}

struct GemmSmem { bf16 a[128][72]; bf16 b[128][72]; };

template <int MT, int NT>
DEVI void gemm_mainloop(f32x16 (&acc)[MT][NT], const bf16* __restrict__ A, int lda, const bf16* __restrict__ B, int ldb,
                        int K, GemmSmem& sm, int wrow0, int wcol0) {
  const int tid = threadIdx.x, lane = tid & 63;
  const int lr = tid >> 3, lc = (tid & 7) * 8;
  u32x4 ra[4], rb[4];
  const bf16* ap = A + (size_t)lr * lda + lc;
  const bf16* bp = B + (size_t)lr * ldb + lc;
#pragma unroll
  for (int i = 0; i < 4; ++i) {
    ra[i] = *(const u32x4*)(ap + (size_t)(32 * i) * lda);
    rb[i] = *(const u32x4*)(bp + (size_t)(32 * i) * ldb);
  }
  const int fr = lane & 31, fk = (lane >> 5) * 8;
  for (int k0 = 0; k0 < K; k0 += 64) {
    __syncthreads();
#pragma unroll
    for (int i = 0; i < 4; ++i) {
      *(u32x4*)&sm.a[lr + 32 * i][lc] = ra[i];
      *(u32x4*)&sm.b[lr + 32 * i][lc] = rb[i];
    }
    __syncthreads();
    if (k0 + 64 < K) {
#pragma unroll
      for (int i = 0; i < 4; ++i) {
        ra[i] = *(const u32x4*)(ap + (size_t)(32 * i) * lda + k0 + 64);
        rb[i] = *(const u32x4*)(bp + (size_t)(32 * i) * ldb + k0 + 64);
      }
    }
#pragma unroll
    for (int ks = 0; ks < 4; ++ks) {
      bf16x8 af[MT], bfr[NT];
#pragma unroll
      for (int mt = 0; mt < MT; ++mt) af[mt] = *(const bf16x8*)&sm.a[wrow0 + mt * 32 + fr][ks * 16 + fk];
#pragma unroll
      for (int nt = 0; nt < NT; ++nt) bfr[nt] = *(const bf16x8*)&sm.b[wcol0 + nt * 32 + fr][ks * 16 + fk];
#pragma unroll
      for (int mt = 0; mt < MT; ++mt)
#pragma unroll
        for (int nt = 0; nt < NT; ++nt)
          acc[mt][nt] = __builtin_amdgcn_mfma_f32_32x32x16_bf16(af[mt], bfr[nt], acc[mt][nt], 0, 0, 0);
    }
  }
}

template <int MT, int NT> DEVI void acc_zero(f32x16 (&acc)[MT][NT]) {
#pragma unroll
  for (int mt = 0; mt < MT; ++mt)
#pragma unroll
    for (int nt = 0; nt < NT; ++nt)
#pragma unroll
      for (int r = 0; r < 16; ++r) acc[mt][nt][r] = 0.f;
}

DEVI int acc_row(int wrow0, int mt, int r, int lane) { return wrow0 + mt * 32 + (r & 3) + 8 * (r >> 2) + 4 * (lane >> 5); }
DEVI int acc_col(int wcol0, int nt, int lane) { return wcol0 + nt * 32 + (lane & 31); }

DEVI void transpose_tile(const float* __restrict__ src, int ld, int n0, int nvalid, int K, bf16* __restrict__ dst, int tile,
                         float* sm) {
  const int ktiles = K >> 6;
  const int nb = (tile / ktiles) << 6, kb = (tile % ktiles) << 6;
  const int tid = threadIdx.x;
  const int ty = tid >> 4, tx = tid & 15;
#pragma unroll
  for (int i = 0; i < 4; ++i) {
    const int k = kb + ty + 16 * i, n = nb + tx * 4;
    f32x4 v = mk_f4(0.f, 0.f, 0.f, 0.f);
    if (n < nvalid) v = *(const f32x4*)(src + (size_t)k * ld + n0 + n);
    float* s = sm + (ty + 16 * i) * 65 + tx * 4;
    s[0] = v.x; s[1] = v.y; s[2] = v.z; s[3] = v.w;
  }
  __syncthreads();
  const int n = tid >> 2, kq = tid & 3;
  bf16x8 o0, o1;
#pragma unroll
  for (int j = 0; j < 8; ++j) {
    o0[j] = (bf16)sm[(kq * 16 + j) * 65 + n];
    o1[j] = (bf16)sm[(kq * 16 + 8 + j) * 65 + n];
  }
  bf16* d = dst + (size_t)(nb + n) * K + kb + kq * 16;
  *(bf16x8*)d = o0;
  *(bf16x8*)(d + 8) = o1;
  __syncthreads();
}

DEVI void convert_job(const float* __restrict__ src, bf16* __restrict__ dst, size_t n) {
  const size_t n4 = n >> 2;
  for (size_t i = (size_t)blockIdx.x * NTHREADS + threadIdx.x; i < n4; i += (size_t)gridDim.x * NTHREADS) {
    const f32x4 v = ((const f32x4*)src)[i];
    bf16x4 o; o[0] = (bf16)v.x; o[1] = (bf16)v.y; o[2] = (bf16)v.z; o[3] = (bf16)v.w;
    ((bf16x4*)dst)[i] = o;
  }
}


DEVI void fp8_rows_job(const float* __restrict__ src, unsigned char* __restrict__ dst, float* __restrict__ inv) {
  const int lane = threadIdx.x & 63;
  const int gw = blockIdx.x * 4 + (threadIdx.x >> 6), nw = gridDim.x * 4;
  for (int r = gw; r < 16384; r += nw) {
    const float* sp = src + (size_t)r * 1024 + lane * 16;
    f32x4 v[4];
    float mx = 0.f;
#pragma unroll
    for (int i = 0; i < 4; ++i) {
      v[i] = *(const f32x4*)(sp + i * 4);
      mx = fmaxf(mx, fmaxf(fmaxf(fabsf(v[i].x), fabsf(v[i].y)), fmaxf(fabsf(v[i].z), fabsf(v[i].w))));
    }
#pragma unroll
    for (int o = 32; o > 0; o >>= 1) mx = fmaxf(mx, __shfl_xor(mx, o, 64));
    const float sc = (mx > 0.f) ? 224.f / mx : 1.f;
    u32x4 o4;
#pragma unroll
    for (int i = 0; i < 4; ++i) {
      int w = 0;
      w = __builtin_amdgcn_cvt_pk_fp8_f32(v[i].x * sc, v[i].y * sc, w, false);
      w = __builtin_amdgcn_cvt_pk_fp8_f32(v[i].z * sc, v[i].w * sc, w, true);
      o4[i] = (unsigned)w;
    }
    *(u32x4*)(dst + (size_t)r * 1024 + lane * 16) = o4;
    if (lane == 0) inv[r] = 1.f / sc;
  }
}

DEVI void rmsnorm_rows_bf16(const float* src, const float* __restrict__ gain, bf16* __restrict__ dst) {
  const int lane = threadIdx.x & 63;
  const int gw = blockIdx.x * 4 + (threadIdx.x >> 6), nw = gridDim.x * 4;
  f32x4 gn[4];
#pragma unroll
  for (int i = 0; i < 4; ++i) gn[i] = *(const f32x4*)(gain + i * 256 + lane * 4);
  for (int t = gw; t < T_TOK; t += nw) {
    const float* xr = src + (size_t)t * DM;
    f32x4 v[4];
    float ss = 0.f;
#pragma unroll
    for (int i = 0; i < 4; ++i) {
      v[i] = *(const f32x4*)(xr + i * 256 + lane * 4);
      ss += v[i].x * v[i].x + v[i].y * v[i].y + v[i].z * v[i].z + v[i].w * v[i].w;
    }
    ss = wave_sum(ss);
    const float rs = rsqrtf(ss * (1.f / DM) + 1e-6f);
#pragma unroll
    for (int i = 0; i < 4; ++i) {
      bf16x4 o;
      o[0] = (bf16)(v[i].x * rs * gn[i].x); o[1] = (bf16)(v[i].y * rs * gn[i].y);
      o[2] = (bf16)(v[i].z * rs * gn[i].z); o[3] = (bf16)(v[i].w * rs * gn[i].w);
      *(bf16x4*)(dst + (size_t)t * DM + i * 256 + lane * 4) = o;
    }
  }
}

DEVI void phase0(const Params& p, unsigned char* smem) {
  unsigned char* ws = p.ws;
  float* smf = (float*)smem;
#define TJOB(SRC, LD, N0, NVALID, NPAD, KK, OFF)                                              \
  for (int tile = blockIdx.x; tile < ((NPAD) >> 6) * ((KK) >> 6); tile += gridDim.x)         \
    transpose_tile((SRC), (LD), (N0), (NVALID), (KK), (bf16*)(ws + (OFF)), tile, smf);
  TJOB(p.w_in, IN_COLS, 0, 2464, 2560, 1024, OFF_WIN_T)
  TJOB(p.w_in, IN_COLS, 2464, 2048, 2048, 1024, OFF_WG_T)
  TJOB(p.rw_w2, 512, 0, 512, 512, 64, OFF_W2_T)
  TJOB(p.rw_a2, 512, 0, 512, 512, 64, OFF_A2_T)
  TJOB(p.rw_g2, 512, 0, 512, 512, 128, OFF_G2_T)
  TJOB(p.rw_w_o, 1024, 0, 1024, 1024, 512, OFF_RWO_T)
  TJOB(p.mla_w_o, 1024, 0, 1024, 1024, 512, OFF_MLO_T)
  TJOB(p.mla_w_uq, 768, 0, 768, 768, 384, OFF_WUQ_T)
  TJOB(p.mla_w_ukv, 1024, 0, 1024, 1024, 256, OFF_WUKV_T)
  TJOB(p.w_out, 1024, 0, 1024, 1024, 1024, OFF_WOUT_T)
  TJOB(p.peer_w_q, 2048, 0, 2048, 2048, 1024, OFF_WQ_T)
  TJOB(p.ple_w_gate, 1024, 0, 1024, 1024, 1024, OFF_PG_T)
  TJOB(p.ple_w_proj, 1024, 0, 1024, 1024, 256, OFF_PP_T)
#undef TJOB
  convert_job(p.peer_sub_keys, (bf16*)(ws + OFF_SK), (size_t)8 * 2 * 128 * 128);
  fp8_rows_job(p.peer_u, ws + OFF_U8, (float*)(ws + OFF_IUS));
  fp8_rows_job(p.peer_v, ws + OFF_V8, (float*)(ws + OFF_IVS));
  convert_job(p.p, (bf16*)(ws + OFF_PBF), (size_t)T_TOK * 256);
  rmsnorm_rows_bf16(p.x, p.norm_mix, (bf16*)(ws + OFF_H1));
  {
    float* cs = (float*)(ws + OFF_CS);
    float* sn = (float*)(ws + OFF_SN);
    for (int i = blockIdx.x * NTHREADS + threadIdx.x; i < T_TOK * 16; i += gridDim.x * NTHREADS) {
      const int t = i >> 4, f = i & 15;
      const float inv = powf(10000.f, -(float)(2 * f) / 32.f);
      const float ang = (float)p.pos[t] * inv;
      double s, c;
      sincos((double)ang, &s, &c);
      cs[i] = (float)c; sn[i] = (float)s;
    }
  }
  if (blockIdx.x == 0 && threadIdx.x < 64) ((unsigned*)(ws + OFF_CNT))[threadIdx.x] = 0u;
  if (blockIdx.x == 0) for (int i = threadIdx.x; i < XCD_BAR_WORDS; i += NTHREADS) ((unsigned*)(ws + OFF_BAR))[i] = 0u;
}

DEVI void phase1(const Params& p, unsigned char* smem) {
  GemmSmem& sm = *(GemmSmem*)smem;
  const bf16* H1 = (const bf16*)(p.ws + OFF_H1);
  const bf16* W = (const bf16*)(p.ws + OFF_WIN_T);
  bf16* zrw = (bf16*)(p.ws + OFF_ZRW);
  bf16* zmla = (bf16*)(p.ws + OFF_ZMLA);
  const int lane = threadIdx.x & 63, w = threadIdx.x >> 6;
  const int wrow0 = (w >> 1) * 64, wcol0 = (w & 1) * 64;
  for (int tile = blockIdx.x; tile < 256 * 20; tile += gridDim.x) {
    const int mt0 = (tile / 20) * 128, nt0 = (tile % 20) * 128;
    f32x16 acc[2][2];
    acc_zero(acc);
    gemm_mainloop<2, 2>(acc, H1 + (size_t)mt0 * DM, DM, W + (size_t)nt0 * DM, DM, DM, sm, wrow0, wcol0);
#pragma unroll
    for (int mt = 0; mt < 2; ++mt)
#pragma unroll
      for (int nt = 0; nt < 2; ++nt) {
        const int n = nt0 + acc_col(wcol0, nt, lane);
#pragma unroll
        for (int r = 0; r < 16; ++r) {
          const int m = mt0 + acc_row(wrow0, mt, r, lane);
          const float v = acc[mt][nt][r];
          if (n < RWC) zrw[(size_t)m * RWC + n] = (bf16)v;
          else if (n < RWC + MLC) zmla[(size_t)m * MLC + (n - RWC)] = (bf16)v;
        }
      }
  }
}

DEVI void phase2a(const Params& p) {
  const int lane = threadIdx.x & 63;
  const int gw = blockIdx.x * 4 + (threadIdx.x >> 6), nw = gridDim.x * 4;
  const bf16* zrw = (const bf16*)(p.ws + OFF_ZRW);
  const bf16* zmla = (const bf16*)(p.ws + OFF_ZMLA);
  bf16* lora = (bf16*)(p.ws + OFF_LORA);
  bf16* cq = (bf16*)(p.ws + OFF_CQ);
  bf16* ckv = (bf16*)(p.ws + OFF_CKV);
  bf16* Kd = (bf16*)((unsigned char*)p.out + OFF_K);
  const float* cs = (const float*)(p.ws + OFF_CS);
  const float* sn = (const float*)(p.ws + OFF_SN);
  const f32x4 mu = *(const f32x4*)(p.rw_mu + 1536 + lane * 4);
  const f32x4 qg0 = *(const f32x4*)(p.mla_q_norm + lane * 4);
  const f32x2 qg1 = *(const f32x2*)(p.mla_q_norm + 256 + lane * 2);
  const f32x4 kg = *(const f32x4*)(p.mla_kv_norm + lane * 4);
  const float mua[4] = {mu.x, mu.y, mu.z, mu.w};
  for (int t = gw; t < T_TOK; t += nw) {
    const int s = t & (SEQ - 1), b = t >> 12;
    {
      const bf16* zp = zrw + (size_t)t * RWC + 1536 + lane * 4;
      const bf16x4 zc = *(const bf16x4*)zp;
      bf16x4 zv;
      if (s > 0) zv = *(const bf16x4*)(zp - RWC);
      else { zv[0] = (bf16)0.f; zv[1] = (bf16)0.f; zv[2] = (bf16)0.f; zv[3] = (bf16)0.f; }
      bf16x4 o;
#pragma unroll
      for (int j = 0; j < 4; ++j) {
        const float c = (float)zc[j], pv = (float)zv[j];
        const float zs = c + mua[j] * (pv - c);
        float val;
        if (lane < 16) val = tanhf(zs);
        else if (lane < 32) val = zs;
        else val = sigmoid_f(zs);
        o[j] = (bf16)val;
      }
      *(bf16x4*)(lora + (size_t)t * 256 + lane * 4) = o;
    }
    {
      const bf16* zq = zmla + (size_t)t * MLC;
      const bf16x4 q0 = *(const bf16x4*)(zq + lane * 4);
      const bf16x2 q1 = *(const bf16x2*)(zq + 256 + lane * 2);
      float f[6] = {(float)q0[0], (float)q0[1], (float)q0[2], (float)q0[3], (float)q1[0], (float)q1[1]};
      float ss = 0.f;
#pragma unroll
      for (int j = 0; j < 6; ++j) ss += f[j] * f[j];
      ss = wave_sum(ss);
      const float rs = rsqrtf(ss * (1.f / 384.f) + 1e-6f);
      bf16x4 o0; bf16x2 o1;
      o0[0] = (bf16)(f[0] * rs * qg0.x); o0[1] = (bf16)(f[1] * rs * qg0.y);
      o0[2] = (bf16)(f[2] * rs * qg0.z); o0[3] = (bf16)(f[3] * rs * qg0.w);
      o1[0] = (bf16)(f[4] * rs * qg1.x); o1[1] = (bf16)(f[5] * rs * qg1.y);
      *(bf16x4*)(cq + (size_t)t * 384 + lane * 4) = o0;
      *(bf16x2*)(cq + (size_t)t * 384 + 256 + lane * 2) = o1;
    }
    {
      const bf16x4 k0 = *(const bf16x4*)(zmla + (size_t)t * MLC + 384 + lane * 4);
      float f[4] = {(float)k0[0], (float)k0[1], (float)k0[2], (float)k0[3]};
      float ss = f[0] * f[0] + f[1] * f[1] + f[2] * f[2] + f[3] * f[3];
      ss = wave_sum(ss);
      const float rs = rsqrtf(ss * (1.f / 256.f) + 1e-6f);
      bf16x4 o;
      o[0] = (bf16)(f[0] * rs * kg.x); o[1] = (bf16)(f[1] * rs * kg.y);
      o[2] = (bf16)(f[2] * rs * kg.z); o[3] = (bf16)(f[3] * rs * kg.w);
      *(bf16x4*)(ckv + (size_t)t * 256 + lane * 4) = o;
    }
    {
      const float xr = (float)zmla[(size_t)t * MLC + 640 + (lane & 31)];
      const float xp = __shfl_xor(xr, 16, 64);
      const int f = lane & 15;
      const float c = cs[t * 16 + f], sv = sn[t * 16 + f];
      const float o = (lane & 16) ? (xr * c + xp * sv) : (xr * c - xp * sv);
      if (lane < 32) {
        const bf16 ob = (bf16)o;
#pragma unroll
        for (int h = 0; h < 8; ++h) Kd[((size_t)(b * 8 + h) * SEQ + s) * 96 + 64 + lane] = ob;
      }
    }
  }
}

constexpr float QSCALE = 0.14724444f;
DEVI void phase2b(const Params& p, unsigned char* smem) {
  GemmSmem& sm = *(GemmSmem*)smem;
  unsigned char* ws = p.ws;
  const bf16* lora = (const bf16*)(ws + OFF_LORA);
  const bf16* cq = (const bf16*)(ws + OFF_CQ);
  const bf16* ckv = (const bf16*)(ws + OFF_CKV);
  float* E = (float*)(ws + OFF_E);
  bf16* ICLR = (bf16*)(ws + OFF_ICLR);
  bf16* G = (bf16*)(ws + OFF_G);
  bf16* Qd = (bf16*)((unsigned char*)p.out + OFF_Q);
  bf16* Kd = (bf16*)((unsigned char*)p.out + OFF_K);
  bf16* Vd = (bf16*)((unsigned char*)p.out + OFF_VT);
  const float* cs = (const float*)(ws + OFF_CS);
  const float* sn = (const float*)(ws + OFF_SN);
  const int lane = threadIdx.x & 63, w = threadIdx.x >> 6;
  const int wrow0 = (w >> 1) * 64, wcol0 = (w & 1) * 64;
  for (int tile = blockIdx.x; tile < 256 * 26; tile += gridDim.x) {
    const int m0 = (tile / 26) * 128, j = tile % 26;
    const bf16* A; const bf16* Bm; int lda, K, kind, n0;
    if (j < 4) { kind = 0; n0 = j * 128; A = lora + (size_t)m0 * 256; lda = 256; K = 64; Bm = (const bf16*)(ws + OFF_W2_T) + (size_t)n0 * 64; }
    else if (j < 8) { kind = 1; n0 = (j - 4) * 128; A = lora + (size_t)m0 * 256 + 64; lda = 256; K = 64; Bm = (const bf16*)(ws + OFF_A2_T) + (size_t)n0 * 64; }
    else if (j < 12) { kind = 2; n0 = (j - 8) * 128; A = lora + (size_t)m0 * 256 + 128; lda = 256; K = 128; Bm = (const bf16*)(ws + OFF_G2_T) + (size_t)n0 * 128; }
    else if (j < 18) { kind = 3; n0 = (j - 12) * 128; A = cq + (size_t)m0 * 384; lda = 384; K = 384; Bm = (const bf16*)(ws + OFF_WUQ_T) + (size_t)n0 * 384; }
    else { kind = 4; n0 = (j - 18) * 128; A = ckv + (size_t)m0 * 256; lda = 256; K = 256; Bm = (const bf16*)(ws + OFF_WUKV_T) + (size_t)n0 * 256; }
    f32x16 acc[2][2];
    acc_zero(acc);
    gemm_mainloop<2, 2>(acc, A, lda, Bm, K, K, sm, wrow0, wcol0);
    if (kind <= 2) {
#pragma unroll
      for (int mt = 0; mt < 2; ++mt)
#pragma unroll
        for (int nt = 0; nt < 2; ++nt) {
          const int n = n0 + acc_col(wcol0, nt, lane);
          const float bias = (kind == 0) ? p.rw_w0[n] : ((kind == 1) ? p.rw_a0[n] : 0.f);
#pragma unroll
          for (int r = 0; r < 16; ++r) {
            const int m = m0 + acc_row(wrow0, mt, r, lane);
            const float v = acc[mt][nt][r];
            if (kind == 0) E[(size_t)m * 512 + n] = 0.60653066f * sigmoid_f(bias + v);
            else if (kind == 1) ICLR[(size_t)m * 512 + n] = (bf16)sigmoid_f(bias + v);
            else G[(size_t)m * 512 + n] = (bf16)v;
          }
        }
    } else if (kind == 3) {
#pragma unroll
      for (int nt = 0; nt < 2; ++nt) {
        const int blk = (n0 + wcol0 + nt * 32) >> 5;
        const int head = blk / 3, part = blk % 3;
        const int d = part * 32 + (lane & 31);
#pragma unroll
        for (int mt = 0; mt < 2; ++mt)
#pragma unroll
          for (int r = 0; r < 16; ++r) {
            const int m = m0 + acc_row(wrow0, mt, r, lane);
            const int s = m & (SEQ - 1), b = m >> 12;
            float v = acc[mt][nt][r] * QSCALE;
            if (part == 2) {
              const float pv = __shfl_xor(v, 16, 64);
              const int f = lane & 15;
              const float c = cs[m * 16 + f], sv = sn[m * 16 + f];
              v = (lane & 16) ? (v * c + pv * sv) : (v * c - pv * sv);
            }
            Qd[((size_t)(b * 8 + head) * SEQ + s) * 96 + d] = (bf16)v;
          }
      }
    } else {
      const int head = n0 >> 7;
      if ((w & 1) == 0) {
#pragma unroll
        for (int nt = 0; nt < 2; ++nt) {
          const int d = nt * 32 + (lane & 31);
#pragma unroll
          for (int mt = 0; mt < 2; ++mt)
#pragma unroll
            for (int r = 0; r < 16; ++r) {
              const int m = m0 + acc_row(wrow0, mt, r, lane);
              const int s = m & (SEQ - 1), b = m >> 12;
              Kd[((size_t)(b * 8 + head) * SEQ + s) * 96 + d] = (bf16)acc[mt][nt][r];
            }
        }
      } else {
#pragma unroll
        for (int nt = 0; nt < 2; ++nt) {
          const int vdim = nt * 32 + (lane & 31);
#pragma unroll
          for (int mt = 0; mt < 2; ++mt)
#pragma unroll
            for (int rg = 0; rg < 4; ++rg) {
              const int m = m0 + wrow0 + mt * 32 + 8 * rg + 4 * (lane >> 5);
              const int s = m & (SEQ - 1), b = m >> 12;
              bf16x4 o;
              o[0] = (bf16)acc[mt][nt][4 * rg + 0]; o[1] = (bf16)acc[mt][nt][4 * rg + 1];
              o[2] = (bf16)acc[mt][nt][4 * rg + 2]; o[3] = (bf16)acc[mt][nt][4 * rg + 3];
              *(bf16x4*)(Vd + (((size_t)(b * 8 + head) * 64 + (s >> 6)) * 64 + vdim) * 64 + (s & 63)) = o;
            }
        }
      }
    }
  }
}

struct ScanBuf { float A[16][64], B[16][64], W[16][64], K2[16][64], R[16][64]; float V[16][16]; };
DEVI void phase3a(const Params& p, unsigned char* smem) {
  ScanBuf* sb = (ScanBuf*)smem;
  const bf16* zrw = (const bf16*)(p.ws + OFF_ZRW);
  const float* E = (const float*)(p.ws + OFF_E);
  const bf16* ICLR = (const bf16*)(p.ws + OFF_ICLR);
  bf16* YRAW = (bf16*)(p.ws + OFF_YRAW);
  float* RK = (float*)(p.ws + OFF_RK);
  const int tid = threadIdx.x, lane = tid & 63, w = tid >> 6;
  const int pi = tid >> 4, kq = tid & 15;
  const int rloc = 4 * w + (lane >> 4), kg = lane & 15;
  for (int item = blockIdx.x; item < 256; item += gridDim.x) {
    const int bh = item >> 2, quarter = item & 3, b = bh >> 3, h = bh & 7;
    const int c0 = h * 64 + 4 * kq;
    const f32x4 mur = *(const f32x4*)(p.rw_mu + c0);
    const f32x4 muk = *(const f32x4*)(p.rw_mu + 512 + c0);
    const f32x4 muv = *(const f32x4*)(p.rw_mu + 1024 + c0);
    const f32x4 kkw = *(const f32x4*)(p.rw_k_k + c0);
    const f32x4 kaw = *(const f32x4*)(p.rw_k_a + c0);
    const f32x4 rkw = *(const f32x4*)(p.rw_r_k + c0);
    const float mur_[4] = {mur.x, mur.y, mur.z, mur.w}, muk_[4] = {muk.x, muk.y, muk.z, muk.w},
                muv_[4] = {muv.x, muv.y, muv.z, muv.w}, kkw_[4] = {kkw.x, kkw.y, kkw.z, kkw.w},
                kaw_[4] = {kaw.x, kaw.y, kaw.z, kaw.w}, rkw_[4] = {rkw.x, rkw.y, rkw.z, rkw.w};
    bf16x4 zr, zk, zv, pr, pk, pv, ic;
    f32x4 ee;
    auto load_raw = [&](int c) {
      const int s = c * 16 + pi;
      const size_t t = (size_t)b * SEQ + s;
      const bf16* zp = zrw + t * RWC + c0;
      zr = *(const bf16x4*)zp; zk = *(const bf16x4*)(zp + 512); zv = *(const bf16x4*)(zp + 1024);
      if (s > 0) {
        pr = *(const bf16x4*)(zp - RWC); pk = *(const bf16x4*)(zp - RWC + 512); pv = *(const bf16x4*)(zp - RWC + 1024);
      } else {
#pragma unroll
        for (int j = 0; j < 4; ++j) { pr[j] = (bf16)0.f; pk[j] = (bf16)0.f; pv[j] = (bf16)0.f; }
      }
      ee = *(const f32x4*)(E + t * 512 + c0);
      ic = *(const bf16x4*)(ICLR + t * 512 + c0);
    };
    load_raw(0);
    float s0 = 0.f, s1 = 0.f, s2 = 0.f, s3 = 0.f;
    for (int c = 0; c < 256; ++c) {
      ScanBuf& bf = sb[c & 1];
      {
        const float ee_[4] = {ee.x, ee.y, ee.z, ee.w};
        float r[4], k[4], v[4], kx[4], icl[4];
        float n2 = 0.f;
#pragma unroll
        for (int j = 0; j < 4; ++j) {
          const float zrj = (float)zr[j], zkj = (float)zk[j], zvj = (float)zv[j];
          r[j] = zrj + mur_[j] * ((float)pr[j] - zrj);
          k[j] = zkj + muk_[j] * ((float)pk[j] - zkj);
          v[j] = zvj + muv_[j] * ((float)pv[j] - zvj);
          kx[j] = k[j] * kkw_[j];
          n2 += kx[j] * kx[j];
          icl[j] = (float)ic[j];
        }
        n2 = row16_allsum(n2);
        const float inv = 1.f / fmaxf(sqrtf(n2), 1e-12f);
        f32x4 a4, b4, w4, k4, r4;
        float av[4], bv[4], wv[4], k2[4];
        float rkp = 0.f;
#pragma unroll
        for (int j = 0; j < 4; ++j) {
          float kkn = kx[j] * inv;
#if ABL == 5
          kkn = (float)(bf16)kkn;
#endif
          k2[j] = k[j] * (1.f + (icl[j] - 1.f) * kaw_[j]);
          av[j] = -kkn;
          bv[j] = kkn * icl[j];
#if ABL == 6
          wv[j] = __expf(-(float)(bf16)ee_[j]);
#else
          wv[j] = __expf(-ee_[j]);
#endif
          rkp += r[j] * k2[j] * rkw_[j];
        }
        rkp = row16_allsum(rkp);
        a4 = mk_f4(av[0], av[1], av[2], av[3]);
        b4 = mk_f4(bv[0], bv[1], bv[2], bv[3]);
        w4 = mk_f4(wv[0], wv[1], wv[2], wv[3]);
        k4 = mk_f4(k2[0], k2[1], k2[2], k2[3]);
        r4 = mk_f4(r[0], r[1], r[2], r[3]);
        *(f32x4*)&bf.A[pi][4 * kq] = a4;
        *(f32x4*)&bf.B[pi][4 * kq] = b4;
        *(f32x4*)&bf.W[pi][4 * kq] = w4;
        *(f32x4*)&bf.K2[pi][4 * kq] = k4;
        *(f32x4*)&bf.R[pi][4 * kq] = r4;
        if ((kq >> 2) == quarter) *(f32x4*)&bf.V[pi][(kq & 3) * 4] = mk_f4(v[0], v[1], v[2], v[3]);
        if (quarter == 0 && kq == 0) RK[((size_t)b * SEQ + c * 16 + pi) * 8 + h] = rkp;
      }
      __syncthreads();
      if (c + 1 < 256) load_raw(c + 1);
      float yv = 0.f;
#pragma unroll
      for (int i = 0; i < 16; ++i) {
        const f32x4 A4 = *(const f32x4*)&bf.A[i][4 * kg];
        const f32x4 B4 = *(const f32x4*)&bf.B[i][4 * kg];
        const f32x4 W4 = *(const f32x4*)&bf.W[i][4 * kg];
        const f32x4 K4 = *(const f32x4*)&bf.K2[i][4 * kg];
        const f32x4 R4 = *(const f32x4*)&bf.R[i][4 * kg];
        const float vv = bf.V[i][rloc];
        float pd = s0 * A4.x + s1 * A4.y + s2 * A4.z + s3 * A4.w;
        const float sa = row16_allsum(pd);
        s0 = s0 * W4.x + vv * K4.x + sa * B4.x;
        s1 = s1 * W4.y + vv * K4.y + sa * B4.y;
        s2 = s2 * W4.z + vv * K4.z + sa * B4.z;
        s3 = s3 * W4.w + vv * K4.w + sa * B4.w;
        float yp = s0 * R4.x + s1 * R4.y + s2 * R4.z + s3 * R4.w;
        const float y = row16_allsum(yp);
        yv = (kg == i) ? y : yv;
      }
      YRAW[((size_t)b * SEQ + c * 16 + kg) * 512 + h * 64 + quarter * 16 + rloc] = (bf16)yv;
    }
    __syncthreads();
  }
}

struct AttnSmem { bf16 k[64][104]; bf16 v[64][68]; int tile; };
DEVI void phase3b(const Params& p, unsigned char* smem, int cnt_idx = 0) {
  AttnSmem& sm = *(AttnSmem*)smem;
  const bf16* Qd = (const bf16*)((const unsigned char*)p.out + OFF_Q);
  const bf16* Kd = (const bf16*)((const unsigned char*)p.out + OFF_K);
  const bf16* Vd = (const bf16*)((const unsigned char*)p.out + OFF_VT);
  bf16* O = (bf16*)(p.ws + OFF_O);
  unsigned* cnt = (unsigned*)(p.ws + OFF_CNT) + cnt_idx;
  const int tid = threadIdx.x, lane = tid & 63, w = tid >> 6;
  const int q = lane & 31, hh = lane >> 5;
  for (;;) {
    if (tid == 0) sm.tile = (int)atomicAdd(cnt, 1u);
    __syncthreads();
    const int tile = sm.tile;
    __syncthreads();
    if (tile >= 2048) break;
    const int qt = 31 - (tile >> 6), bh = tile & 63;
    const int s0 = qt * 128;
    const int nkt = 2 * qt + 2;
    const int my_nkt = 2 * qt + 1 + (w >> 1);
    bf16x8 qf[6];
    {
      const bf16* qp = Qd + ((size_t)bh * SEQ + s0 + w * 32 + q) * 96 + hh * 8;
#pragma unroll
      for (int ks = 0; ks < 6; ++ks) qf[ks] = *(const bf16x8*)(qp + ks * 16);
    }
    f32x16 ot[2];
#pragma unroll
    for (int vb = 0; vb < 2; ++vb)
#pragma unroll
      for (int r = 0; r < 16; ++r) ot[vb][r] = 0.f;
    float mrun = -1e30f, lsum = 0.f;
    u32x4 kr[3], vr[2];
    auto gload = [&](int kt) {
      const bf16* kb = Kd + ((size_t)bh * SEQ + kt * 64) * 96;
#pragma unroll
      for (int i = 0; i < 3; ++i) kr[i] = *(const u32x4*)(kb + (size_t)(tid + 256 * i) * 8);
      const bf16* vb = Vd + ((size_t)bh * 64 + kt) * 4096;
#pragma unroll
      for (int i = 0; i < 2; ++i) vr[i] = *(const u32x4*)(vb + (size_t)(tid + 256 * i) * 8);
    };
    gload(0);
    for (int kt = 0; kt < nkt; ++kt) {
      __syncthreads();
#pragma unroll
      for (int i = 0; i < 3; ++i) {
        const int id = tid + 256 * i;
        const int row = id / 12, cc = id % 12;
        *(u32x4*)&sm.k[row][cc * 8] = kr[i];
      }
#pragma unroll
      for (int i = 0; i < 2; ++i) {
        const int id = tid + 256 * i;
        const int row = id >> 3, cc = id & 7;
        u32x2* d = (u32x2*)&sm.v[row][cc * 8];
        d[0] = mk_u2(vr[i].x, vr[i].y);
        d[1] = mk_u2(vr[i].z, vr[i].w);
      }
      __syncthreads();
      if (kt + 1 < nkt) gload(kt + 1);
      if (kt < my_nkt) {
        f32x16 st[2];
#pragma unroll
        for (int kb2 = 0; kb2 < 2; ++kb2) {
#pragma unroll
          for (int r = 0; r < 16; ++r) st[kb2][r] = 0.f;
#pragma unroll
          for (int ks = 0; ks < 6; ++ks) {
            const bf16x8 a = *(const bf16x8*)&sm.k[kb2 * 32 + q][ks * 16 + hh * 8];
            st[kb2] = __builtin_amdgcn_mfma_f32_32x32x16_bf16(a, qf[ks], st[kb2], 0, 0, 0);
          }
        }
        float mx = st[0][0];
#pragma unroll
        for (int kb2 = 0; kb2 < 2; ++kb2)
#pragma unroll
          for (int r = 0; r < 16; ++r) mx = fmaxf(mx, st[kb2][r]);
        mx = fmaxf(mx, __shfl_xor(mx, 32, 64));
        const float mnew = fmaxf(mrun, mx);
        const float alpha = __builtin_amdgcn_exp2f(mrun - mnew);
        mrun = mnew;
        float ps = 0.f;
#pragma unroll
        for (int kb2 = 0; kb2 < 2; ++kb2)
#pragma unroll
          for (int r = 0; r < 16; ++r) {
            const float pv = __builtin_amdgcn_exp2f(st[kb2][r] - mnew);
            st[kb2][r] = pv;
            ps += pv;
          }
        lsum = lsum * alpha + ps;
#pragma unroll
        for (int vb = 0; vb < 2; ++vb)
#pragma unroll
          for (int r = 0; r < 16; ++r) ot[vb][r] *= alpha;
#pragma unroll
        for (int kb2 = 0; kb2 < 2; ++kb2)
#pragma unroll
          for (int s2 = 0; s2 < 2; ++s2) {
            bf16x8 pf;
#pragma unroll
            for (int j = 0; j < 8; ++j) pf[j] = (bf16)st[kb2][8 * s2 + j];
#pragma unroll
            for (int vb = 0; vb < 2; ++vb) {
              const bf16x4 lo = *(const bf16x4*)&sm.v[vb * 32 + q][kb2 * 32 + 16 * s2 + 4 * hh];
              const bf16x4 hi = *(const bf16x4*)&sm.v[vb * 32 + q][kb2 * 32 + 16 * s2 + 8 + 4 * hh];
              bf16x8 a;
              a[0] = lo[0]; a[1] = lo[1]; a[2] = lo[2]; a[3] = lo[3];
              a[4] = hi[0]; a[5] = hi[1]; a[6] = hi[2]; a[7] = hi[3];
              ot[vb] = __builtin_amdgcn_mfma_f32_32x32x16_bf16(a, pf, ot[vb], 0, 0, 0);
            }
          }
      }
    }
    const float ltot = lsum + __shfl_xor(lsum, 32, 64);
    const float inv = 1.f / ltot;
    const int b = bh >> 3, h = bh & 7;
    bf16* op = O + ((size_t)b * SEQ + s0 + w * 32 + q) * 512 + h * 64;
#pragma unroll
    for (int vb = 0; vb < 2; ++vb)
#pragma unroll
      for (int rg = 0; rg < 4; ++rg) {
        bf16x4 o;
        o[0] = (bf16)(ot[vb][4 * rg + 0] * inv); o[1] = (bf16)(ot[vb][4 * rg + 1] * inv);
        o[2] = (bf16)(ot[vb][4 * rg + 2] * inv); o[3] = (bf16)(ot[vb][4 * rg + 3] * inv);
        *(bf16x4*)(op + vb * 32 + 8 * rg + 4 * hh) = o;
      }
  }
}

DEVI void phase3c(const Params& p) {
  const int lane = threadIdx.x & 63;
  const int gw = blockIdx.x * 4 + (threadIdx.x >> 6), nw = gridDim.x * 4;
  const bf16* zrw = (const bf16*)(p.ws + OFF_ZRW);
  const bf16* YRAW = (const bf16*)(p.ws + OFF_YRAW);
  const bf16* G = (const bf16*)(p.ws + OFF_G);
  const float* RK = (const float*)(p.ws + OFF_RK);
  bf16* YA = (bf16*)(p.ws + OFF_YAPRE);
  const int c0 = lane * 8, head = lane >> 3;
  float gw_[8], gb_[8], mu_[8];
#pragma unroll
  for (int j = 0; j < 8; ++j) { gw_[j] = p.rw_gn_w[c0 + j]; gb_[j] = p.rw_gn_b[c0 + j]; mu_[j] = p.rw_mu[1024 + c0 + j]; }
  for (int t = gw; t < T_TOK; t += nw) {
    const int s = t & (SEQ - 1);
    const bf16x8 y8 = *(const bf16x8*)(YRAW + (size_t)t * 512 + c0);
    float y[8];
    float sm = 0.f;
#pragma unroll
    for (int j = 0; j < 8; ++j) { y[j] = (float)y8[j]; sm += y[j]; }
    const float mean = row8_allsum(sm) * (1.f / 64.f);
    float sq = 0.f;
#pragma unroll
    for (int j = 0; j < 8; ++j) { y[j] -= mean; sq += y[j] * y[j]; }
    const float var = row8_allsum(sq) * (1.f / 64.f);
    const float rstd = rsqrtf(var + 64e-5f);
    const bf16* vp = zrw + (size_t)t * RWC + 1024 + c0;
    const bf16x8 vc = *(const bf16x8*)vp;
    bf16x8 vq;
    if (s > 0) vq = *(const bf16x8*)(vp - RWC);
    else {
#pragma unroll
      for (int j = 0; j < 8; ++j) vq[j] = (bf16)0.f;
    }
    const bf16x8 g8 = *(const bf16x8*)(G + (size_t)t * 512 + c0);
    const float rk = RK[(size_t)t * 8 + head];
    bf16x8 o;
#pragma unroll
    for (int j = 0; j < 8; ++j) {
      const float vcur = (float)vc[j];
      const float vs = vcur + mu_[j] * ((float)vq[j] - vcur);
      const float yn = y[j] * rstd * gw_[j] + gb_[j];
      o[j] = (bf16)((yn + rk * vs) * (float)g8[j]);
    }
    *(bf16x8*)(YA + (size_t)t * 512 + c0) = o;
  }
}

DEVI void phase4(const Params& p, unsigned char* smem) {
  GemmSmem& sm = *(GemmSmem*)smem;
  unsigned char* ws = p.ws;
  const bf16* H1 = (const bf16*)(ws + OFF_H1);
  const bf16* WG = (const bf16*)(ws + OFF_WG_T);
  const bf16* YA = (const bf16*)(ws + OFF_YAPRE);
  const bf16* OO = (const bf16*)(ws + OFF_O);
  const bf16* RWO = (const bf16*)(ws + OFF_RWO_T);
  const bf16* MLO = (const bf16*)(ws + OFF_MLO_T);
  bf16* M = (bf16*)(ws + OFF_M);
  const int lane = threadIdx.x & 63, w = threadIdx.x >> 6;
  const int wrow0 = (w >> 1) * 64, wcol0 = (w & 1) * 64;
  for (int tile = blockIdx.x; tile < 256 * 8; tile += gridDim.x) {
    const int m0 = (tile >> 3) * 128, n0 = (tile & 7) * 128;
    unsigned pk[2][2][8];
#pragma nounroll
    for (int g = 0; g < 4; ++g) {
      const bf16* A; const bf16* Bm; int ld;
      if (g == 0) { A = YA + (size_t)m0 * 512; Bm = RWO + (size_t)n0 * 512; ld = 512; }
      else if (g == 1) { A = H1 + (size_t)m0 * DM; Bm = WG + (size_t)n0 * DM; ld = DM; }
      else if (g == 2) { A = OO + (size_t)m0 * 512; Bm = MLO + (size_t)n0 * 512; ld = 512; }
      else { A = H1 + (size_t)m0 * DM; Bm = WG + (size_t)(1024 + n0) * DM; ld = DM; }
      f32x16 acc[2][2];
      acc_zero(acc);
      gemm_mainloop<2, 2>(acc, A, ld, Bm, ld, ld, sm, wrow0, wcol0);
      if (g == 0 || g == 2) {
#pragma unroll
        for (int a = 0; a < 2; ++a)
#pragma unroll
          for (int b = 0; b < 2; ++b)
#pragma unroll
            for (int r = 0; r < 8; ++r) pk[a][b][r] = pack2(acc[a][b][2 * r], acc[a][b][2 * r + 1]);
      } else {
#pragma unroll
        for (int a = 0; a < 2; ++a)
#pragma unroll
          for (int b = 0; b < 2; ++b) {
            const int n = n0 + acc_col(wcol0, b, lane);
#pragma unroll
            for (int r = 0; r < 16; ++r) {
              const int m = m0 + acc_row(wrow0, a, r, lane);
              const unsigned u = pk[a][b][r >> 1];
              const float y = (r & 1) ? bfhi(u) : bflo(u);
              float val = y * sigmoid_f(acc[a][b][r]);
#if ABL == 2
              if (g == 3) val = 0.f;
#elif ABL == 3
              if (g == 1) val = 0.f;
#endif
              bf16* dst = M + (size_t)m * DM + n;
              if (g == 3) val += (float)(*dst);
              *dst = (bf16)val;
            }
          }
      }
    }
  }
}

DEVI void phase5(const Params& p, unsigned char* smem) {
  GemmSmem& sm = *(GemmSmem*)smem;
  const bf16* M = (const bf16*)(p.ws + OFF_M);
  const bf16* WO = (const bf16*)(p.ws + OFF_WOUT_T);
  const int lane = threadIdx.x & 63, w = threadIdx.x >> 6;
  const int wrow0 = (w >> 1) * 64, wcol0 = (w & 1) * 64;
  for (int tile = blockIdx.x; tile < 256 * 8; tile += gridDim.x) {
    const int m0 = (tile >> 3) * 128, n0 = (tile & 7) * 128;
    f32x16 acc[2][2];
    acc_zero(acc);
    gemm_mainloop<2, 2>(acc, M + (size_t)m0 * DM, DM, WO + (size_t)n0 * DM, DM, DM, sm, wrow0, wcol0);
#pragma unroll
    for (int a = 0; a < 2; ++a)
#pragma unroll
      for (int b = 0; b < 2; ++b) {
        const int n = n0 + acc_col(wcol0, b, lane);
#pragma unroll
        for (int r = 0; r < 16; ++r) {
          const int m = m0 + acc_row(wrow0, a, r, lane);
          const size_t idx = (size_t)m * DM + n;
          p.out[idx] = p.x[idx] + acc[a][b][r];
        }
      }
  }
}

DEVI unsigned pack_key(float s, int n) {
  unsigned u = __float_as_uint(s);
  u = (u & 0x80000000u) ? ~u : (u | 0x80000000u);
  return (u & 0xFFFFFF80u) | (unsigned)n;
}
DEVI float key_score(unsigned k) {
  unsigned u = k & 0xFFFFFF80u;
  u = (u & 0x80000000u) ? (u & 0x7FFFFFFFu) : ~u;
  return __uint_as_float(u);
}
template <int N> DEVI void bitonic_sort_desc(unsigned (&v)[N]) {
#pragma unroll
  for (int k = 2; k <= N; k <<= 1) {
#pragma unroll
    for (int j = k >> 1; j > 0; j >>= 1) {
#pragma unroll
      for (int i = 0; i < N; ++i) {
        const int l = i ^ j;
        if (l > i) {
          const bool desc = ((i & k) == 0);
          const unsigned a = v[i], b = v[l];
          const unsigned mx = a > b ? a : b, mn = a > b ? b : a;
          v[i] = desc ? mx : mn;
          v[l] = desc ? mn : mx;
        }
      }
    }
  }
}
template <int N> DEVI void bitonic_merge_desc(unsigned (&v)[N]) {
#pragma unroll
  for (int j = N >> 1; j > 0; j >>= 1) {
#pragma unroll
    for (int i = 0; i < N; ++i) {
      const int l = i ^ j;
      if (l > i) {
        const unsigned a = v[i], b = v[l];
        v[i] = a > b ? a : b;
        v[l] = a > b ? b : a;
      }
    }
  }
}

DEVI void phase7(const Params& p, unsigned char* smem) {
  GemmSmem& sm = *(GemmSmem*)smem;
  const bf16* H2 = (const bf16*)(p.ws + OFF_H2);
  const bf16* WQ = (const bf16*)(p.ws + OFF_WQ_T);
  const bf16* SK = (const bf16*)(p.ws + OFF_SK);
  unsigned* TOPK = (unsigned*)(p.ws + OFF_TOPK);
  const int lane = threadIdx.x & 63, w = threadIdx.x >> 6;
  const int hh = lane >> 5;
  for (int tile = blockIdx.x; tile < 256 * 16; tile += gridDim.x) {
    const int m0 = (tile >> 4) * 128, hc = tile & 15;
    f32x16 acc[4][1];
    acc_zero(acc);
    gemm_mainloop<4, 1>(acc, WQ + (size_t)(hc * 128) * DM, DM, H2 + (size_t)m0 * DM, DM, DM, sm, 0, w * 32);
    bf16x8 qf[4][2];
#pragma unroll
    for (int db = 0; db < 4; ++db)
#pragma unroll
      for (int s2 = 0; s2 < 2; ++s2)
#pragma unroll
        for (int j = 0; j < 8; ++j) qf[db][s2][j] = (bf16)acc[db][0][8 * s2 + j];
    unsigned key[64];
    const bf16* skb = SK + (size_t)hc * 128 * 128;
#pragma unroll
    for (int nb = 0; nb < 4; ++nb) {
      f32x16 sc;
#pragma unroll
      for (int r = 0; r < 16; ++r) sc[r] = 0.f;
      const bf16* rowp = skb + (size_t)(nb * 32 + (lane & 31)) * 128 + 4 * hh;
#pragma unroll
      for (int db = 0; db < 4; ++db)
#pragma unroll
        for (int s2 = 0; s2 < 2; ++s2) {
          const bf16x4 lo = *(const bf16x4*)(rowp + db * 32 + 16 * s2);
          const bf16x4 hi = *(const bf16x4*)(rowp + db * 32 + 16 * s2 + 8);
          bf16x8 a;
          a[0] = lo[0]; a[1] = lo[1]; a[2] = lo[2]; a[3] = lo[3];
          a[4] = hi[0]; a[5] = hi[1]; a[6] = hi[2]; a[7] = hi[3];
          sc = __builtin_amdgcn_mfma_f32_32x32x16_bf16(a, qf[db][s2], sc, 0, 0, 0);
        }
#pragma unroll
      for (int r = 0; r < 16; ++r) key[nb * 16 + r] = pack_key(sc[r], nb * 32 + (r & 3) + 8 * (r >> 2) + 4 * hh);
    }
    bitonic_sort_desc<64>(key);
    unsigned top[16];
#pragma unroll
    for (int i = 0; i < 16; ++i) {
      const unsigned o = (unsigned)__shfl_xor((int)key[15 - i], 32, 64);
      top[i] = key[i] > o ? key[i] : o;
    }
    bitonic_merge_desc<16>(top);
    if (hh == 0) {
      const int t = m0 + w * 32 + (lane & 31);
      u32x4* dst = (u32x4*)(TOPK + ((size_t)t * 16 + hc) * 16);
      dst[0] = mk_u4(top[0], top[1], top[2], top[3]);
      dst[1] = mk_u4(top[4], top[5], top[6], top[7]);
      dst[2] = mk_u4(top[8], top[9], top[10], top[11]);
      dst[3] = mk_u4(top[12], top[13], top[14], top[15]);
    }
  }
}

DEVI void phase7b(const Params& p, unsigned char* smem) {
  unsigned* ka = (unsigned*)smem;
  unsigned* kb = ka + 16 * 256;
  const unsigned* TOPK = (const unsigned*)(p.ws + OFF_TOPK);
  int* IDX = (int*)(p.ws + OFF_IDX);
  float* GATE = (float*)(p.ws + OFF_GATE);
  const int tid = threadIdx.x;
  for (int grp = blockIdx.x; grp < (T_TOK * 8) / NTHREADS; grp += gridDim.x) {
    const int item = grp * NTHREADS + tid;
    const u32x4* src = (const u32x4*)(TOPK + (size_t)item * 32);
#pragma unroll
    for (int i = 0; i < 4; ++i) {
      const u32x4 va = src[i], vb = src[4 + i];
      ka[(4 * i + 0) * 256 + tid] = va.x; ka[(4 * i + 1) * 256 + tid] = va.y;
      ka[(4 * i + 2) * 256 + tid] = va.z; ka[(4 * i + 3) * 256 + tid] = va.w;
      kb[(4 * i + 0) * 256 + tid] = vb.x; kb[(4 * i + 1) * 256 + tid] = vb.y;
      kb[(4 * i + 2) * 256 + tid] = vb.z; kb[(4 * i + 3) * 256 + tid] = vb.w;
    }
    unsigned long long jp = 0ull;
    float sc[16];
    int ex[16];
#pragma unroll
    for (int r = 0; r < 16; ++r) {
      float best = -3.0e38f;
      int bi = 0, bj = 0;
      for (int i = 0; i < 16; ++i) {
        const int ji = (int)((jp >> (4 * i)) & 15ull);
        const float cand = key_score(ka[i * 256 + tid]) + key_score(kb[ji * 256 + tid]);
        if (cand > best) { best = cand; bi = i; bj = ji; }
      }
      sc[r] = best;
      ex[r] = (int)(ka[bi * 256 + tid] & 127u) * 128 + (int)(kb[bj * 256 + tid] & 127u);
      jp += 1ull << (4 * bi);
    }
    float den = 0.f;
    const float smax = sc[0];
#pragma unroll
    for (int r = 0; r < 16; ++r) { sc[r] = __expf(sc[r] - smax); den += sc[r]; }
    const float inv = 1.f / den;
    i32x4* di = (i32x4*)(IDX + (size_t)item * 16);
    f32x4* dg = (f32x4*)(GATE + (size_t)item * 16);
#pragma unroll
    for (int i = 0; i < 4; ++i) {
      di[i] = mk_i4(ex[4 * i], ex[4 * i + 1], ex[4 * i + 2], ex[4 * i + 3]);
      dg[i] = mk_f4(sc[4 * i] * inv, sc[4 * i + 1] * inv, sc[4 * i + 2] * inv, sc[4 * i + 3] * inv);
    }
  }
}

struct PeerBuf { u32x4 uq[4]; u32x4 vq[4]; float ius; float ivs[4]; float gt; };
DEVI void peer_issue(PeerBuf& b, int it, int idxr, float gater, const unsigned char* __restrict__ U8, const unsigned char* __restrict__ V8,
                     const float* __restrict__ IUS, const float* __restrict__ IVS, int g, int j, int lane) {
  const int srcl = (it * 4 + g) & 63;
  const int e = __shfl(idxr, srcl, 64);
  b.gt = __shfl(gater, srcl, 64);
  const unsigned char* up = U8 + (size_t)e * 1024 + j * 16;
#pragma unroll
  for (int i = 0; i < 4; ++i) b.uq[i] = *(const u32x4*)(up + i * 256);
  b.ius = IUS[e];
#pragma unroll
  for (int q = 0; q < 4; ++q) {
    const int eq = __builtin_amdgcn_readlane(idxr, (it * 4 + q) & 63);
    b.vq[q] = *(const u32x4*)(V8 + (size_t)eq * 1024 + lane * 16);
    b.ivs[q] = IVS[eq];
  }
}
DEVI void peer_compute(const PeerBuf& b, const unsigned (&hq)[32], float (&acc)[16]) {
  float d0 = 0.f, d1 = 0.f, d2 = 0.f, d3 = 0.f;
#pragma unroll
  for (int i = 0; i < 4; ++i)
#pragma unroll
    for (int wi = 0; wi < 4; ++wi) {
      const int w = (int)b.uq[i][wi];
      const f32x2 lo = __builtin_amdgcn_cvt_pk_f32_fp8(w, false);
      const f32x2 hi = __builtin_amdgcn_cvt_pk_f32_fp8(w, true);
      const unsigned plo = pack2(lo.x, lo.y), phi = pack2(hi.x, hi.y);
      if (wi & 1) { d2 = dot2bf(hq[i * 8 + wi * 2], plo, d2); d3 = dot2bf(hq[i * 8 + wi * 2 + 1], phi, d3); }
      else { d0 = dot2bf(hq[i * 8 + wi * 2], plo, d0); d1 = dot2bf(hq[i * 8 + wi * 2 + 1], phi, d1); }
    }
  float d = (d0 + d1) + (d2 + d3);
  d = row16_allsum(d) * b.ius;
  const float act = 0.5f * d * (1.f + erff(d * 0.70710678f));
  const int cfi = __float_as_int(b.gt * act);
#pragma unroll
  for (int q = 0; q < 4; ++q) {
    const float cc = __int_as_float(__builtin_amdgcn_readlane(cfi, 16 * q)) * b.ivs[q];
#pragma unroll
    for (int wi = 0; wi < 4; ++wi) {
      const int w = (int)b.vq[q][wi];
      const f32x2 lo = __builtin_amdgcn_cvt_pk_f32_fp8(w, false);
      const f32x2 hi = __builtin_amdgcn_cvt_pk_f32_fp8(w, true);
      acc[wi * 4 + 0] += cc * lo.x;
      acc[wi * 4 + 1] += cc * lo.y;
      acc[wi * 4 + 2] += cc * hi.x;
      acc[wi * 4 + 3] += cc * hi.y;
    }
  }
}
template <bool DRY> DEVI void phase8(const Params& p) {
  const int lane = threadIdx.x & 63;
  const int gw = blockIdx.x * 4 + (threadIdx.x >> 6), nw = gridDim.x * 4;
  const bf16* H2 = (const bf16*)(p.ws + OFF_H2);
  const unsigned char* U8 = p.ws + OFF_U8;
  const unsigned char* V8 = p.ws + OFF_V8;
  const float* IUS = (const float*)(p.ws + OFF_IUS);
  const float* IVS = (const float*)(p.ws + OFF_IVS);
  const int* IDX = (const int*)(p.ws + OFF_IDX);
  const float* GATE = (const float*)(p.ws + OFF_GATE);
  bf16* H3 = (bf16*)(p.ws + OFF_H3);
  const int g = lane >> 4, j = lane & 15;
  f32x4 gpl[4];
#pragma unroll
  for (int i = 0; i < 4; ++i) gpl[i] = *(const f32x4*)(p.norm_ple + lane * 16 + i * 4);
  for (int t = gw; t < T_TOK; t += nw) {
    unsigned hq[32];
#pragma unroll
    for (int i = 0; i < 4; ++i) {
      const bf16* hp = H2 + (size_t)t * DM + i * 256 + j * 16;
      const u32x4 a = *(const u32x4*)hp, c = *(const u32x4*)(hp + 8);
#pragma unroll
      for (int k = 0; k < 4; ++k) { hq[i * 8 + k] = a[k]; hq[i * 8 + 4 + k] = c[k]; }
    }
    const int idx0 = IDX[(size_t)t * 128 + lane], idx1 = IDX[(size_t)t * 128 + 64 + lane];
    const float gt0 = GATE[(size_t)t * 128 + lane], gt1 = GATE[(size_t)t * 128 + 64 + lane];
    float acc[16];
#pragma unroll
    for (int i = 0; i < 16; ++i) acc[i] = 0.f;
    PeerBuf ba, bb;
    peer_issue(ba, 0, idx0, gt0, U8, V8, IUS, IVS, g, j, lane);
#pragma unroll 1
    for (int it = 0; it < 32; it += 2) {
      peer_issue(bb, it + 1, (it + 1 < 16) ? idx0 : idx1, (it + 1 < 16) ? gt0 : gt1, U8, V8, IUS, IVS, g, j, lane);
      peer_compute(ba, hq, acc);
      if (it + 2 < 32) peer_issue(ba, it + 2, (it + 2 < 16) ? idx0 : idx1, (it + 2 < 16) ? gt0 : gt1, U8, V8, IUS, IVS, g, j, lane);
      peer_compute(bb, hq, acc);
    }
    float* xo = p.out + (size_t)t * DM + lane * 16;
    f32x4 xv[4];
    float ss = 0.f;
#pragma unroll
    for (int i = 0; i < 4; ++i) {
      xv[i] = *(const f32x4*)(xo + i * 4);
      xv[i].x += acc[i * 4 + 0]; xv[i].y += acc[i * 4 + 1]; xv[i].z += acc[i * 4 + 2]; xv[i].w += acc[i * 4 + 3];
      ss += xv[i].x * xv[i].x + xv[i].y * xv[i].y + xv[i].z * xv[i].z + xv[i].w * xv[i].w;
      if (!DRY) *(f32x4*)(xo + i * 4) = xv[i];
    }
    ss = wave_sum(ss);
    const float rs = rsqrtf(ss * (1.f / DM) + 1e-6f);
    bf16x8 o0, o1;
    o0[0] = (bf16)(xv[0].x * rs * gpl[0].x); o0[1] = (bf16)(xv[0].y * rs * gpl[0].y); o0[2] = (bf16)(xv[0].z * rs * gpl[0].z); o0[3] = (bf16)(xv[0].w * rs * gpl[0].w);
    o0[4] = (bf16)(xv[1].x * rs * gpl[1].x); o0[5] = (bf16)(xv[1].y * rs * gpl[1].y); o0[6] = (bf16)(xv[1].z * rs * gpl[1].z); o0[7] = (bf16)(xv[1].w * rs * gpl[1].w);
    o1[0] = (bf16)(xv[2].x * rs * gpl[2].x); o1[1] = (bf16)(xv[2].y * rs * gpl[2].y); o1[2] = (bf16)(xv[2].z * rs * gpl[2].z); o1[3] = (bf16)(xv[2].w * rs * gpl[2].w);
    o1[4] = (bf16)(xv[3].x * rs * gpl[3].x); o1[5] = (bf16)(xv[3].y * rs * gpl[3].y); o1[6] = (bf16)(xv[3].z * rs * gpl[3].z); o1[7] = (bf16)(xv[3].w * rs * gpl[3].w);
    *(bf16x8*)(H3 + (size_t)t * DM + lane * 16) = o0;
    *(bf16x8*)(H3 + (size_t)t * DM + lane * 16 + 8) = o1;
  }
}

DEVI void phase10(const Params& p, unsigned char* smem) {
  GemmSmem& sm = *(GemmSmem*)smem;
  const bf16* H3 = (const bf16*)(p.ws + OFF_H3);
  const bf16* PG = (const bf16*)(p.ws + OFF_PG_T);
  const bf16* PB = (const bf16*)(p.ws + OFF_PBF);
  const bf16* PP = (const bf16*)(p.ws + OFF_PP_T);
  const int lane = threadIdx.x & 63, w = threadIdx.x >> 6;
  const int wrow0 = (w >> 1) * 64, wcol0 = (w & 1) * 64;
  for (int tile = blockIdx.x; tile < 256 * 8; tile += gridDim.x) {
    const int m0 = (tile >> 3) * 128, n0 = (tile & 7) * 128;
    unsigned pk[2][2][8];
    {
      f32x16 acc2[2][2];
      acc_zero(acc2);
      gemm_mainloop<2, 2>(acc2, PB + (size_t)m0 * 256, 256, PP + (size_t)n0 * 256, 256, 256, sm, wrow0, wcol0);
#pragma unroll
      for (int a = 0; a < 2; ++a)
#pragma unroll
        for (int b = 0; b < 2; ++b)
#pragma unroll
          for (int r = 0; r < 8; ++r) pk[a][b][r] = pack2(acc2[a][b][2 * r], acc2[a][b][2 * r + 1]);
    }
    f32x16 acc[2][2];
    acc_zero(acc);
    gemm_mainloop<2, 2>(acc, H3 + (size_t)m0 * DM, DM, PG + (size_t)n0 * DM, DM, DM, sm, wrow0, wcol0);
#pragma unroll
    for (int a = 0; a < 2; ++a)
#pragma unroll
      for (int b = 0; b < 2; ++b) {
        const int n = n0 + acc_col(wcol0, b, lane);
#pragma unroll
        for (int r = 0; r < 16; ++r) {
          const int m = m0 + acc_row(wrow0, a, r, lane);
          const size_t idx = (size_t)m * DM + n;
          const unsigned u = pk[a][b][r >> 1];
          const float pp = (r & 1) ? bfhi(u) : bflo(u);
          p.out[idx] = p.out[idx] + sigmoid_f(acc[a][b][r]) * pp;
        }
      }
  }
}

DEVI void phase11(const Params& p) {
  const int lane = threadIdx.x & 63;
  const int gw = blockIdx.x * 4 + (threadIdx.x >> 6), nw = gridDim.x * 4;
  f32x4 gn[4];
#pragma unroll
  for (int i = 0; i < 4; ++i) gn[i] = *(const f32x4*)(p.norm_final + i * 256 + lane * 4);
  for (int t = gw; t < T_TOK; t += nw) {
    float* xr = p.out + (size_t)t * DM;
    f32x4 v[4];
    float ss = 0.f;
#pragma unroll
    for (int i = 0; i < 4; ++i) {
      v[i] = *(const f32x4*)(xr + i * 256 + lane * 4);
      ss += v[i].x * v[i].x + v[i].y * v[i].y + v[i].z * v[i].z + v[i].w * v[i].w;
    }
    ss = wave_sum(ss);
    const float rs = rsqrtf(ss * (1.f / DM) + 1e-6f);
#pragma unroll
    for (int i = 0; i < 4; ++i) {
      f32x4 o;
      o.x = v[i].x * rs * gn[i].x; o.y = v[i].y * rs * gn[i].y; o.z = v[i].z * rs * gn[i].z; o.w = v[i].w * rs * gn[i].w;
      *(f32x4*)(xr + i * 256 + lane * 4) = o;
    }
  }
}

constexpr int N_PHASES = 15;
__global__ void __launch_bounds__(NTHREADS, 2) hybrid_block_kernel(Params p, int ph0, int ph1) {
  __shared__ __attribute__((aligned(16))) unsigned char smem[49152];
  cg::grid_group grid = cg::this_grid();
#ifndef DUP_PHASE
#define DUP_PHASE -1
#endif
  volatile LAS unsigned* xst = (volatile LAS unsigned*)(smem + 49152 - 16);
  if (threadIdx.x == 0) { xst[0] = 0u; xst[1] = 0u; }
  __syncthreads();
  XcdBarrier xb;
#define GSYNC(K) { if ((K) == 0) { grid.sync(); xb = xcd_barrier_post((unsigned*)(p.ws + OFF_BAR), xst); } else xcd_barrier(xb); }
#define RUN_PHASE(K, CALL) if (ph0 <= (K) && (K) < ph1) { \
    if (DUP_PHASE == (K)) { if ((K) == 12) phase8<true>(p); else if ((K) == 5) phase3b(p, smem, 1); else { CALL; } GSYNC(1) } \
    CALL; if ((K) + 1 < ph1) GSYNC(K) }
  RUN_PHASE(0, phase0(p, smem))
  RUN_PHASE(1, phase1(p, smem))
  RUN_PHASE(2, phase2a(p))
  RUN_PHASE(3, phase2b(p, smem))
  RUN_PHASE(4, phase3a(p, smem))
  RUN_PHASE(5, phase3b(p, smem))
  RUN_PHASE(6, phase3c(p))
  RUN_PHASE(7, phase4(p, smem))
  RUN_PHASE(8, phase5(p, smem))
  RUN_PHASE(9, rmsnorm_rows_bf16(p.out, p.norm_ffn, (bf16*)(p.ws + OFF_H2)))
  RUN_PHASE(10, phase7(p, smem))
  RUN_PHASE(11, phase7b(p, smem))
  RUN_PHASE(12, phase8<false>(p))
  RUN_PHASE(13, phase10(p, smem))
  RUN_PHASE(14, phase11(p))
#undef RUN_PHASE
}

extern "C" void kernel_launch(void* const* d_in, const int* in_sizes, int n_in, void* d_out, int out_size, void* d_ws,
                              size_t ws_size, hipStream_t stream) {
  static int grid_blocks = 0;
  if (!grid_blocks) {
    int dev = 0, cus = 0, per_cu = 0;
    hipGetDevice(&dev);
    hipDeviceGetAttribute(&cus, hipDeviceAttributeMultiprocessorCount, dev);
    hipOccupancyMaxActiveBlocksPerMultiprocessor(&per_cu, hybrid_block_kernel, NTHREADS, 0);
    if (per_cu > 2) per_cu = 2;
    if (per_cu < 1) per_cu = 1;
    grid_blocks = cus * per_cu;
  }
  Params p{};
  const float** fp = (const float**)&p;
  for (int i = 0; i < 32; ++i) fp[i] = (const float*)d_in[i];
  p.pos = (const int*)d_in[2];
  p.out = (float*)d_out;
  p.ws = (unsigned char*)d_ws;
#ifndef MULTI_LAUNCH
  int ph0 = 0, ph1 = N_PHASES;
  void* args[] = {&p, &ph0, &ph1};
  hipError_t e = hipLaunchCooperativeKernel((void*)hybrid_block_kernel, dim3(grid_blocks), dim3(NTHREADS), args, 0, stream);
  if (e != hipSuccess) fprintf(stderr, "cooperative launch failed: %s (grid %d)\n", hipGetErrorString(e), grid_blocks);
#else
  for (int ph = 0; ph < N_PHASES; ++ph)
    hipLaunchKernelGGL(hybrid_block_kernel, dim3(grid_blocks), dim3(NTHREADS), 0, stream, p, ph, ph + 1);
#endif
}
```

```cpp
#include <hip/hip_runtime.h>
#include <hip/hip_cooperative_groups.h>
#include <stdint.h>
#include <stdio.h>
namespace cg = cooperative_groups;

typedef __bf16 bf16;
typedef __attribute__((ext_vector_type(8))) __bf16 bf16x8;
typedef __attribute__((ext_vector_type(4))) __bf16 bf16x4;
typedef __attribute__((ext_vector_type(2))) __bf16 bf16x2;
typedef __attribute__((ext_vector_type(16))) float f32x16;
typedef __attribute__((ext_vector_type(4))) float f32x4;
typedef __attribute__((ext_vector_type(2))) float f32x2;
typedef __attribute__((ext_vector_type(4))) unsigned u32x4;
typedef __attribute__((ext_vector_type(2))) unsigned u32x2;
typedef __attribute__((ext_vector_type(4))) int i32x4;

#define DEVI __device__ __forceinline__
#ifndef ABL
#define ABL 0
#endif

constexpr int T_TOK = 32768;
constexpr int SEQ = 4096;
constexpr int DM = 1024;
constexpr int IN_COLS = 4512;
constexpr int RWC = 1792;
constexpr int MLC = 672;
constexpr int NTHREADS = 512;
constexpr int NWAVES = 8;
constexpr int LDS_BYTES = 148480;

constexpr size_t MiB = 1ull << 20;
constexpr size_t OFF_WIN_T = 0;
constexpr size_t OFF_WG_T = 5 * MiB;
constexpr size_t OFF_WLORA_T = 9 * MiB;
constexpr size_t OFF_RWO_T = 10 * MiB;
constexpr size_t OFF_MLO_T = 11 * MiB;
constexpr size_t OFF_WUQ_T = 12 * MiB;
constexpr size_t OFF_WUKV_T = 13 * MiB;
constexpr size_t OFF_PP_T = 13 * MiB + 524288;
constexpr size_t OFF_WOUT_T = 14 * MiB;
constexpr size_t OFF_PG_T = 16 * MiB;
constexpr size_t OFF_WQ_T = 18 * MiB;
constexpr size_t OFF_SK = 22 * MiB;
constexpr size_t OFF_CNT = 22 * MiB + 524288;
constexpr size_t OFF_BAR = 22 * MiB + 524288 + 65536;
constexpr size_t OFF_PTAB = 22 * MiB + 524288 + 131072;
constexpr size_t OFF_CS = 23 * MiB;
constexpr size_t OFF_SN = 25 * MiB;
constexpr size_t OFF_RK = 27 * MiB;
constexpr size_t OFF_PBF = 28 * MiB;
constexpr size_t OFF_U8 = 44 * MiB;
constexpr size_t OFF_V8 = 60 * MiB;
constexpr size_t OFF_IUS = 76 * MiB;
constexpr size_t OFF_IVS = 76 * MiB + 65536;
constexpr size_t OFF_H1 = 108 * MiB;
constexpr size_t OFF_ZRW = 172 * MiB;
constexpr size_t OFF_ZMLA = 284 * MiB;
constexpr size_t OFF_LORA = 326 * MiB;
constexpr size_t OFF_CQ = 342 * MiB;
constexpr size_t OFF_CKV = 366 * MiB;
constexpr size_t OFF_E = 382 * MiB;
constexpr size_t OFF_ICLR = 446 * MiB;
constexpr size_t OFF_G = 478 * MiB;
constexpr size_t OFF_O = 284 * MiB;
constexpr size_t OFF_YRAW = 326 * MiB;
constexpr size_t OFF_YAPRE = 358 * MiB;
constexpr size_t OFF_M = 172 * MiB;
constexpr size_t OFF_M2 = 390 * MiB;
constexpr size_t OFF_H2 = 382 * MiB;
constexpr size_t OFF_TOPK = 236 * MiB;
constexpr size_t OFF_IDX = 446 * MiB;
constexpr size_t OFF_GATE = 462 * MiB;
constexpr size_t OFF_H3 = 172 * MiB;
constexpr size_t OFF_XB = 108 * MiB;
constexpr size_t OFF_Q = 0;
constexpr size_t OFF_K = 48 * MiB;
constexpr size_t OFF_VT = 96 * MiB;

struct Params {
  const float* x; const float* p; const int* pos; const float* norm_mix; const float* w_in; const float* rw_mu;
  const float* rw_w0; const float* rw_w2; const float* rw_a0; const float* rw_a2; const float* rw_g2; const float* rw_k_k;
  const float* rw_k_a; const float* rw_r_k; const float* rw_gn_w; const float* rw_gn_b; const float* rw_w_o;
  const float* mla_q_norm; const float* mla_w_uq; const float* mla_kv_norm; const float* mla_w_ukv; const float* mla_w_o;
  const float* w_out; const float* norm_ffn; const float* peer_w_q; const float* peer_sub_keys; const float* peer_u;
  const float* peer_v; const float* norm_ple; const float* ple_w_gate; const float* ple_w_proj; const float* norm_final;
  float* out; unsigned char* ws;
};
#define GLB __attribute__((address_space(1)))
struct ParamsG {
  const GLB float* x; const GLB float* p; const GLB int* pos; const GLB float* norm_mix; const GLB float* w_in; const GLB float* rw_mu;
  const GLB float* rw_w0; const GLB float* rw_w2; const GLB float* rw_a0; const GLB float* rw_a2; const GLB float* rw_g2; const GLB float* rw_k_k;
  const GLB float* rw_k_a; const GLB float* rw_r_k; const GLB float* rw_gn_w; const GLB float* rw_gn_b; const GLB float* rw_w_o;
  const GLB float* mla_q_norm; const GLB float* mla_w_uq; const GLB float* mla_kv_norm; const GLB float* mla_w_ukv; const GLB float* mla_w_o;
  const GLB float* w_out; const GLB float* norm_ffn; const GLB float* peer_w_q; const GLB float* peer_sub_keys; const GLB float* peer_u;
  const GLB float* peer_v; const GLB float* norm_ple; const GLB float* ple_w_gate; const GLB float* ple_w_proj; const GLB float* norm_final;
  GLB float* out; GLB unsigned char* ws;
};
template <class T> DEVI T* gp(GLB T* q) { return (T*)q; }

DEVI u32x4 mk_u4(unsigned a, unsigned b, unsigned c, unsigned d) { u32x4 v; v.x = a; v.y = b; v.z = c; v.w = d; return v; }
DEVI u32x2 mk_u2(unsigned a, unsigned b) { u32x2 v; v.x = a; v.y = b; return v; }
DEVI f32x4 mk_f4(float a, float b, float c, float d) { f32x4 v; v.x = a; v.y = b; v.z = c; v.w = d; return v; }
DEVI i32x4 mk_i4(int a, int b, int c, int d) { i32x4 v; v.x = a; v.y = b; v.z = c; v.w = d; return v; }
DEVI float wave_sum(float v) {
#pragma unroll
  for (int o = 32; o > 0; o >>= 1) v += __shfl_xor(v, o, 64);
  return v;
}
template <int CTRL> DEVI float dpp_f(float v) {
  return __int_as_float(__builtin_amdgcn_update_dpp(0, __float_as_int(v), CTRL, 0xf, 0xf, true));
}
DEVI float row16_allsum(float v) {
  v += dpp_f<0xB1>(v);
  v += dpp_f<0x4E>(v);
  v += dpp_f<0x141>(v);
  v += dpp_f<0x140>(v);
  return v;
}
DEVI float row8_allsum(float v) {
  v += dpp_f<0xB1>(v);
  v += dpp_f<0x4E>(v);
  v += dpp_f<0x141>(v);
  return v;
}
DEVI float sigmoid_f(float x) { return 1.f / (1.f + __expf(-x)); }
DEVI float bflo(unsigned u) { return __uint_as_float(u << 16); }
DEVI float bfhi(unsigned u) { return __uint_as_float(u & 0xffff0000u); }
DEVI unsigned pack2(float a, float b) {
  bf16x2 v; v[0] = (bf16)a; v[1] = (bf16)b;
  return __builtin_bit_cast(unsigned, v);
}
DEVI float dot2bf(unsigned a, unsigned b, float c) {
  return __builtin_amdgcn_fdot2_f32_bf16(__builtin_bit_cast(bf16x2, a), __builtin_bit_cast(bf16x2, b), c, false);
}


#define XB_TMO      128
#define XB_XCNT(j)  (256  + 64 * (j))
#define XB_XSUB(j)  (1280 + 64 * (j))
#define XB_XGEN(j)  (2304 + 64 * (j))
#define XB_TOP      3328
#define XB_TOPGEN   3392
#define XCD_BAR_WORDS 3456
#define XB_SPIN_CAP (1u << 22)
#define LAS __attribute__((address_space(3)))
DEVI unsigned xb_ld(unsigned* p) { return __hip_atomic_load(p, __ATOMIC_RELAXED, __HIP_MEMORY_SCOPE_AGENT); }
DEVI unsigned xb_add(unsigned* p, unsigned v) { return __hip_atomic_fetch_add(p, v, __ATOMIC_RELAXED, __HIP_MEMORY_SCOPE_AGENT); }
DEVI unsigned xb_xcc_id() { return (unsigned)__builtin_amdgcn_s_getreg((3 << 11) | 20) & 0xFu; }
#define XB_SPIN(cond, bar) do { unsigned _sp = 0; while (cond) { __builtin_amdgcn_s_sleep(1); \
    if ((++_sp & 255u) == 0u) { if (xb_ld(&(bar)[XB_TMO])) break; if (_sp > XB_SPIN_CAP) { atomicAdd(&(bar)[XB_TMO], 1u); break; } } } } while (0)
struct XcdBarrier { unsigned* bar; unsigned x; volatile LAS unsigned* st; };
DEVI XcdBarrier xcd_barrier_post(unsigned* bar, volatile LAS unsigned* st) {
  XcdBarrier b; b.bar = bar; b.x = xb_xcc_id(); b.st = st;
  if (threadIdx.x == 0) (void)xb_add(&bar[XB_XCNT(b.x)], 1u);
  return b;
}
DEVI void xcd_barrier_complete(unsigned* bar, unsigned x, unsigned& nloc, unsigned& nx) {
  const unsigned G = gridDim.x * gridDim.y * gridDim.z;
  unsigned sum, cnt, mine, sp = 0u;
  for (;;) {
    sum = 0u; cnt = 0u; mine = 0u;
#pragma unroll
    for (unsigned j = 0; j < 16; ++j) { const unsigned c = xb_ld(&bar[XB_XCNT(j)]); sum += c; cnt += (c > 0u) ? 1u : 0u; mine = (j == x) ? c : mine; }
    if (sum == G) break;
    __builtin_amdgcn_s_sleep(1);
    if ((++sp & 255u) == 0u) { if (xb_ld(&bar[XB_TMO])) break; if (sp > XB_SPIN_CAP) { atomicAdd(&bar[XB_TMO], 1u); break; } }
  }
  nloc = mine > 0u ? mine : 1u; nx = cnt > 0u ? cnt : 1u;
}
DEVI void xcd_barrier(const XcdBarrier& b) {
  asm volatile("s_waitcnt vmcnt(0)" ::: "memory");
  __syncthreads();
  if (threadIdx.x == 0) {
    unsigned* bar = b.bar;
    __builtin_amdgcn_s_waitcnt(0);
    unsigned nloc = b.st[0], nx = b.st[1];
    if (nloc == 0u) { xcd_barrier_complete(bar, b.x, nloc, nx); b.st[0] = nloc; b.st[1] = nx; }
    const unsigned old = xb_add(&bar[XB_XSUB(b.x)], 1u);
    const unsigned gen = old / nloc;
    if (old + 1u == (gen + 1u) * nloc) {
      __builtin_amdgcn_fence(__ATOMIC_RELEASE, "agent");
      asm volatile("s_waitcnt vmcnt(0)" ::: "memory");
      const unsigned og = xb_add(&bar[XB_TOP], 1u);
      const unsigned tg = og / nx;
      if (og + 1u == (tg + 1u) * nx) xb_add(&bar[XB_TOPGEN], 1u);
      else XB_SPIN(xb_ld(&bar[XB_TOPGEN]) == tg, bar);
      __builtin_amdgcn_fence(__ATOMIC_ACQUIRE, "agent");
      xb_add(&bar[XB_XGEN(b.x)], 1u);
      asm volatile("s_waitcnt vmcnt(0)" ::: "memory");
    } else {
      XB_SPIN(xb_ld(&bar[XB_XGEN(b.x)]) == gen, bar);
      __builtin_amdgcn_fence(__ATOMIC_ACQUIRE, "agent");
      asm volatile("s_waitcnt vmcnt(0)" ::: "memory");
    }
  }
  __syncthreads();
}

namespace pg8 {
#define PG8_LAS __attribute__((address_space(3)))
typedef unsigned short bf16_t;
typedef short bf16x8 __attribute__((ext_vector_type(8)));
typedef float f32x4 __attribute__((ext_vector_type(4)));
typedef unsigned u32x4 __attribute__((ext_vector_type(4)));
constexpr int BM = 256, BK = 64, HALF = 128, HTB = HALF * BK * 2  , STAGE_BYTES = 8 * HTB, NXCD = 8, WGM = 8;

__host__ __device__ __forceinline__ int lds_byte(int r, int c) { const int st = (r >> 4) * 2 + (c >> 5), rr = r & 15, cc = c & 31, ob = rr * 64 + cc * 2; return st * 1024 + (ob ^ (((ob >> 9) & 1) << 5)); }
__host__ __device__ __forceinline__ void stage_rc(int b, int& R, int& C) { const int st = b / 1024, sb = b % 1024, swz = sb ^ (((sb >> 9) & 1) << 5); R = (st >> 1) * 16 + swz / 64; C = (st & 1) * 32 + (swz % 64) / 2; }
__host__ __device__ __forceinline__ int perm32(int rho) { const int n = rho >> 4, i = rho & 15; return 8 * (i >> 2) + 4 * n + (i & 3); }

struct Unit { int pm, pn; };
struct Gemm { const bf16_t* A; const bf16_t* Bt; int M, N, K; };

struct StaticOrder {
    int nM, nN, nwg, G, c;
    __host__ __device__ void init(int M, int N, int G_, int c_) { nM = M / BM; nN = N / BM; nwg = nM * nN; G = G_; c = c_; }
    __host__ __device__ bool next(int i, Unit& u) const {
        const long L = (long)i * G + c; if (L >= nwg) return false;
        int wgid = (int)L; { const int q = nwg / NXCD, r = nwg % NXCD, xcd = wgid % NXCD, off = wgid / NXCD; wgid = (xcd < r ? xcd * (q + 1) : r * (q + 1) + (xcd - r) * q) + off; }
        const int nig = WGM * nN, gid = wgid / nig, fm = gid * WGM, gsz = (nM - fm) < WGM ? (nM - fm) : WGM;
        u.pm = fm + ((wgid % nig) % gsz); u.pn = (wgid % nig) / gsz; return true;
    }
    __device__ __forceinline__ void a_ready(const Unit&) const {}
    __device__ __forceinline__ void done(const Unit&) const {}
};

template <class Epi, class Sched, bool STAMP = false>
__device__ __forceinline__ void gemm_phase(PG8_LAS unsigned char* lds, const Gemm g, const Sched& S, const Epi& E, unsigned long long* stamps) {
    int tid_ = threadIdx.x; asm volatile("" : "+v"(tid_));
    const int tid = tid_, wid = __builtin_amdgcn_readfirstlane(tid >> 6), lane = tid & 63, wr = wid >> 2, wc = wid & 3, fr = lane & 15, fq = lane >> 4;
    const int K = g.K, nt = K / BK;
    int ts_lo = 0, ts_hi = 0, nts = 0; const unsigned long long rt_entry = STAMP ? (unsigned long long)wall_clock64() : 0ull;
#define PG8_STAMP() do { if (STAMP && wid == 0 && nts < 64) { const unsigned long long _c = (unsigned long long)clock64(); \
        ts_lo = (lane == nts) ? (int)(unsigned)_c : ts_lo; ts_hi = (lane == nts) ? (int)(unsigned)(_c >> 32) : ts_hi; ++nts; } } while (0)
    PG8_STAMP();
    unsigned voffA[2], voffB[2];
#pragma unroll
    for (int i = 0; i < 2; ++i) { int R, C; stage_rc(tid * 16 + i * 8192, R, C); const int Rb = Epi::PERM ? ((R & ~31) + perm32(R & 31)) : R;
        voffA[i] = (unsigned)(R * K + C) * 2u; voffB[i] = (unsigned)(Rb * K + C) * 2u; }
    const size_t kstep = (size_t)(BK * 2);
    const size_t hstep = (size_t)HALF * K * 2;
    const size_t tstep = 2 * hstep;
    const unsigned ldsw = (unsigned)wid * 1024u;
    const int aoff = lds_byte(wr * 64 + fr, fq * 8), boff = lds_byte(wc * 32 + fr, fq * 8);
#define PG8_SA(b, h) (((b) * 2 + (h)) * HTB)
#define PG8_SB(b, h) ((4 + (b) * 2 + (h)) * HTB)
#define PG8_STAGE(bufoff, gbase, voff) do { _Pragma("unroll") for (int _i = 0; _i < 2; ++_i) \
        __builtin_amdgcn_global_load_lds((const unsigned*)((const char*)(gbase) + (voff)[_i]), (PG8_LAS unsigned*)(lds + (bufoff) + ldsw + _i * 8192), 16, 0, 0); } while (0)
#define PG8_LDA(dst, b, h) do { _Pragma("unroll") for (int m = 0; m < 4; ++m) _Pragma("unroll") for (int k = 0; k < 2; ++k) dst[m][k] = *(const PG8_LAS bf16x8*)(lds + PG8_SA(b, h) + aoff + m * 2048 + k * 1024); } while (0)
#define PG8_LDB(dst, b, h) do { _Pragma("unroll") for (int n = 0; n < 2; ++n) _Pragma("unroll") for (int k = 0; k < 2; ++k) dst[n][k] = *(const PG8_LAS bf16x8*)(lds + PG8_SB(b, h) + boff + n * 2048 + k * 1024); } while (0)
#define PG8_MMA(ai, bj, At, Bt) do { __builtin_amdgcn_s_setprio(1); _Pragma("unroll") for (int m = 0; m < 4; ++m) _Pragma("unroll") for (int n = 0; n < 2; ++n) _Pragma("unroll") for (int k = 0; k < 2; ++k) \
        acc[ai][bj][m][n] = __builtin_amdgcn_mfma_f32_16x16x32_bf16(Bt[n][k], At[m][k], acc[ai][bj][m][n], 0, 0, 0); __builtin_amdgcn_s_setprio(0); } while (0)
#define PG8_WAIT_V(n) asm volatile("s_waitcnt vmcnt(" #n ")" ::: "memory")
#define PG8_WAIT_L(n) asm volatile("s_waitcnt lgkmcnt(" #n ")" ::: "memory")
#define PG8_BAR __builtin_amdgcn_s_barrier()
#define PG8_SCHED __builtin_amdgcn_sched_barrier(0)
    Unit cur, nxt; int ui = 0;
    if (!S.next(0, cur)) return;
    f32x4 acc[2][2][4][2];
#pragma unroll
    for (int a = 0; a < 2; ++a)
#pragma unroll
        for (int b = 0; b < 2; ++b)
#pragma unroll
            for (int m = 0; m < 4; ++m)
#pragma unroll
                for (int n = 0; n < 2; ++n) acc[a][b][m][n] = (f32x4){0.f, 0.f, 0.f, 0.f};
    bf16x8 At[4][2], B0[2][2], B1[2][2];
    const char* cA = (const char*)g.A + (size_t)cur.pm * tstep; const char* cB = (const char*)g.Bt + (size_t)cur.pn * tstep;
    S.a_ready(cur);
    PG8_STAGE(PG8_SB(0, 0), cB, voffB); PG8_STAGE(PG8_SA(0, 0), cA, voffA); PG8_STAGE(PG8_SB(0, 1), cB + hstep, voffB); PG8_STAGE(PG8_SA(0, 1), cA + hstep, voffA);
    if (wr == 1) PG8_BAR;
    PG8_WAIT_V(4); PG8_BAR;
    PG8_STAGE(PG8_SB(1, 0), cB + kstep, voffB); PG8_STAGE(PG8_SA(1, 0), cA + kstep, voffA); PG8_STAGE(PG8_SB(1, 1), cB + hstep + kstep, voffB);
    PG8_WAIT_V(6); PG8_BAR;
    PG8_STAMP();
    for (;;) {
        const bool has_next = S.next(ui + 1, nxt);
        const char* nA = has_next ? (const char*)g.A + (size_t)nxt.pm * tstep : cA; const char* nB = has_next ? (const char*)g.Bt + (size_t)nxt.pn * tstep : cB;
        for (int t = 0; t < nt; t += 2) {
            const bool last = (t == nt - 2);
            const char* a1 = cA + (size_t)(t + 1) * kstep;
            const char* a2 = last ? nA : cA + (size_t)(t + 2) * kstep; const char* b2 = last ? nB : cB + (size_t)(t + 2) * kstep;
            const char* a3 = a2 + kstep; const char* b3 = b2 + kstep;
            if (last && has_next) S.a_ready(nxt);
            PG8_LDB(B0, 0, 0); PG8_SCHED; PG8_LDA(At, 0, 0); PG8_STAGE(PG8_SA(1, 1), a1 + hstep, voffA);
            PG8_WAIT_L(8); PG8_BAR; PG8_WAIT_L(0); PG8_MMA(0, 0, At, B0); PG8_BAR; PG8_SCHED;
            PG8_LDB(B1, 0, 1); PG8_STAGE(PG8_SB(0, 0), b2, voffB);
            PG8_BAR; PG8_WAIT_L(0); PG8_MMA(0, 1, At, B1); PG8_BAR;
            PG8_LDA(At, 0, 1); PG8_STAGE(PG8_SA(0, 0), a2, voffA);
            PG8_BAR; PG8_WAIT_L(0); PG8_MMA(1, 0, At, B0); PG8_BAR; PG8_SCHED;
            PG8_STAGE(PG8_SB(0, 1), b2 + hstep, voffB);
            PG8_WAIT_V(6); PG8_BAR; PG8_MMA(1, 1, At, B1); PG8_BAR;
            PG8_LDB(B0, 1, 0); PG8_SCHED; PG8_LDA(At, 1, 0); PG8_STAGE(PG8_SA(0, 1), a2 + hstep, voffA);
            PG8_WAIT_L(8); PG8_BAR; PG8_WAIT_L(0); PG8_MMA(0, 0, At, B0); PG8_BAR; PG8_SCHED;
            PG8_LDB(B1, 1, 1); PG8_STAGE(PG8_SB(1, 0), b3, voffB);
            PG8_BAR; PG8_WAIT_L(0); PG8_MMA(0, 1, At, B1); PG8_BAR;
            PG8_LDA(At, 1, 1); PG8_STAGE(PG8_SA(1, 0), a3, voffA);
            PG8_BAR; PG8_WAIT_L(0); PG8_MMA(1, 0, At, B0); PG8_BAR; PG8_SCHED;
            PG8_STAGE(PG8_SB(1, 1), b3 + hstep, voffB);
            PG8_WAIT_V(6); PG8_BAR; PG8_MMA(1, 1, At, B1); PG8_BAR;
        }
        PG8_STAMP();
        if constexpr (!Epi::AFTER_DRAIN) { E(acc, cur, wr, wc, fr, fq); S.done(cur); }
        PG8_STAMP();
        if (!has_next) break;
#pragma unroll
        for (int a = 0; a < 2; ++a)
#pragma unroll
            for (int b = 0; b < 2; ++b)
#pragma unroll
                for (int m = 0; m < 4; ++m)
#pragma unroll
                    for (int n = 0; n < 2; ++n) acc[a][b][m][n] = (f32x4){0.f, 0.f, 0.f, 0.f};
        cur = nxt; cA = nA; cB = nB; ++ui;
    }
    PG8_WAIT_V(0);
    if (wr == 0) PG8_BAR;
    PG8_BAR;
    if constexpr (Epi::AFTER_DRAIN) { E.fused(acc, cur, wr, wc, fr, fq, lds, wid, lane); S.done(cur); }
    PG8_STAMP();
    if (STAMP && wid == 0) { stamps[lane] = lane < nts ? (((unsigned long long)(unsigned)ts_hi << 32) | (unsigned)ts_lo) : 0ull;
        if (lane == 62) stamps[62] = rt_entry; if (lane == 63) stamps[63] = (unsigned long long)wall_clock64(); }
#undef PG8_STAMP
#undef PG8_SA
#undef PG8_SB
#undef PG8_STAGE
#undef PG8_LDA
#undef PG8_LDB
#undef PG8_MMA
#undef PG8_WAIT_V
#undef PG8_WAIT_L
#undef PG8_BAR
#undef PG8_SCHED
}
}


#define PG_EPI_ROWS(ROWBODY)                                                                     \
  _Pragma("unroll") for (int ai = 0; ai < 2; ++ai) _Pragma("unroll") for (int m = 0; m < 4; ++m) { \
    int row = u.pm * 256 + ai * 128 + wr * 64 + m * 16 + fr;                                      \
    asm volatile("" : "+v"(row));                                                                 \
    ROWBODY                                                                                       \
    asm volatile("" ::: "memory"); }
#define PG_EPI_COLS(COLBODY)                                                                      \
  _Pragma("unroll") for (int bj = 0; bj < 2; ++bj) _Pragma("unroll") for (int n = 0; n < 2; ++n) { \
    const int col = u.pn * 256 + bj * 128 + wc * 32 + 8 * fq + 4 * n;                             \
    const f32x4 v = acc[ai][bj][m][n];                                                            \
    COLBODY }
typedef const f32x4 (&PgAcc)[2][2][4][2];
#define PG_ROW_OF(r) (u.pm * 256 + ((r) >> 2) * 128 + wr * 64 + ((r) & 3) * 16 + fr)
#define PG_EPI_PIPELINED(LOADS, USE)                                                            \
  {                                                                                             \
    const int colb = u.pn * 256 + wc * 32 + 8 * fq;                                             \
    int row = PG_ROW_OF(0);                                                                     \
    asm volatile("" : "+v"(row));                                                               \
    { const int lrow = row; _Pragma("unroll") for (int c = 0; c < 4; ++c) { const int slot = 0; const unsigned off = (unsigned)(lrow * DM + colb + (c >> 1) * 128 + (c & 1) * 4); LOADS } } \
    _Pragma("unroll") for (int r = 0; r < 8; ++r) {                                             \
      int rown = PG_ROW_OF((r + 1) & 7);                                                        \
      asm volatile("" : "+v"(rown));                                                            \
      if (r < 7) { const int lrow = rown; _Pragma("unroll") for (int c = 0; c < 4; ++c) { const int slot = (r + 1) & 1; const unsigned off = (unsigned)(lrow * DM + colb + (c >> 1) * 128 + (c & 1) * 4); LOADS } } \
      _Pragma("unroll") for (int c = 0; c < 4; ++c) {                                           \
        const int slot = r & 1;                                                                 \
        const unsigned off = (unsigned)(row * DM + colb + (c >> 1) * 128 + (c & 1) * 4);       \
        const f32x4 v = acc[r >> 2][c >> 1][r & 3][c & 1];                                      \
        USE }                                                                                   \
      asm volatile("" ::: "memory");                                                            \
      row = rown;                                                                               \
    }                                                                                           \
  }
DEVI bf16x4 to_bf4(f32x4 v) { bf16x4 o; o[0] = (bf16)v.x; o[1] = (bf16)v.y; o[2] = (bf16)v.z; o[3] = (bf16)v.w; return o; }
template <class Epi> DEVI void run_gemm(unsigned char* smem, const bf16* A, const bf16* Bt, int M, int N, int K, const Epi& E) {
  pg8::Gemm g; g.A = (const pg8::bf16_t*)A; g.Bt = (const pg8::bf16_t*)Bt; g.M = M; g.N = N; g.K = K;
  pg8::StaticOrder S; S.init(M, N, (int)gridDim.x, (int)blockIdx.x);
  pg8::gemm_phase<Epi, pg8::StaticOrder, false>((PG8_LAS unsigned char*)smem, g, S, E, nullptr);
}

template <int MTILES, int NTILES, int R>
DEVI bool tile_map(int it, int& mt, int& nt) {
  const int xcd = blockIdx.x & 7, slot = blockIdx.x >> 3, nslots = gridDim.x >> 3;
  const int L = it * nslots + slot;
  if (L >= (MTILES / 8) * NTILES) return false;
  const int group = L / (R * NTILES), rem = L % (R * NTILES);
  nt = rem / R;
  mt = (group * R + (rem % R)) * 8 + xcd;
  return true;
}

DEVI void transpose_job(const float* __restrict__ src, int ld, int n0, int nvalid, int npad, int K, bf16* __restrict__ dst, float* smf, const float* __restrict__ kscale = nullptr) {
  const int vb = threadIdx.x >> 8, tid = threadIdx.x & 255;
  float* sm = smf + vb * (64 * 65);
  const int ktiles = K >> 6, ntiles = (npad >> 6) * ktiles;
  const int ty = tid >> 4, tx = tid & 15;
  for (int base = blockIdx.x * 2; base < ntiles; base += gridDim.x * 2) {
    const int tile = base + vb;
    const bool ok = tile < ntiles;
    const int nb = (tile / ktiles) << 6, kb = (tile % ktiles) << 6;
    if (ok) {
#pragma unroll
      for (int i = 0; i < 4; ++i) {
        const int k = kb + ty + 16 * i, n = nb + tx * 4;
        f32x4 v = mk_f4(0.f, 0.f, 0.f, 0.f);
        if (n < nvalid) v = *(const f32x4*)(src + (size_t)k * ld + n0 + n);
        if (kscale) v = v * kscale[k];
        float* q = sm + (ty + 16 * i) * 65 + tx * 4;
        q[0] = v.x; q[1] = v.y; q[2] = v.z; q[3] = v.w;
      }
    }
    __syncthreads();
    if (ok) {
      const int n = tid >> 2, kq = tid & 3;
      bf16x8 o0, o1;
#pragma unroll
      for (int j = 0; j < 8; ++j) {
        o0[j] = (bf16)sm[(kq * 16 + j) * 65 + n];
        o1[j] = (bf16)sm[(kq * 16 + 8 + j) * 65 + n];
      }
      bf16* d = dst + (size_t)(nb + n) * K + kb + kq * 16;
      *(bf16x8*)d = o0;
      *(bf16x8*)(d + 8) = o1;
    }
    __syncthreads();
  }
}

DEVI void convert_job(const float* __restrict__ src, bf16* __restrict__ dst, size_t n) {
  const size_t n4 = n >> 2;
  for (size_t i = (size_t)blockIdx.x * NTHREADS + threadIdx.x; i < n4; i += (size_t)gridDim.x * NTHREADS) {
    const f32x4 v = ((const f32x4*)src)[i];
    bf16x4 o; o[0] = (bf16)v.x; o[1] = (bf16)v.y; o[2] = (bf16)v.z; o[3] = (bf16)v.w;
    ((bf16x4*)dst)[i] = o;
  }
}


DEVI void fp4_rows_job(const float* __restrict__ src, unsigned char* __restrict__ dst, float* __restrict__ inv, const float* __restrict__ cscale = nullptr) {
  const int lane = threadIdx.x & 63;
  const int gw = blockIdx.x * NWAVES + (threadIdx.x >> 6), nw = gridDim.x * NWAVES;
  for (int r = gw; r < 16384; r += nw) {
    const float* sp = src + (size_t)r * 1024 + lane * 16;
    f32x4 v[4];
    float mx = 0.f;
#pragma unroll
    for (int i = 0; i < 4; ++i) {
      v[i] = *(const f32x4*)(sp + i * 4);
      if (cscale) v[i] = v[i] * *(const f32x4*)(cscale + lane * 16 + i * 4);
      mx = fmaxf(mx, fmaxf(fmaxf(fabsf(v[i].x), fabsf(v[i].y)), fmaxf(fabsf(v[i].z), fabsf(v[i].w))));
    }
#pragma unroll
    for (int o = 32; o > 0; o >>= 1) mx = fmaxf(mx, __shfl_xor(mx, o, 64));
    const float sc = (mx > 0.f) ? 6.f / mx : 1.f;
    u32x2 o2;
#pragma unroll
    for (int d = 0; d < 2; ++d) {
      unsigned w = 0u;
      w = __builtin_amdgcn_cvt_scalef32_pk_fp4_f32(w, v[2 * d].x * sc, v[2 * d].y * sc, 1.0f, 0);
      w = __builtin_amdgcn_cvt_scalef32_pk_fp4_f32(w, v[2 * d].z * sc, v[2 * d].w * sc, 1.0f, 1);
      w = __builtin_amdgcn_cvt_scalef32_pk_fp4_f32(w, v[2 * d + 1].x * sc, v[2 * d + 1].y * sc, 1.0f, 2);
      w = __builtin_amdgcn_cvt_scalef32_pk_fp4_f32(w, v[2 * d + 1].z * sc, v[2 * d + 1].w * sc, 1.0f, 3);
      o2[d] = w;
    }
    *(u32x2*)(dst + (size_t)r * 512 + lane * 8) = o2;
    if (lane == 0) inv[r] = 1.f / sc;
  }
}

DEVI void rmsnorm_rows_bf16(const float* src, const float* __restrict__ gain, bf16* __restrict__ dst) {
  const int lane = threadIdx.x & 63;
  const int gw = blockIdx.x * NWAVES + (threadIdx.x >> 6), nw = gridDim.x * NWAVES;
  f32x4 gn[4];
#pragma unroll
  for (int i = 0; i < 4; ++i) gn[i] = *(const f32x4*)(gain + i * 256 + lane * 4);
  for (int t = gw; t < T_TOK; t += nw) {
    const float* xr = src + (size_t)t * DM;
    f32x4 v[4];
    float ss = 0.f;
#pragma unroll
    for (int i = 0; i < 4; ++i) {
      v[i] = *(const f32x4*)(xr + i * 256 + lane * 4);
      ss += v[i].x * v[i].x + v[i].y * v[i].y + v[i].z * v[i].z + v[i].w * v[i].w;
    }
    ss = wave_sum(ss);
    const float rs = rsqrtf(ss * (1.f / DM) + 1e-6f);
#pragma unroll
    for (int i = 0; i < 4; ++i) {
      bf16x4 o;
      o[0] = (bf16)(v[i].x * rs * gn[i].x); o[1] = (bf16)(v[i].y * rs * gn[i].y);
      o[2] = (bf16)(v[i].z * rs * gn[i].z); o[3] = (bf16)(v[i].w * rs * gn[i].w);
      *(bf16x4*)(dst + (size_t)t * DM + i * 256 + lane * 4) = o;
    }
  }
}

DEVI void rmsnorm_rows_bf16_from_bf16(const bf16* __restrict__ src, const float* __restrict__ gain, bf16* __restrict__ dst) {
  const int lane = threadIdx.x & 63;
  const int gw = blockIdx.x * NWAVES + (threadIdx.x >> 6), nw = gridDim.x * NWAVES;
  f32x4 gn[4];
#pragma unroll
  for (int i = 0; i < 4; ++i) gn[i] = *(const f32x4*)(gain + i * 256 + lane * 4);
  for (int t = gw; t < T_TOK; t += nw) {
    const bf16* xr = src + (size_t)t * DM;
    bf16x4 v[4];
    float ss = 0.f;
#pragma unroll
    for (int i = 0; i < 4; ++i) {
      v[i] = *(const bf16x4*)(xr + i * 256 + lane * 4);
#pragma unroll
      for (int j = 0; j < 4; ++j) ss += (float)v[i][j] * (float)v[i][j];
    }
    ss = wave_sum(ss);
    const float rs = rsqrtf(ss * (1.f / DM) + 1e-6f);
#pragma unroll
    for (int i = 0; i < 4; ++i) {
      bf16x4 o;
      o[0] = (bf16)((float)v[i][0] * rs * gn[i].x); o[1] = (bf16)((float)v[i][1] * rs * gn[i].y);
      o[2] = (bf16)((float)v[i][2] * rs * gn[i].z); o[3] = (bf16)((float)v[i][3] * rs * gn[i].w);
      *(bf16x4*)(dst + (size_t)t * DM + i * 256 + lane * 4) = o;
    }
  }
}

DEVI void phase0(const ParamsG& p, unsigned char* smem) {
  unsigned char* ws = gp(p.ws);
  float* smf = (float*)smem;
#define TJOB(SRC, LD, N0, NVALID, NPAD, KK, OFF) transpose_job((SRC), (LD), (N0), (NVALID), (NPAD), (KK), (bf16*)(ws + (OFF)), smf);
  TJOB(gp(p.w_in), IN_COLS, 0, 2464, 2560, 1024, OFF_WIN_T)
  TJOB(gp(p.w_in), IN_COLS, 2464, 2048, 2048, 1024, OFF_WG_T)
  TJOB(gp(p.rw_w_o), 1024, 0, 1024, 1024, 512, OFF_RWO_T)
  TJOB(gp(p.mla_w_o), 1024, 0, 1024, 1024, 512, OFF_MLO_T)
  TJOB(gp(p.mla_w_uq), 768, 0, 768, 768, 384, OFF_WUQ_T)
  TJOB(gp(p.mla_w_ukv), 1024, 0, 1024, 1024, 256, OFF_WUKV_T)
  TJOB(gp(p.w_out), 1024, 0, 1024, 1024, 1024, OFF_WOUT_T)
  transpose_job(gp(p.peer_w_q), 2048, 0, 2048, 2048, 1024, (bf16*)(ws + OFF_WQ_T), smf, gp(p.norm_ffn));
  TJOB(gp(p.ple_w_gate), 1024, 0, 1024, 1024, 1024, OFF_PG_T)
  TJOB(gp(p.ple_w_proj), 1024, 0, 1024, 1024, 256, OFF_PP_T)
#undef TJOB
  {
    bf16* wl = (bf16*)(ws + OFF_WLORA_T);
    for (int i = blockIdx.x * NTHREADS + threadIdx.x; i < 1536 * 256; i += gridDim.x * NTHREADS) {
      const int n = i >> 8, k = i & 255;
      float v = 0.f;
      if (n < 512) { if (k < 64) v = gp(p.rw_w2)[k * 512 + n]; }
      else if (n < 1024) { if (k >= 64 && k < 128) v = gp(p.rw_a2)[(k - 64) * 512 + (n - 512)]; }
      else { if (k >= 128) v = gp(p.rw_g2)[(k - 128) * 512 + (n - 1024)]; }
      wl[i] = (bf16)v;
    }
  }
  convert_job(gp(p.peer_sub_keys), (bf16*)(ws + OFF_SK), (size_t)8 * 2 * 128 * 128);
  fp4_rows_job(gp(p.peer_u), ws + OFF_U8, (float*)(ws + OFF_IUS), gp(p.norm_ffn));
  fp4_rows_job(gp(p.peer_v), ws + OFF_V8, (float*)(ws + OFF_IVS));
  convert_job(gp(p.p), (bf16*)(ws + OFF_PBF), (size_t)T_TOK * 256);
  rmsnorm_rows_bf16(gp(p.x), gp(p.norm_mix), (bf16*)(ws + OFF_H1));
  {
    float* cs = (float*)(ws + OFF_CS);
    float* sn = (float*)(ws + OFF_SN);
    for (int i = blockIdx.x * NTHREADS + threadIdx.x; i < T_TOK * 16; i += gridDim.x * NTHREADS) {
      const int t = i >> 4, f = i & 15;
      const float inv = powf(10000.f, -(float)(2 * f) / 32.f);
      const float ang = (float)gp(p.pos)[t] * inv;
      double s, c;
      sincos((double)ang, &s, &c);
      cs[i] = (float)c; sn[i] = (float)s;
    }
  }
  if (blockIdx.x == 0 && threadIdx.x < 64) ((unsigned*)(ws + OFF_CNT))[threadIdx.x] = 0u;
  if (blockIdx.x == 0) for (int i = threadIdx.x; i < XCD_BAR_WORDS; i += NTHREADS) ((unsigned*)(ws + OFF_BAR))[i] = 0u;
}

struct EpiZ {
  static constexpr bool PERM = true, AFTER_DRAIN = false;
  bf16* zrw; bf16* zmla;
  DEVI void operator()(PgAcc acc, const pg8::Unit& u, int wr, int wc, int fr, int fq) const {
    PG_EPI_ROWS(PG_EPI_COLS(
      if (col < RWC) *(bf16x4*)(zrw + (unsigned)(row * RWC + col)) = to_bf4(v);
      else if (col < RWC + MLC) *(bf16x4*)(zmla + (unsigned)(row * MLC + (col - RWC))) = to_bf4(v);
    ))
  }
};
DEVI void phase1(const ParamsG& p, unsigned char* smem) {
  EpiZ e; e.zrw = (bf16*)(gp(p.ws) + OFF_ZRW); e.zmla = (bf16*)(gp(p.ws) + OFF_ZMLA);
  run_gemm(smem, (const bf16*)(gp(p.ws) + OFF_H1), (const bf16*)(gp(p.ws) + OFF_WIN_T), T_TOK, 2560, DM, e);
}

DEVI void phase2a(const ParamsG& p) {
  const int lane = threadIdx.x & 63;
  const int gw = blockIdx.x * NWAVES + (threadIdx.x >> 6), nw = gridDim.x * NWAVES;
  const bf16* zrw = (const bf16*)(gp(p.ws) + OFF_ZRW);
  const bf16* zmla = (const bf16*)(gp(p.ws) + OFF_ZMLA);
  bf16* lora = (bf16*)(gp(p.ws) + OFF_LORA);
  bf16* cq = (bf16*)(gp(p.ws) + OFF_CQ);
  bf16* ckv = (bf16*)(gp(p.ws) + OFF_CKV);
  bf16* Kd = (bf16*)((unsigned char*)gp(p.out) + OFF_K);
  const float* cs = (const float*)(gp(p.ws) + OFF_CS);
  const float* sn = (const float*)(gp(p.ws) + OFF_SN);
  const f32x4 mu = *(const f32x4*)(gp(p.rw_mu) + 1536 + lane * 4);
  const f32x4 qg0 = *(const f32x4*)(gp(p.mla_q_norm) + lane * 4);
  const f32x2 qg1 = *(const f32x2*)(gp(p.mla_q_norm) + 256 + lane * 2);
  const f32x4 kg = *(const f32x4*)(gp(p.mla_kv_norm) + lane * 4);
  const float mua[4] = {mu.x, mu.y, mu.z, mu.w};
  for (int t = gw; t < T_TOK; t += nw) {
    const int s = t & (SEQ - 1), b = t >> 12;
    {
      const bf16* zp = zrw + (size_t)t * RWC + 1536 + lane * 4;
      const bf16x4 zc = *(const bf16x4*)zp;
      bf16x4 zv;
      if (s > 0) zv = *(const bf16x4*)(zp - RWC);
      else { zv[0] = (bf16)0.f; zv[1] = (bf16)0.f; zv[2] = (bf16)0.f; zv[3] = (bf16)0.f; }
      bf16x4 o;
#pragma unroll
      for (int j = 0; j < 4; ++j) {
        const float c = (float)zc[j], pv = (float)zv[j];
        const float zs = c + mua[j] * (pv - c);
        float val;
        if (lane < 16) val = tanhf(zs);
        else if (lane < 32) val = zs;
        else val = sigmoid_f(zs);
        o[j] = (bf16)val;
      }
      *(bf16x4*)(lora + (size_t)t * 256 + lane * 4) = o;
    }
    {
      const bf16* zq = zmla + (size_t)t * MLC;
      const bf16x4 q0 = *(const bf16x4*)(zq + lane * 4);
      const bf16x2 q1 = *(const bf16x2*)(zq + 256 + lane * 2);
      float f[6] = {(float)q0[0], (float)q0[1], (float)q0[2], (float)q0[3], (float)q1[0], (float)q1[1]};
      float ss = 0.f;
#pragma unroll
      for (int j = 0; j < 6; ++j) ss += f[j] * f[j];
      ss = wave_sum(ss);
      const float rs = rsqrtf(ss * (1.f / 384.f) + 1e-6f);
      bf16x4 o0; bf16x2 o1;
      o0[0] = (bf16)(f[0] * rs * qg0.x); o0[1] = (bf16)(f[1] * rs * qg0.y);
      o0[2] = (bf16)(f[2] * rs * qg0.z); o0[3] = (bf16)(f[3] * rs * qg0.w);
      o1[0] = (bf16)(f[4] * rs * qg1.x); o1[1] = (bf16)(f[5] * rs * qg1.y);
      *(bf16x4*)(cq + (size_t)t * 384 + lane * 4) = o0;
      *(bf16x2*)(cq + (size_t)t * 384 + 256 + lane * 2) = o1;
    }
    {
      const bf16x4 k0 = *(const bf16x4*)(zmla + (size_t)t * MLC + 384 + lane * 4);
      float f[4] = {(float)k0[0], (float)k0[1], (float)k0[2], (float)k0[3]};
      float ss = f[0] * f[0] + f[1] * f[1] + f[2] * f[2] + f[3] * f[3];
      ss = wave_sum(ss);
      const float rs = rsqrtf(ss * (1.f / 256.f) + 1e-6f);
      bf16x4 o;
      o[0] = (bf16)(f[0] * rs * kg.x); o[1] = (bf16)(f[1] * rs * kg.y);
      o[2] = (bf16)(f[2] * rs * kg.z); o[3] = (bf16)(f[3] * rs * kg.w);
      *(bf16x4*)(ckv + (size_t)t * 256 + lane * 4) = o;
    }
    {
      const float xr = (float)zmla[(size_t)t * MLC + 640 + (lane & 31)];
      const float xp = __shfl_xor(xr, 16, 64);
      const int f = lane & 15;
      const float c = cs[t * 16 + f], sv = sn[t * 16 + f];
      const float o = (lane & 16) ? (xr * c + xp * sv) : (xr * c - xp * sv);
      if (lane < 32) {
        const bf16 ob = (bf16)o;
#pragma unroll
        for (int h = 0; h < 8; ++h) Kd[((size_t)(b * 8 + h) * SEQ + s) * 96 + 64 + lane] = ob;
      }
    }
  }
}

constexpr float QSCALE = 0.14724444f;
template <bool SSQ = false>
DEVI void route_mainloop(f32x16 (&acc)[4], const bf16* __restrict__ A, int lda, const bf16* __restrict__ B, int ldb, int nk, unsigned char* base,
                         const bf16* __restrict__ sk = nullptr, float* ssq = nullptr, int s0 = 0, bool primed = false) {
  const int tid = threadIdx.x, lane = tid & 63, w = tid >> 6;
  unsigned ao[2], bo[4];
#pragma unroll
  for (int i = 0; i < 2; ++i) { const int r = (w + 8 * i) * 8 + (lane >> 3); ao[i] = (unsigned)(r * lda + (((lane & 7) ^ ((r >> 1) & 7)) * 8)) * 2u; }
#pragma unroll
  for (int i = 0; i < 4; ++i) { const int r = (w + 8 * i) * 8 + (lane >> 3); bo[i] = (unsigned)(r * ldb + (((lane & 7) ^ ((r >> 1) & 7)) * 8)) * 2u; }
  const int sw = (lane >> 1) & 7, hh = lane >> 5;
  const int arow = (lane & 31) * 128, brow = (w * 32 + (lane & 31)) * 128;
  auto issue = [&](int kt, int slot) {
    unsigned char* nb = base + slot * 49152;
#pragma unroll
    for (int i = 0; i < 2; ++i)
      __builtin_amdgcn_global_load_lds((const unsigned*)((const char*)A + (ao[i] + (unsigned)kt * 128u)), (__attribute__((address_space(3))) unsigned*)(nb + (w + 8 * i) * 1024), 16, 0, 0);
#pragma unroll
    for (int i = 0; i < 4; ++i)
      __builtin_amdgcn_global_load_lds((const unsigned*)((const char*)B + (bo[i] + (unsigned)kt * 128u)), (__attribute__((address_space(3))) unsigned*)(nb + 16384 + (w + 8 * i) * 1024), 16, 0, 0);
  };
  float ss0 = 0.f, ss1 = 0.f;
  if (!primed) {
    __syncthreads();
    issue(0, s0);
    issue(1, s0 == 2 ? 0 : s0 + 1);
  }
  int cur = s0;
  for (int kt = 0; kt < nk; ++kt) {
    if (kt + 1 < nk) asm volatile("s_waitcnt vmcnt(6)" ::: "memory");
    else if (sk) asm volatile("s_waitcnt vmcnt(4)" ::: "memory");
    else asm volatile("s_waitcnt vmcnt(0)" ::: "memory");
    __syncthreads();
    int nx2 = cur + 2; if (nx2 >= 3) nx2 -= 3;
    if (kt + 2 < nk) issue(kt + 2, nx2);
    else if (kt + 2 == nk && sk) {
#pragma unroll
      for (int i = 0; i < 4; ++i) {
        const int r = (w * 4 + i) * 4 + (lane >> 4);
        const int ch = (lane & 15) ^ (r & 15);
        __builtin_amdgcn_global_load_lds((const unsigned*)((const char*)sk + (unsigned)(r * 128 + ch * 8) * 2u), (__attribute__((address_space(3))) unsigned*)(base + nx2 * 49152 + (w * 4 + i) * 1024), 16, 0, 0);
      }
    }
    const unsigned char* cb = base + cur * 49152;
    cur = (cur == 2) ? 0 : cur + 1;
#pragma unroll
    for (int ks = 0; ks < 4; ++ks) {
      const int co = ((ks * 2 + hh) ^ sw) * 16;
      const bf16x8 bfr = *(const bf16x8*)(cb + 16384 + brow + co);
      if (SSQ) {
        const u32x4 bu = __builtin_bit_cast(u32x4, bfr);
        ss0 = dot2bf(bu.x, bu.x, ss0); ss1 = dot2bf(bu.y, bu.y, ss1);
        ss0 = dot2bf(bu.z, bu.z, ss0); ss1 = dot2bf(bu.w, bu.w, ss1);
      }
#pragma unroll
      for (int mt = 0; mt < 4; ++mt) {
        const bf16x8 af = *(const bf16x8*)(cb + arow + mt * 4096 + co);
        acc[mt] = __builtin_amdgcn_mfma_f32_32x32x16_bf16(af, bfr, acc[mt], 0, 0, 0);
      }
    }
  }
  if (SSQ) *ssq = ss0 + ss1;
  if (sk) { asm volatile("s_waitcnt vmcnt(0)" ::: "memory"); __syncthreads(); }
}
DEVI void route_prime(const bf16* __restrict__ A, int lda, const bf16* __restrict__ B, int ldb, unsigned char* base, int s0) {
  const int tid = threadIdx.x, lane = tid & 63, w = tid >> 6;
#pragma unroll
  for (int kt = 0; kt < 2; ++kt) {
    int slot = s0 + kt; if (slot >= 3) slot -= 3;
    unsigned char* nb = base + slot * 49152;
#pragma unroll
    for (int i = 0; i < 2; ++i) {
      const int r = (w + 8 * i) * 8 + (lane >> 3);
      const unsigned ao = (unsigned)(r * lda + (((lane & 7) ^ ((r >> 1) & 7)) * 8)) * 2u;
      __builtin_amdgcn_global_load_lds((const unsigned*)((const char*)A + (ao + (unsigned)kt * 128u)), (__attribute__((address_space(3))) unsigned*)(nb + (w + 8 * i) * 1024), 16, 0, 0);
    }
#pragma unroll
    for (int i = 0; i < 4; ++i) {
      const int r = (w + 8 * i) * 8 + (lane >> 3);
      const unsigned bo = (unsigned)(r * ldb + (((lane & 7) ^ ((r >> 1) & 7)) * 8)) * 2u;
      __builtin_amdgcn_global_load_lds((const unsigned*)((const char*)B + (bo + (unsigned)kt * 128u)), (__attribute__((address_space(3))) unsigned*)(nb + 16384 + (w + 8 * i) * 1024), 16, 0, 0);
    }
  }
}
DEVI void phase2b(const ParamsG& p, unsigned char* smem) {
  unsigned char* ws = gp(p.ws);
  const bf16* LORA = (const bf16*)(ws + OFF_LORA);
  const bf16* CQ = (const bf16*)(ws + OFF_CQ);
  const bf16* CKV = (const bf16*)(ws + OFF_CKV);
  bf16* E = (bf16*)(ws + OFF_E);
  bf16* ICLR = (bf16*)(ws + OFF_ICLR);
  bf16* G = (bf16*)(ws + OFF_G);
  bf16* Qd = (bf16*)((unsigned char*)gp(p.out) + OFF_Q);
  bf16* Kd = (bf16*)((unsigned char*)gp(p.out) + OFF_K);
  bf16* Vd = (bf16*)((unsigned char*)gp(p.out) + OFF_VT);
  const int lane = threadIdx.x & 63, w = threadIdx.x >> 6, hh = lane >> 5;
  for (int it = 0;; ++it) {
    int tm, j;
    if (!tile_map<128, 26, 2>(it, tm, j)) break;
    const int m0 = tm * 256;
    const bf16* A; const bf16* Bm; int K, kind, n0;
    if (j < 12) { kind = 0; n0 = j * 128; K = 256; A = (const bf16*)(ws + OFF_WLORA_T) + (size_t)n0 * 256; Bm = LORA + (size_t)m0 * 256; }
    else if (j < 18) { kind = 1; n0 = (j - 12) * 128; K = 384; A = (const bf16*)(ws + OFF_WUQ_T) + (size_t)n0 * 384; Bm = CQ + (size_t)m0 * 384; }
    else { kind = 2; n0 = (j - 18) * 128; K = 256; A = (const bf16*)(ws + OFF_WUKV_T) + (size_t)n0 * 256; Bm = CKV + (size_t)m0 * 256; }
    f32x16 acc[4];
#pragma unroll
    for (int mt = 0; mt < 4; ++mt)
#pragma unroll
      for (int r = 0; r < 16; ++r) acc[mt][r] = 0.f;
    route_mainloop(acc, A, K, Bm, K, K >> 6, smem);
    {
      bf16* wb = (bf16*)(smem + w * 8704);
      __syncthreads();
#pragma unroll
      for (int mt = 0; mt < 4; ++mt)
#pragma unroll
        for (int rg = 0; rg < 4; ++rg) {
          f32x4 v; v.x = acc[mt][4 * rg + 0]; v.y = acc[mt][4 * rg + 1]; v.z = acc[mt][4 * rg + 2]; v.w = acc[mt][4 * rg + 3];
          if (kind == 1) v = v * QSCALE;
          *(bf16x4*)(wb + (lane & 31) * 136 + mt * 32 + 8 * rg + 4 * hh) = to_bf4(v);
        }
      __builtin_amdgcn_fence(__ATOMIC_RELEASE, "wavefront");
#pragma unroll
      for (int ps = 0; ps < 8; ++ps) {
        const int tl = ps * 4 + (lane >> 4), f0 = (lane & 15) * 8;
        const u32x4 v = *(const u32x4*)(wb + tl * 136 + f0);
        const size_t tok = (size_t)m0 + w * 32 + tl;
        const size_t bb = tok >> 12, ss = tok & (SEQ - 1);
        if (kind == 0) {
          bf16* D = (n0 < 512) ? E : ((n0 < 1024) ? ICLR : G);
          *(u32x4*)(D + tok * 512 + (n0 & 511) + f0) = v;
        } else if (kind == 1) {
          const int f = n0 + f0, head = f / 96, d = f - head * 96;
          *(u32x4*)(Qd + ((bb * 8 + head) * SEQ + ss) * 96 + d) = v;
        } else {
          const int head = n0 >> 7;
          if (f0 < 64) *(u32x4*)(Kd + ((bb * 8 + head) * SEQ + ss) * 96 + f0) = v;
          else *(u32x4*)(Vd + ((bb * 8 + head) * SEQ + ss) * 64 + (f0 - 64)) = v;
        }
      }
    }
  }
}

struct ScanBuf { float A[16][64], B[16][64], W[16][64], K2[16][64], R[16][64]; float V[16][16]; };
DEVI void phase3a(const ParamsG& p, unsigned char* smem) {
  ScanBuf* sb = (ScanBuf*)smem;
  const bf16* zrw = (const bf16*)(gp(p.ws) + OFF_ZRW);
  const bf16* E = (const bf16*)(gp(p.ws) + OFF_E);
  const bf16* ICLR = (const bf16*)(gp(p.ws) + OFF_ICLR);
  bf16* YRAW = (bf16*)(gp(p.ws) + OFF_YRAW);
  float* RK = (float*)(gp(p.ws) + OFF_RK);
  const int role = threadIdx.x >> 8;
  const int tid = threadIdx.x & 255, lane = tid & 63, w = tid >> 6;
  const int pi = tid >> 4, kq = tid & 15;
  const int rloc = 4 * w + (lane >> 4), kg = lane & 15;
  if (role == 0) __builtin_amdgcn_s_setprio(3);
  for (int item = blockIdx.x; item < 256; item += gridDim.x) {
    const int bh = item >> 2, quarter = item & 3, b = bh >> 3, h = bh & 7;
    const int c0 = h * 64 + 4 * kq;
    if (role == 1) {
      const f32x4 mur = *(const f32x4*)(gp(p.rw_mu) + c0);
      const f32x4 muk = *(const f32x4*)(gp(p.rw_mu) + 512 + c0);
      const f32x4 muv = *(const f32x4*)(gp(p.rw_mu) + 1024 + c0);
      const f32x4 kkw = *(const f32x4*)(gp(p.rw_k_k) + c0);
      const f32x4 kaw = *(const f32x4*)(gp(p.rw_k_a) + c0);
      const f32x4 rkw = *(const f32x4*)(gp(p.rw_r_k) + c0);
      const f32x4 w0v = *(const f32x4*)(gp(p.rw_w0) + c0);
      const f32x4 a0v = *(const f32x4*)(gp(p.rw_a0) + c0);
      const float w0_[4] = {w0v.x, w0v.y, w0v.z, w0v.w}, a0_[4] = {a0v.x, a0v.y, a0v.z, a0v.w};
      const float mur_[4] = {mur.x, mur.y, mur.z, mur.w}, muk_[4] = {muk.x, muk.y, muk.z, muk.w},
                  muv_[4] = {muv.x, muv.y, muv.z, muv.w}, kkw_[4] = {kkw.x, kkw.y, kkw.z, kkw.w},
                  kaw_[4] = {kaw.x, kaw.y, kaw.z, kaw.w}, rkw_[4] = {rkw.x, rkw.y, rkw.z, rkw.w};
      bf16x4 zr, zk, zv, pr, pk, pv, ic;
      f32x4 ee;
      auto load_raw = [&](int c) {
        const int s = c * 16 + pi;
        const size_t t = (size_t)b * SEQ + s;
        const bf16* zp = zrw + t * RWC + c0;
        zr = *(const bf16x4*)zp; zk = *(const bf16x4*)(zp + 512); zv = *(const bf16x4*)(zp + 1024);
        if (s > 0) {
          pr = *(const bf16x4*)(zp - RWC); pk = *(const bf16x4*)(zp - RWC + 512); pv = *(const bf16x4*)(zp - RWC + 1024);
        } else {
#pragma unroll
          for (int j = 0; j < 4; ++j) { pr[j] = (bf16)0.f; pk[j] = (bf16)0.f; pv[j] = (bf16)0.f; }
        }
        { const bf16x4 e4 = *(const bf16x4*)(E + t * 512 + c0); ee = mk_f4((float)e4[0], (float)e4[1], (float)e4[2], (float)e4[3]); }
        ic = *(const bf16x4*)(ICLR + t * 512 + c0);
      };
      auto prep = [&](int c) {
        ScanBuf& bf = sb[c & 1];
        const float ee_[4] = {ee.x, ee.y, ee.z, ee.w};
        float r[4], k[4], v[4], kx[4], icl[4];
        float n2 = 0.f;
#pragma unroll
        for (int j = 0; j < 4; ++j) {
          const float zrj = (float)zr[j], zkj = (float)zk[j], zvj = (float)zv[j];
          r[j] = zrj + mur_[j] * ((float)pr[j] - zrj);
          k[j] = zkj + muk_[j] * ((float)pk[j] - zkj);
          v[j] = zvj + muv_[j] * ((float)pv[j] - zvj);
          kx[j] = k[j] * kkw_[j];
          n2 += kx[j] * kx[j];
          icl[j] = sigmoid_f(a0_[j] + (float)ic[j]);
        }
        n2 = row16_allsum(n2);
        const float inv = 1.f / fmaxf(sqrtf(n2), 1e-12f);
        float av[4], bv[4], wv[4], k2[4];
        float rkp = 0.f;
#pragma unroll
        for (int j = 0; j < 4; ++j) {
          const float kkn = kx[j] * inv;
          k2[j] = k[j] * (1.f + (icl[j] - 1.f) * kaw_[j]);
          av[j] = -kkn;
          bv[j] = kkn * icl[j];
          wv[j] = __expf(-0.60653066f * sigmoid_f(w0_[j] + ee_[j]));
          rkp += r[j] * k2[j] * rkw_[j];
        }
        rkp = row16_allsum(rkp);
        *(f32x4*)&bf.A[pi][4 * kq] = mk_f4(av[0], av[1], av[2], av[3]);
        *(f32x4*)&bf.B[pi][4 * kq] = mk_f4(bv[0], bv[1], bv[2], bv[3]);
        *(f32x4*)&bf.W[pi][4 * kq] = mk_f4(wv[0], wv[1], wv[2], wv[3]);
        *(f32x4*)&bf.K2[pi][4 * kq] = mk_f4(k2[0], k2[1], k2[2], k2[3]);
        *(f32x4*)&bf.R[pi][4 * kq] = mk_f4(r[0], r[1], r[2], r[3]);
        if ((kq >> 2) == quarter) *(f32x4*)&bf.V[pi][(kq & 3) * 4] = mk_f4(v[0], v[1], v[2], v[3]);
        if (quarter == 0 && kq == 0) RK[((size_t)b * SEQ + c * 16 + pi) * 8 + h] = rkp;
      };
      load_raw(0);
      prep(0);
      load_raw(1);
      __syncthreads();
      for (int c = 0; c < 256; ++c) {
        if (c + 1 < 256) prep(c + 1);
        if (c + 2 < 256) load_raw(c + 2);
        __syncthreads();
      }
    } else {
      float s0 = 0.f, s1 = 0.f, s2 = 0.f, s3 = 0.f;
      __syncthreads();
      for (int c = 0; c < 256; ++c) {
        const ScanBuf& bf = sb[c & 1];
        float yv = 0.f;
#pragma unroll
        for (int i = 0; i < 16; ++i) {
          const f32x4 A4 = *(const f32x4*)&bf.A[i][4 * kg];
          const f32x4 B4 = *(const f32x4*)&bf.B[i][4 * kg];
          const f32x4 W4 = *(const f32x4*)&bf.W[i][4 * kg];
          const f32x4 K4 = *(const f32x4*)&bf.K2[i][4 * kg];
          const f32x4 R4 = *(const f32x4*)&bf.R[i][4 * kg];
          const float vv = bf.V[i][rloc];
          float pd = s0 * A4.x + s1 * A4.y + s2 * A4.z + s3 * A4.w;
          const float sa = row16_allsum(pd);
          s0 = s0 * W4.x + vv * K4.x + sa * B4.x;
          s1 = s1 * W4.y + vv * K4.y + sa * B4.y;
          s2 = s2 * W4.z + vv * K4.z + sa * B4.z;
          s3 = s3 * W4.w + vv * K4.w + sa * B4.w;
          float yp = s0 * R4.x + s1 * R4.y + s2 * R4.z + s3 * R4.w;
          const float y = row16_allsum(yp);
          yv = (kg == i) ? y : yv;
        }
        YRAW[((size_t)b * SEQ + c * 16 + kg) * 512 + h * 64 + quarter * 16 + rloc] = (bf16)yv;
        __syncthreads();
      }
    }
    __syncthreads();
  }
  __builtin_amdgcn_s_setprio(0);
}

struct AttnSmem { bf16 k[2][64][104]; bf16 v[2][64][68]; int tile; };
DEVI void phase3b(const ParamsG& p, unsigned char* smem) {
  AttnSmem& sm = *(AttnSmem*)smem;
  const bf16* Qd = (const bf16*)((const unsigned char*)gp(p.out) + OFF_Q);
  const bf16* Kd = (const bf16*)((const unsigned char*)gp(p.out) + OFF_K);
  const bf16* Vd = (const bf16*)((const unsigned char*)gp(p.out) + OFF_VT);
  bf16* O = (bf16*)(gp(p.ws) + OFF_O);
  unsigned* cnt = (unsigned*)(gp(p.ws) + OFF_CNT);
  const int tid = threadIdx.x, lane = tid & 63, w = tid >> 6;
  const int q = lane & 31, hh = lane >> 5;
  for (;;) {
    __syncthreads();
    if (tid == 0) sm.tile = (int)atomicAdd(cnt, 1u);
    __syncthreads();
    const int tile = sm.tile;
    if (tile >= 1024) break;
    const int qt = 15 - (tile >> 6), bh = tile & 63;
    const int s0 = qt * 256;
    const int nkt = 4 * qt + 4;
    const int my_nkt = 4 * qt + 1 + (w >> 1);
    bf16x8 qf[6];
    {
      const bf16* qp = Qd + ((size_t)bh * SEQ + s0 + w * 32 + q) * 96 + hh * 8;
#pragma unroll
      for (int ks = 0; ks < 6; ++ks) qf[ks] = *(const bf16x8*)(qp + ks * 16);
      const size_t trow = (size_t)(bh >> 3) * SEQ + s0 + w * 32 + q;
      const float* cp = (const float*)(gp(p.ws) + OFF_CS) + trow * 16 + hh * 8;
      const float* sp = (const float*)(gp(p.ws) + OFF_SN) + trow * 16 + hh * 8;
#pragma unroll
      for (int j = 0; j < 8; ++j) {
        const float c = cp[j], sv = sp[j];
        const float x1 = (float)qf[4][j], x2 = (float)qf[5][j];
        qf[4][j] = (bf16)(x1 * c - x2 * sv);
        qf[5][j] = (bf16)(x2 * c + x1 * sv);
      }
    }
    f32x16 ot[2];
#pragma unroll
    for (int vb = 0; vb < 2; ++vb)
#pragma unroll
      for (int r = 0; r < 16; ++r) ot[vb][r] = 0.f;
    float mref = 0.f, lsum = 0.f;
    u32x4 kr0, kr1, vr;
    kr1 = mk_u4(0u, 0u, 0u, 0u);
    auto gload = [&](int kt) {
      const bf16* kb = Kd + ((size_t)bh * SEQ + kt * 64) * 96;
      kr0 = *(const u32x4*)(kb + (size_t)tid * 8);
      if (tid < 256) kr1 = *(const u32x4*)(kb + (size_t)(tid + 512) * 8);
      const bf16* vb = Vd + ((size_t)bh * SEQ + kt * 64) * 64;
      vr = *(const u32x4*)(vb + (size_t)tid * 8);
    };
    auto lwrite = [&](int buf) {
      const int row = tid / 12, cc = tid % 12;
      *(u32x4*)&sm.k[buf][row][cc * 8] = kr0;
      if (tid < 256) { const int id = tid + 512; *(u32x4*)&sm.k[buf][id / 12][(id % 12) * 8] = kr1; }
      const int key = tid >> 3, vd0 = (tid & 7) * 8;
      unsigned short* vs = (unsigned short*)&sm.v[buf][0][0];
#pragma unroll
      for (int j = 0; j < 4; ++j) {
        vs[(vd0 + 2 * j) * 68 + key] = (unsigned short)(vr[j] & 0xffffu);
        vs[(vd0 + 2 * j + 1) * 68 + key] = (unsigned short)(vr[j] >> 16);
      }
    };
    gload(0);
    lwrite(0);
    if (nkt > 1) gload(1);
    __syncthreads();
    for (int kt = 0; kt < nkt; ++kt) {
      const int cb_ = kt & 1;
      if (kt + 1 < nkt) lwrite(cb_ ^ 1);
      if (kt + 2 < nkt) gload(kt + 2);
      if (kt < my_nkt) {
        f32x16 st[2];
        const float nmref = -mref;
#pragma unroll
        for (int kb2 = 0; kb2 < 2; ++kb2) {
#pragma unroll
          for (int r = 0; r < 16; ++r) st[kb2][r] = nmref;
#pragma unroll
          for (int ks = 0; ks < 6; ++ks) {
            const bf16x8 a = *(const bf16x8*)&sm.k[cb_][kb2 * 32 + q][ks * 16 + hh * 8];
            st[kb2] = __builtin_amdgcn_mfma_f32_32x32x16_bf16(a, qf[ks], st[kb2], 0, 0, 0);
          }
        }
        float mx = st[0][0];
#pragma unroll
        for (int kb2 = 0; kb2 < 2; ++kb2)
#pragma unroll
          for (int r = 0; r < 16; ++r) mx = fmaxf(mx, st[kb2][r]);
        mx = fmaxf(mx, __shfl_xor(mx, 32, 64));
        if (kt == 0) {
          mref = mx;
#pragma unroll
          for (int kb2 = 0; kb2 < 2; ++kb2)
#pragma unroll
            for (int r = 0; r < 16; ++r) st[kb2][r] -= mx;
        } else if (__builtin_amdgcn_ballot_w64(mx > 8.f) != 0ull) {
          const float delta = fmaxf(mx, 0.f);
          const float alpha = __builtin_amdgcn_exp2f(-delta);
          mref += delta;
          lsum *= alpha;
#pragma unroll
          for (int kb2 = 0; kb2 < 2; ++kb2)
#pragma unroll
            for (int r = 0; r < 16; ++r) st[kb2][r] -= delta;
#pragma unroll
          for (int vb = 0; vb < 2; ++vb)
#pragma unroll
            for (int r = 0; r < 16; ++r) ot[vb][r] *= alpha;
        }
        float ps = 0.f;
#pragma unroll
        for (int kb2 = 0; kb2 < 2; ++kb2)
#pragma unroll
          for (int r = 0; r < 16; ++r) {
            const float pv = __builtin_amdgcn_exp2f(st[kb2][r]);
            st[kb2][r] = pv;
            ps += pv;
          }
        lsum += ps;
#pragma unroll
        for (int kb2 = 0; kb2 < 2; ++kb2)
#pragma unroll
          for (int s2 = 0; s2 < 2; ++s2) {
            bf16x8 pf;
#pragma unroll
            for (int j = 0; j < 8; ++j) pf[j] = (bf16)st[kb2][8 * s2 + j];
#pragma unroll
            for (int vb = 0; vb < 2; ++vb) {
              const bf16x4 lo = *(const bf16x4*)&sm.v[cb_][vb * 32 + q][kb2 * 32 + 16 * s2 + 4 * hh];
              const bf16x4 hi = *(const bf16x4*)&sm.v[cb_][vb * 32 + q][kb2 * 32 + 16 * s2 + 8 + 4 * hh];
              bf16x8 a;
              a[0] = lo[0]; a[1] = lo[1]; a[2] = lo[2]; a[3] = lo[3];
              a[4] = hi[0]; a[5] = hi[1]; a[6] = hi[2]; a[7] = hi[3];
              ot[vb] = __builtin_amdgcn_mfma_f32_32x32x16_bf16(a, pf, ot[vb], 0, 0, 0);
            }
          }
      }
      __syncthreads();
    }
    const float ltot = lsum + __shfl_xor(lsum, 32, 64);
    const float inv = 1.f / ltot;
    const int b = bh >> 3, h = bh & 7;
    bf16* op = O + ((size_t)b * SEQ + s0 + w * 32 + q) * 512 + h * 64;
#pragma unroll
    for (int vb = 0; vb < 2; ++vb)
#pragma unroll
      for (int rg = 0; rg < 4; ++rg) {
        bf16x4 o;
        o[0] = (bf16)(ot[vb][4 * rg + 0] * inv); o[1] = (bf16)(ot[vb][4 * rg + 1] * inv);
        o[2] = (bf16)(ot[vb][4 * rg + 2] * inv); o[3] = (bf16)(ot[vb][4 * rg + 3] * inv);
        *(bf16x4*)(op + vb * 32 + 8 * rg + 4 * hh) = o;
      }
  }
}

constexpr int CS_LD = 72;
constexpr int CS_SLOT = 64 * CS_LD * 2;
constexpr size_t CS_ITEM = 64 * 64;
constexpr size_t OFF_CS_PH = 0;
constexpr size_t OFF_CS_PL = 32 * MiB;
constexpr size_t OFF_CS_QA = 64 * MiB;
constexpr size_t OFF_CS_SL = 96 * MiB;
constexpr size_t OFF_CS_YL1 = 358 * MiB;
constexpr size_t OFF_CS_YL2 = 316 * MiB;
DEVI size_t cs_yl_off(int item) { return (item < 3072) ? OFF_CS_YL1 + (size_t)item * CS_ITEM * 2 : OFF_CS_YL2 + (size_t)(item - 3072) * CS_ITEM * 2; }

DEVI f32x4 mfma16(bf16x8 a, bf16x8 b, f32x4 c) { return __builtin_amdgcn_mfma_f32_16x16x32_bf16(a, b, c, 0, 0, 0); }
DEVI f32x4 cs_block(const bf16* X, const bf16* Y, int rb, int cb, int lane, f32x4 acc) {
  const int r = lane & 15, g = lane >> 4;
#pragma unroll
  for (int ks = 0; ks < 2; ++ks) {
    const bf16x8 a = *(const bf16x8*)(X + (rb * 16 + r) * CS_LD + ks * 32 + g * 8);
    const bf16x8 b = *(const bf16x8*)(Y + (cb * 16 + r) * CS_LD + ks * 32 + g * 8);
    acc = mfma16(a, b, acc);
  }
  return acc;
}
DEVI void cs_store_rowmajor(bf16* D, int rb, int cb, int lane, f32x4 v) {
  const int row0 = rb * 16 + 4 * (lane >> 4), col = cb * 16 + (lane & 15);
  D[(row0 + 0) * CS_LD + col] = (bf16)v.x; D[(row0 + 1) * CS_LD + col] = (bf16)v.y;
  D[(row0 + 2) * CS_LD + col] = (bf16)v.z; D[(row0 + 3) * CS_LD + col] = (bf16)v.w;
}
DEVI void cs_store_transposed(bf16* DT, int rb, int cb, int lane, f32x4 v) {
  const int row0 = rb * 16 + 4 * (lane >> 4), col = cb * 16 + (lane & 15);
  *(bf16x4*)(DT + col * CS_LD + row0) = to_bf4(v);
}

DEVI void phase3A(const ParamsG& p, unsigned char* smem) {
  const bf16* zrw = (const bf16*)(gp(p.ws) + OFF_ZRW);
  const bf16* E = (const bf16*)(gp(p.ws) + OFF_E);
  const bf16* ICLR = (const bf16*)(gp(p.ws) + OFF_ICLR);
  float* RK = (float*)(gp(p.ws) + OFF_RK);
  bf16* gPH = (bf16*)((unsigned char*)gp(p.out) + OFF_CS_PH);
  bf16* gPL = (bf16*)((unsigned char*)gp(p.out) + OFF_CS_PL);
  bf16* gQA = (bf16*)((unsigned char*)gp(p.out) + OFF_CS_QA);
  bf16* gSL = (bf16*)((unsigned char*)gp(p.out) + OFF_CS_SL);
  bf16* SLOT[14];
#pragma unroll
  for (int i = 0; i < 14; ++i) SLOT[i] = (bf16*)(smem + i * CS_SLOT);
  float* GL = (float*)smem;
  bf16* RAWA = SLOT[2]; bf16* RAWB = SLOT[3]; bf16* RAWK = SLOT[4]; bf16* RAWV = SLOT[5];
  bf16* At = SLOT[6]; bf16* Rt = SLOT[7]; bf16* Bt = SLOT[8]; bf16* Kt = SLOT[9];
  bf16* AT = SLOT[10]; bf16* BH = SLOT[11]; bf16* KH = SLOT[12]; bf16* VT = SLOT[13];
  float* BTOT = (float*)(smem + 14 * CS_SLOT);
  float* G63 = BTOT + 8 * 64;
  bf16* Lm = SLOT[0]; bf16* LmT = SLOT[1]; bf16* Lak = SLOT[2]; bf16* Mrb = SLOT[3]; bf16* Mrk = SLOT[4];
  const int tid = threadIdx.x, lane = tid & 63, w = tid >> 6;
  const int rb = w >> 1, cb0 = 2 * (w & 1);
  bf16x8 zr, zk, zv, pr, pk, pv, ic, e8;
  auto fetch = [&](int item) {
    const int bh = item >> 6, ch = item & 63, b = bh >> 3, h = bh & 7;
    const int tt = tid >> 3, kc = (tid & 7) * 8;
    const int s = ch * 64 + tt;
    const size_t t = (size_t)b * SEQ + s;
    const int c0 = h * 64 + kc;
    const bf16* zp = zrw + t * RWC + c0;
    zr = *(const bf16x8*)zp; zk = *(const bf16x8*)(zp + 512); zv = *(const bf16x8*)(zp + 1024);
    if (s > 0) { pr = *(const bf16x8*)(zp - RWC); pk = *(const bf16x8*)(zp - RWC + 512); pv = *(const bf16x8*)(zp - RWC + 1024); }
    else {
#pragma unroll
      for (int j = 0; j < 8; ++j) { pr[j] = (bf16)0.f; pk[j] = (bf16)0.f; pv[j] = (bf16)0.f; }
    }
    e8 = *(const bf16x8*)(E + t * 512 + c0);
    ic = *(const bf16x8*)(ICLR + t * 512 + c0);
  };
  if ((int)blockIdx.x < 4096) fetch(blockIdx.x);
  for (int item = blockIdx.x; item < 4096; item += gridDim.x) {
    const int bh = item >> 6, ch = item & 63, b = bh >> 3, h = bh & 7;
    const int tbase = ch * 64;
    float a_[8], b_[8], k2_[8], r_[8];
    {
      const int tt = tid >> 3, kc = (tid & 7) * 8;
      const int s = tbase + tt;
      const size_t t = (size_t)b * SEQ + s;
      const int c0 = h * 64 + kc;
      const float ee[8] = {(float)e8[0], (float)e8[1], (float)e8[2], (float)e8[3], (float)e8[4], (float)e8[5], (float)e8[6], (float)e8[7]};
      float k_[8], v_[8], kx[8], icl[8], lw[8];
      float n2 = 0.f;
#pragma unroll
      for (int j = 0; j < 8; ++j) {
        const float zrj = (float)zr[j], zkj = (float)zk[j], zvj = (float)zv[j];
        r_[j] = zrj + gp(p.rw_mu)[c0 + j] * ((float)pr[j] - zrj);
        k_[j] = zkj + gp(p.rw_mu)[512 + c0 + j] * ((float)pk[j] - zkj);
        v_[j] = zvj + gp(p.rw_mu)[1024 + c0 + j] * ((float)pv[j] - zvj);
        kx[j] = k_[j] * gp(p.rw_k_k)[c0 + j];
        n2 += kx[j] * kx[j];
        icl[j] = sigmoid_f(gp(p.rw_a0)[c0 + j] + (float)ic[j]);
        lw[j] = -0.60653066f * sigmoid_f(gp(p.rw_w0)[c0 + j] + ee[j]);
      }
      n2 = row8_allsum(n2);
      const float inv = 1.f / fmaxf(sqrtf(n2), 1e-12f);
      float rkp = 0.f;
#pragma unroll
      for (int j = 0; j < 8; ++j) {
        const float kkn = kx[j] * inv;
        k2_[j] = k_[j] * (1.f + (icl[j] - 1.f) * gp(p.rw_k_a)[c0 + j]);
        a_[j] = -kkn;
        b_[j] = kkn * icl[j];
        rkp += r_[j] * k2_[j] * gp(p.rw_r_k)[c0 + j];
      }
      rkp = row8_allsum(rkp);
      if ((tid & 7) == 0) RK[t * 8 + h] = rkp;
      *(f32x4*)&GL[tt * 64 + kc] = mk_f4(lw[0], lw[1], lw[2], lw[3]);
      *(f32x4*)&GL[tt * 64 + kc + 4] = mk_f4(lw[4], lw[5], lw[6], lw[7]);
      bf16x8 oa, ob, ok, ov;
#pragma unroll
      for (int j = 0; j < 8; ++j) { oa[j] = (bf16)a_[j]; ob[j] = (bf16)b_[j]; ok[j] = (bf16)k2_[j]; ov[j] = (bf16)v_[j]; }
      *(bf16x8*)(RAWA + tt * CS_LD + kc) = oa; *(bf16x8*)(RAWB + tt * CS_LD + kc) = ob;
      *(bf16x8*)(RAWK + tt * CS_LD + kc) = ok; *(bf16x8*)(RAWV + tt * CS_LD + kc) = ov;
    }
    if (item + (int)gridDim.x < 4096) fetch(item + gridDim.x);
    __syncthreads();
    {
      const int kch = tid & 63, tb = tid >> 6;
      float run = 0.f;
#pragma unroll
      for (int i = 0; i < 8; ++i) { run += GL[(tb * 8 + i) * 64 + kch]; GL[(tb * 8 + i) * 64 + kch] = run; }
      BTOT[tb * 64 + kch] = run;
    }
    __syncthreads();
    {
      const int kch = tid & 63, tb = tid >> 6;
      float off = 0.f;
      for (int i = 0; i < tb; ++i) off += BTOT[i * 64 + kch];
#pragma unroll
      for (int i = 0; i < 8; ++i) GL[(tb * 8 + i) * 64 + kch] += off;
    }
    __syncthreads();
    {
      const int tt = tid >> 3, kc = (tid & 7) * 8;
      bf16x8 oA, oR, oB, oK;
#pragma unroll
      for (int j = 0; j < 8; ++j) {
        const float g = GL[tt * 64 + kc + j];
        const float gm = (tt > 0) ? GL[(tt - 1) * 64 + kc + j] : 0.f;
        const float ig = __expf(-g);
        oA[j] = (bf16)(a_[j] * __expf(gm));
        oR[j] = (bf16)(r_[j] * __expf(g));
        oB[j] = (bf16)(b_[j] * ig);
        oK[j] = (bf16)(k2_[j] * ig);
      }
      *(bf16x8*)(At + tt * CS_LD + kc) = oA; *(bf16x8*)(Rt + tt * CS_LD + kc) = oR;
      *(bf16x8*)(Bt + tt * CS_LD + kc) = oB; *(bf16x8*)(Kt + tt * CS_LD + kc) = oK;
    }
    {
      const int kch = tid & 63, tb = tid >> 6;
      const float g63 = GL[63 * 64 + kch];
      bf16x8 oAT, oBH, oKH, oVT;
#pragma unroll
      for (int i = 0; i < 8; ++i) {
        const int t = tb * 8 + i;
        const float g = GL[t * 64 + kch];
        const float gm = (t > 0) ? GL[(t - 1) * 64 + kch] : 0.f;
        const float sc = __expf(g63 - g);
        oAT[i] = (bf16)((float)RAWA[t * CS_LD + kch] * __expf(gm));
        oBH[i] = (bf16)((float)RAWB[t * CS_LD + kch] * sc);
        oKH[i] = (bf16)((float)RAWK[t * CS_LD + kch] * sc);
        oVT[i] = RAWV[t * CS_LD + kch];
      }
      *(bf16x8*)(AT + kch * CS_LD + tb * 8) = oAT; *(bf16x8*)(BH + kch * CS_LD + tb * 8) = oBH;
      *(bf16x8*)(KH + kch * CS_LD + tb * 8) = oKH; *(bf16x8*)(VT + kch * CS_LD + tb * 8) = oVT;
      if (tb == 0) G63[kch] = __expf(g63);
    }
    __syncthreads();
    f32x4 tacc[2];
#pragma unroll
    for (int q = 0; q < 2; ++q) {
      const int cb = cb0 + q;
      const f32x4 z4 = mk_f4(0.f, 0.f, 0.f, 0.f);
      f32x4 dab = cs_block(At, Bt, rb, cb, lane, z4);
      f32x4 dak = cs_block(At, Kt, rb, cb, lane, z4);
      f32x4 drb = cs_block(Rt, Bt, rb, cb, lane, z4);
      f32x4 drk = cs_block(Rt, Kt, rb, cb, lane, z4);
      const int row0 = rb * 16 + 4 * (lane >> 4), col = cb * 16 + (lane & 15);
#pragma unroll
      for (int i = 0; i < 4; ++i) {
        const int row = row0 + i;
        if (col >= row) { dab[i] = 0.f; dak[i] = 0.f; }
        if (col > row) { drb[i] = 0.f; drk[i] = 0.f; }
      }
      tacc[q] = dab;
#pragma unroll
      for (int i = 0; i < 4; ++i) if (col == row0 + i) tacc[q][i] += 1.f;
      asm volatile("" ::: "memory");
      cs_store_rowmajor(Lm, rb, cb, lane, dab);
      cs_store_transposed(LmT, rb, cb, lane, dab);
      cs_store_rowmajor(Lak, rb, cb, lane, dak);
      cs_store_rowmajor(Mrb, rb, cb, lane, drb);
      cs_store_rowmajor(Mrk, rb, cb, lane, drk);
      cs_store_transposed(SLOT[5], rb, cb, lane, tacc[q]);
    }
    __syncthreads();
    {
      bf16* Pc = Lm; bf16* PcT = LmT; bf16* Pn = At; bf16* PnT = Bt;
      bf16* TTc = SLOT[5]; bf16* TTn = Kt;
#pragma unroll 1
      for (int it = 0; it < 5; ++it) {
        f32x4 pp[2];
#pragma unroll
        for (int q = 0; q < 2; ++q) pp[q] = cs_block(Pc, PcT, rb, cb0 + q, lane, mk_f4(0.f, 0.f, 0.f, 0.f));
#pragma unroll
        for (int q = 0; q < 2; ++q) { cs_store_rowmajor(Pn, rb, cb0 + q, lane, pp[q]); cs_store_transposed(PnT, rb, cb0 + q, lane, pp[q]); }
        __syncthreads();
#pragma unroll
        for (int q = 0; q < 2; ++q) tacc[q] = cs_block(Pn, TTc, rb, cb0 + q, lane, tacc[q]);
#pragma unroll
        for (int q = 0; q < 2; ++q) cs_store_transposed(TTn, rb, cb0 + q, lane, tacc[q]);
        __syncthreads();
        bf16* t1 = Pc; Pc = Pn; Pn = t1; t1 = PcT; PcT = PnT; PnT = t1; t1 = TTc; TTc = TTn; TTn = t1;
      }
    }
    bf16* Tm = SLOT[0]; bf16* WT = SLOT[1]; bf16* TAT = SLOT[5]; bf16* ULT = SLOT[6];
#pragma unroll
    for (int q = 0; q < 2; ++q) cs_store_rowmajor(Tm, rb, cb0 + q, lane, tacc[q]);
#pragma unroll
    for (int q = 0; q < 2; ++q) cs_store_transposed(WT, rb, cb0 + q, lane, cs_block(Lak, VT, rb, cb0 + q, lane, mk_f4(0.f, 0.f, 0.f, 0.f)));
    __syncthreads();
#pragma unroll
    for (int q = 0; q < 2; ++q) {
      cs_store_transposed(TAT, rb, cb0 + q, lane, cs_block(Tm, AT, rb, cb0 + q, lane, mk_f4(0.f, 0.f, 0.f, 0.f)));
      cs_store_transposed(ULT, rb, cb0 + q, lane, cs_block(Tm, WT, rb, cb0 + q, lane, mk_f4(0.f, 0.f, 0.f, 0.f)));
    }
    __syncthreads();
    {
      bf16* oQA = SLOT[2]; bf16* oYL = SLOT[8]; bf16* oPH = SLOT[9];
      f32x4 pm_[2], sl_[2];
#pragma unroll
      for (int q = 0; q < 2; ++q) {
        const int cb = cb0 + q;
        const int row0 = rb * 16 + 4 * (lane >> 4), col = cb * 16 + (lane & 15);
        f32x4 qa;
#pragma unroll
        for (int i = 0; i < 4; ++i) qa[i] = (float)Rt[(row0 + i) * CS_LD + col];
        qa = cs_block(Mrb, TAT, rb, cb, lane, qa);
        f32x4 yl = cs_block(Mrb, ULT, rb, cb, lane, mk_f4(0.f, 0.f, 0.f, 0.f));
        yl = cs_block(Mrk, VT, rb, cb, lane, yl);
        f32x4 pm = cs_block(BH, TAT, rb, cb, lane, mk_f4(0.f, 0.f, 0.f, 0.f));
#pragma unroll
        for (int i = 0; i < 4; ++i) if (col == row0 + i) pm[i] += G63[col];
        f32x4 sl = cs_block(BH, ULT, rb, cb, lane, mk_f4(0.f, 0.f, 0.f, 0.f));
        sl = cs_block(KH, VT, rb, cb, lane, sl);
        cs_store_rowmajor(oQA, rb, cb, lane, qa);
        cs_store_rowmajor(oYL, rb, cb, lane, yl);
        cs_store_rowmajor(oPH, rb, cb, lane, pm);
        pm_[q] = pm; sl_[q] = sl;
      }
      __syncthreads();
      bf16* oPL = SLOT[0]; bf16* oSL = SLOT[1];
#pragma unroll
      for (int q = 0; q < 2; ++q) {
        const int cb = cb0 + q;
        const int row0 = rb * 16 + 4 * (lane >> 4), col = cb * 16 + (lane & 15);
        f32x4 lo;
#pragma unroll
        for (int i = 0; i < 4; ++i) lo[i] = pm_[q][i] - (float)oPH[(row0 + i) * CS_LD + col];
        cs_store_rowmajor(oPL, rb, cb, lane, lo);
        cs_store_rowmajor(oSL, rb, cb, lane, sl_[q]);
      }
      __syncthreads();
      const size_t ib = (size_t)item * CS_ITEM + (size_t)tid * 8;
      const int row = tid >> 3, cc = (tid & 7) * 8;
      *(u32x4*)(gQA + ib) = *(const u32x4*)(oQA + row * CS_LD + cc);
      *(u32x4*)((bf16*)(gp(p.ws) + cs_yl_off(item)) + (size_t)tid * 8) = *(const u32x4*)(oYL + row * CS_LD + cc);
      *(u32x4*)(gPH + ib) = *(const u32x4*)(oPH + row * CS_LD + cc);
      *(u32x4*)(gPL + ib) = *(const u32x4*)(oPL + row * CS_LD + cc);
      *(u32x4*)(gSL + ib) = *(const u32x4*)(oSL + row * CS_LD + cc);
    }
    __syncthreads();
  }
}

struct CsStage { bf16 ph[64 * CS_LD]; bf16 pl[64 * CS_LD]; bf16 qa[64 * CS_LD]; bf16 sl[64 * 16]; bf16 yl[64 * 16]; bf16 zh[16 * CS_LD]; bf16 zl[16 * CS_LD]; };
DEVI void phase3B(const ParamsG& p, unsigned char* smem) {
  const bf16* gPH = (const bf16*)((const unsigned char*)gp(p.out) + OFF_CS_PH);
  const bf16* gPL = (const bf16*)((const unsigned char*)gp(p.out) + OFF_CS_PL);
  const bf16* gQA = (const bf16*)((const unsigned char*)gp(p.out) + OFF_CS_QA);
  const bf16* gSL = (const bf16*)((const unsigned char*)gp(p.out) + OFF_CS_SL);
  bf16* YRAW = (bf16*)(gp(p.ws) + OFF_YRAW);
  CsStage* st = (CsStage*)smem;
  const int tid = threadIdx.x, lane = tid & 63, w = tid >> 6;
  const int r = lane & 15, g = lane >> 4;
  for (int item = blockIdx.x; item < 256; item += gridDim.x) {
    const int bh = item >> 2, vb = item & 3, b = bh >> 3, h = bh & 7;
    u32x4 rPH[2], rPL[2], rQA[2]; unsigned rSL[2], rYL[2];
    auto gload = [&](int ch, int sl) {
      const int it2 = bh * 64 + ch;
      const size_t ib = (size_t)it2 * CS_ITEM;
      rPH[sl] = *(const u32x4*)(gPH + ib + (size_t)tid * 8);
      rPL[sl] = *(const u32x4*)(gPL + ib + (size_t)tid * 8);
      rQA[sl] = *(const u32x4*)(gQA + ib + (size_t)tid * 8);
      const size_t o = (size_t)(tid >> 3) * 64 + vb * 16 + (tid & 7) * 2;
      rSL[sl] = *(const unsigned*)(gSL + ib + o);
      rYL[sl] = *(const unsigned*)((const bf16*)(gp(p.ws) + cs_yl_off(it2)) + o);
    };
    auto stage_write = [&](int ch, int sl) {
      CsStage& s2 = st[ch & 1];
      const int row = tid >> 3, cc = (tid & 7) * 8;
      *(u32x4*)(s2.ph + row * CS_LD + cc) = rPH[sl];
      *(u32x4*)(s2.pl + row * CS_LD + cc) = rPL[sl];
      *(u32x4*)(s2.qa + row * CS_LD + cc) = rQA[sl];
      *(unsigned*)(s2.sl + row * 16 + (tid & 7) * 2) = rSL[sl];
      *(unsigned*)(s2.yl + row * 16 + (tid & 7) * 2) = rYL[sl];
    };
    gload(0, 0);
    gload(1, 1);
    __syncthreads();
    for (int i = tid; i < 16 * CS_LD; i += NTHREADS) { st[0].zh[i] = (bf16)0.f; st[0].zl[i] = (bf16)0.f; }
    stage_write(0, 0);
    gload(2, 0);
    __syncthreads();
#pragma unroll 2
    for (int ch = 0; ch < 64; ++ch) {
      if (ch + 1 < 64) stage_write(ch + 1, (ch + 1) & 1);
      if (ch + 3 < 64) gload(ch + 3, (ch + 1) & 1);
      const CsStage& c = st[ch & 1];
      CsStage& n = st[(ch + 1) & 1];
      if (w < 4) {
        f32x4 acc;
#pragma unroll
        for (int i = 0; i < 4; ++i) acc[i] = (float)c.sl[(w * 16 + 4 * g + i) * 16 + r];
#pragma unroll
        for (int ks = 0; ks < 2; ++ks) {
          const bf16x8 ah = *(const bf16x8*)(c.ph + (w * 16 + r) * CS_LD + ks * 32 + g * 8);
          const bf16x8 al = *(const bf16x8*)(c.pl + (w * 16 + r) * CS_LD + ks * 32 + g * 8);
          const bf16x8 bh8 = *(const bf16x8*)(c.zh + r * CS_LD + ks * 32 + g * 8);
          const bf16x8 bl8 = *(const bf16x8*)(c.zl + r * CS_LD + ks * 32 + g * 8);
          acc = mfma16(ah, bh8, acc);
          acc = mfma16(ah, bl8, acc);
          acc = mfma16(al, bh8, acc);
        }
        const bf16x4 hi4 = to_bf4(acc);
        f32x4 res;
#pragma unroll
        for (int i = 0; i < 4; ++i) res[i] = acc[i] - (float)hi4[i];
        *(bf16x4*)(n.zh + r * CS_LD + w * 16 + 4 * g) = hi4;
        *(bf16x4*)(n.zl + r * CS_LD + w * 16 + 4 * g) = to_bf4(res);
      } else {
        const int tb = w - 4;
        f32x4 acc;
#pragma unroll
        for (int i = 0; i < 4; ++i) acc[i] = (float)c.yl[(tb * 16 + 4 * g + i) * 16 + r];
#pragma unroll
        for (int ks = 0; ks < 2; ++ks) {
          const bf16x8 a = *(const bf16x8*)(c.qa + (tb * 16 + r) * CS_LD + ks * 32 + g * 8);
          const bf16x8 bh8 = *(const bf16x8*)(c.zh + r * CS_LD + ks * 32 + g * 8);
          const bf16x8 bl8 = *(const bf16x8*)(c.zl + r * CS_LD + ks * 32 + g * 8);
          acc = mfma16(a, bh8, acc);
          acc = mfma16(a, bl8, acc);
        }
#pragma unroll
        for (int i = 0; i < 4; ++i) {
          const size_t t = (size_t)b * SEQ + ch * 64 + tb * 16 + 4 * g + i;
          YRAW[t * 512 + h * 64 + vb * 16 + r] = (bf16)acc[i];
        }
      }
      __syncthreads();
    }
  }
}

DEVI void phase3c(const ParamsG& p) {
  const int lane = threadIdx.x & 63;
  const int gw = blockIdx.x * NWAVES + (threadIdx.x >> 6), nw = gridDim.x * NWAVES;
  const bf16* zrw = (const bf16*)(gp(p.ws) + OFF_ZRW);
  const bf16* YRAW = (const bf16*)(gp(p.ws) + OFF_YRAW);
  const bf16* G = (const bf16*)(gp(p.ws) + OFF_G);
  const float* RK = (const float*)(gp(p.ws) + OFF_RK);
  bf16* YA = (bf16*)(gp(p.ws) + OFF_YAPRE);
  const int c0 = lane * 8, head = lane >> 3;
  float gw_[8], gb_[8], mu_[8];
#pragma unroll
  for (int j = 0; j < 8; ++j) { gw_[j] = gp(p.rw_gn_w)[c0 + j]; gb_[j] = gp(p.rw_gn_b)[c0 + j]; mu_[j] = gp(p.rw_mu)[1024 + c0 + j]; }
  for (int t = gw; t < T_TOK; t += nw) {
    const int s = t & (SEQ - 1);
    const bf16x8 y8 = *(const bf16x8*)(YRAW + (size_t)t * 512 + c0);
    float y[8];
    float sm = 0.f;
#pragma unroll
    for (int j = 0; j < 8; ++j) { y[j] = (float)y8[j]; sm += y[j]; }
    const float mean = row8_allsum(sm) * (1.f / 64.f);
    float sq = 0.f;
#pragma unroll
    for (int j = 0; j < 8; ++j) { y[j] -= mean; sq += y[j] * y[j]; }
    const float var = row8_allsum(sq) * (1.f / 64.f);
    const float rstd = rsqrtf(var + 64e-5f);
    const bf16* vp = zrw + (size_t)t * RWC + 1024 + c0;
    const bf16x8 vc = *(const bf16x8*)vp;
    bf16x8 vq;
    if (s > 0) vq = *(const bf16x8*)(vp - RWC);
    else {
#pragma unroll
      for (int j = 0; j < 8; ++j) vq[j] = (bf16)0.f;
    }
    const bf16x8 g8 = *(const bf16x8*)(G + (size_t)t * 512 + c0);
    const float rk = RK[(size_t)t * 8 + head];
    bf16x8 o;
#pragma unroll
    for (int j = 0; j < 8; ++j) {
      const float vcur = (float)vc[j];
      const float vs = vcur + mu_[j] * ((float)vq[j] - vcur);
      const float yn = y[j] * rstd * gw_[j] + gb_[j];
      o[j] = (bf16)((yn + rk * vs) * (float)g8[j]);
    }
    *(bf16x8*)(YA + (size_t)t * 512 + c0) = o;
  }
}

template <int MODE> struct EpiMix {
  static constexpr bool PERM = true, AFTER_DRAIN = false;
  bf16* D; const bf16* S;
  DEVI void operator()(PgAcc acc, const pg8::Unit& u, int wr, int wc, int fr, int fq) const {
    if constexpr (MODE == 1) {
      bf16x4 ly[2][4];
      PG_EPI_PIPELINED(
        ly[slot][c] = *(const bf16x4*)(D + off); ,
        const bf16x4 y = ly[slot][c];
        f32x4 o; o.x = (float)y[0] * sigmoid_f(v.x); o.y = (float)y[1] * sigmoid_f(v.y); o.z = (float)y[2] * sigmoid_f(v.z); o.w = (float)y[3] * sigmoid_f(v.w);
        *(bf16x4*)(D + off) = to_bf4(o);
      )
      return;
    }
    if constexpr (MODE == 3) {
      bf16x4 ly[2][4]; bf16x4 ls[2][4];
      PG_EPI_PIPELINED(
        ly[slot][c] = *(const bf16x4*)(D + off); ls[slot][c] = *(const bf16x4*)(S + off); ,
        const bf16x4 y = ly[slot][c]; const bf16x4 y2 = ls[slot][c];
        f32x4 o; o.x = (float)y[0] + (float)y2[0] * sigmoid_f(v.x); o.y = (float)y[1] + (float)y2[1] * sigmoid_f(v.y);
        o.z = (float)y[2] + (float)y2[2] * sigmoid_f(v.z); o.w = (float)y[3] + (float)y2[3] * sigmoid_f(v.w);
        *(bf16x4*)(D + off) = to_bf4(o);
      )
      return;
    }
    PG_EPI_ROWS(PG_EPI_COLS(
      bf16* q = D + (unsigned)(row * DM + col);
      if (MODE == 0) *(bf16x4*)q = to_bf4(v);
      else if (MODE == 1) {
        const bf16x4 y = *(const bf16x4*)q;
        f32x4 o; o.x = (float)y[0] * sigmoid_f(v.x); o.y = (float)y[1] * sigmoid_f(v.y); o.z = (float)y[2] * sigmoid_f(v.z); o.w = (float)y[3] * sigmoid_f(v.w);
        *(bf16x4*)q = to_bf4(o);
      } else {
        const bf16x4 y = *(const bf16x4*)q; const bf16x4 y2 = *(const bf16x4*)(S + (unsigned)(row * DM + col));
        f32x4 o; o.x = (float)y[0] + (float)y2[0] * sigmoid_f(v.x); o.y = (float)y[1] + (float)y2[1] * sigmoid_f(v.y);
        o.z = (float)y[2] + (float)y2[2] * sigmoid_f(v.z); o.w = (float)y[3] + (float)y2[3] * sigmoid_f(v.w);
        *(bf16x4*)q = to_bf4(o);
      }
    ))
  }
};
DEVI void phase4(const ParamsG& p, unsigned char* smem) {
  unsigned char* ws = gp(p.ws);
  const bf16* H1 = (const bf16*)(ws + OFF_H1);
  const bf16* WG = (const bf16*)(ws + OFF_WG_T);
  bf16* M = (bf16*)(ws + OFF_M);
  bf16* M2 = (bf16*)(ws + OFF_M2);
  { EpiMix<0> e; e.D = M; e.S = nullptr; run_gemm(smem, (const bf16*)(ws + OFF_YAPRE), (const bf16*)(ws + OFF_RWO_T), T_TOK, DM, 512, e); }
  { EpiMix<1> e; e.D = M; e.S = nullptr; run_gemm(smem, H1, WG, T_TOK, DM, DM, e); }
  { EpiMix<0> e; e.D = M2; e.S = nullptr; run_gemm(smem, (const bf16*)(ws + OFF_O), (const bf16*)(ws + OFF_MLO_T), T_TOK, DM, 512, e); }
  { EpiMix<3> e; e.D = M; e.S = M2; run_gemm(smem, H1, WG + (size_t)1024 * DM, T_TOK, DM, DM, e); }
}

struct EpiX1 {
  static constexpr bool PERM = true, AFTER_DRAIN = false;
  const float* x; bf16* xb;
  DEVI void operator()(PgAcc acc, const pg8::Unit& u, int wr, int wc, int fr, int fq) const {
    f32x4 lx[2][4];
    PG_EPI_PIPELINED(
      lx[slot][c] = *(const f32x4*)(x + off); ,
      const f32x4 s4 = lx[slot][c] + v;
      bf16x4 o; o[0] = (bf16)s4.x; o[1] = (bf16)s4.y; o[2] = (bf16)s4.z; o[3] = (bf16)s4.w;
      *(bf16x4*)(xb + off) = o;
    )
  }
};
DEVI void phase5(const ParamsG& p, unsigned char* smem) {
  EpiX1 e; e.x = gp(p.x); e.xb = (bf16*)(gp(p.ws) + OFF_XB);
  run_gemm(smem, (const bf16*)(gp(p.ws) + OFF_M), (const bf16*)(gp(p.ws) + OFF_WOUT_T), T_TOK, DM, DM, e);
}

DEVI unsigned pack_key(float s, int n) {
  unsigned u = __float_as_uint(s);
  u = (u & 0x80000000u) ? ~u : (u | 0x80000000u);
  return (u & 0xFFFFFF80u) | (unsigned)n;
}
DEVI float key_score(unsigned k) {
  unsigned u = k & 0xFFFFFF80u;
  u = (u & 0x80000000u) ? (u & 0x7FFFFFFFu) : ~u;
  return __uint_as_float(u);
}
template <int N> DEVI void bitonic_sort_desc(unsigned (&v)[N]) {
#pragma unroll
  for (int k = 2; k <= N; k <<= 1) {
#pragma unroll
    for (int j = k >> 1; j > 0; j >>= 1) {
#pragma unroll
      for (int i = 0; i < N; ++i) {
        const int l = i ^ j;
        if (l > i) {
          const bool desc = ((i & k) == 0);
          const unsigned a = v[i], b = v[l];
          const unsigned mx = a > b ? a : b, mn = a > b ? b : a;
          v[i] = desc ? mx : mn;
          v[l] = desc ? mn : mx;
        }
      }
    }
  }
}
template <int N> DEVI void bitonic_merge_desc(unsigned (&v)[N]) {
#pragma unroll
  for (int j = N >> 1; j > 0; j >>= 1) {
#pragma unroll
    for (int i = 0; i < N; ++i) {
      const int l = i ^ j;
      if (l > i) {
        const unsigned a = v[i], b = v[l];
        v[i] = a > b ? a : b;
        v[l] = a > b ? b : a;
      }
    }
  }
}

DEVI void phase7(const ParamsG& p, unsigned char* smem) {
  const bf16* H2 = (const bf16*)(gp(p.ws) + OFF_XB);
  const bf16* WQ = (const bf16*)(gp(p.ws) + OFF_WQ_T);
  const bf16* SK = (const bf16*)(gp(p.ws) + OFF_SK);
  unsigned* TOPK = (unsigned*)(gp(p.ws) + OFF_TOPK);
  const int lane = threadIdx.x & 63, w = threadIdx.x >> 6;
  const int hh = lane >> 5;
  int s0 = 0;
  bool primed = false;
  int tm, hc;
  bool have = tile_map<128, 16, 2>(0, tm, hc);
  for (int it = 0; have; ++it) {
    const int m0 = tm * 256;
    const int cur_hc = hc;
    f32x16 acc[4];
#pragma unroll
    for (int mt = 0; mt < 4; ++mt)
#pragma unroll
      for (int r = 0; r < 16; ++r) acc[mt][r] = 0.f;
    float ssq;
    route_mainloop<true>(acc, WQ + (size_t)(hc * 128) * DM, DM, H2 + (size_t)m0 * DM, DM, 16, smem, SK + (size_t)hc * 128 * 128, &ssq, s0, primed);
    const int sk_slot = (s0 + 1) % 3;
    have = tile_map<128, 16, 2>(it + 1, tm, hc);
    s0 = (s0 + 2) % 3;
    primed = have;
    if (have) route_prime(WQ + (size_t)(hc * 128) * DM, DM, H2 + (size_t)(tm * 256) * DM, DM, smem, s0);
    ssq += __shfl_xor(ssq, 32, 64);
    const float rstd = rsqrtf(ssq * (1.f / DM) + 1e-6f);
    bf16x8 qf[4][2];
#pragma unroll
    for (int db = 0; db < 4; ++db)
#pragma unroll
      for (int s2 = 0; s2 < 2; ++s2)
#pragma unroll
        for (int j = 0; j < 8; ++j) qf[db][s2][j] = (bf16)(acc[db][8 * s2 + j] * rstd);
    unsigned key[64];
    int hh4 = 4 * hh; asm volatile("" : "+v"(hh4));
    const unsigned char* skl = smem + sk_slot * 49152;
#pragma unroll
    for (int nb = 0; nb < 4; ++nb) {
      f32x16 sc;
#pragma unroll
      for (int r = 0; r < 16; ++r) sc[r] = 0.f;
      const int n = nb * 32 + (lane & 31);
      const unsigned char* rowp = skl + n * 256 + 8 * hh;
#pragma unroll
      for (int db = 0; db < 4; ++db)
#pragma unroll
        for (int s2 = 0; s2 < 2; ++s2) {
          const int c = db * 4 + 2 * s2;
          const bf16x4 lo = *(const bf16x4*)(rowp + ((c ^ (n & 15)) * 16));
          const bf16x4 hi = *(const bf16x4*)(rowp + (((c + 1) ^ (n & 15)) * 16));
          bf16x8 a;
          a[0] = lo[0]; a[1] = lo[1]; a[2] = lo[2]; a[3] = lo[3];
          a[4] = hi[0]; a[5] = hi[1]; a[6] = hi[2]; a[7] = hi[3];
          sc = __builtin_amdgcn_mfma_f32_32x32x16_bf16(a, qf[db][s2], sc, 0, 0, 0);
        }
#pragma unroll
      for (int r = 0; r < 16; ++r) key[nb * 16 + r] = pack_key(sc[r], nb * 32 + (r & 3) + 8 * (r >> 2) + hh4);
    }
    unsigned g0[16], g1[16], g2[16], g3[16];
#pragma unroll
    for (int i = 0; i < 16; ++i) { g0[i] = key[i]; g1[i] = key[16 + i]; g2[i] = key[32 + i]; g3[i] = key[48 + i]; }
    bitonic_sort_desc<16>(g0); bitonic_sort_desc<16>(g1); bitonic_sort_desc<16>(g2); bitonic_sort_desc<16>(g3);
#pragma unroll
    for (int i = 0; i < 16; ++i) { g0[i] = g0[i] > g1[15 - i] ? g0[i] : g1[15 - i]; g2[i] = g2[i] > g3[15 - i] ? g2[i] : g3[15 - i]; }
    bitonic_merge_desc<16>(g0); bitonic_merge_desc<16>(g2);
#pragma unroll
    for (int i = 0; i < 16; ++i) g0[i] = g0[i] > g2[15 - i] ? g0[i] : g2[15 - i];
    bitonic_merge_desc<16>(g0);
    unsigned top[16];
#pragma unroll
    for (int i = 0; i < 16; ++i) {
      const unsigned o = (unsigned)__shfl_xor((int)g0[15 - i], 32, 64);
      top[i] = g0[i] > o ? g0[i] : o;
    }
    bitonic_merge_desc<16>(top);
    if (hh == 0) {
      const int t = m0 + w * 32 + (lane & 31);
      u32x4* dst = (u32x4*)(TOPK + ((size_t)t * 16 + cur_hc) * 16);
      dst[0] = mk_u4(top[0], top[1], top[2], top[3]);
      dst[1] = mk_u4(top[4], top[5], top[6], top[7]);
      dst[2] = mk_u4(top[8], top[9], top[10], top[11]);
      dst[3] = mk_u4(top[12], top[13], top[14], top[15]);
    }
  }
}

DEVI void phase7b(const ParamsG& p, unsigned char* smem) {
  unsigned* ka = (unsigned*)smem;
  unsigned* kb = ka + 16 * 512;
  const unsigned* TOPK = (const unsigned*)(gp(p.ws) + OFF_TOPK);
  int* IDX = (int*)(gp(p.ws) + OFF_IDX);
  float* GATE = (float*)(gp(p.ws) + OFF_GATE);
  const int tid = threadIdx.x;
  for (int grp = blockIdx.x; grp < (T_TOK * 8) / NTHREADS; grp += gridDim.x) {
    const int item = grp * NTHREADS + tid;
    const u32x4* src = (const u32x4*)(TOPK + (size_t)item * 32);
#pragma unroll
    for (int i = 0; i < 4; ++i) {
      const u32x4 va = src[i], vb = src[4 + i];
      ka[(4 * i + 0) * 512 + tid] = va.x; ka[(4 * i + 1) * 512 + tid] = va.y;
      ka[(4 * i + 2) * 512 + tid] = va.z; ka[(4 * i + 3) * 512 + tid] = va.w;
      kb[(4 * i + 0) * 512 + tid] = vb.x; kb[(4 * i + 1) * 512 + tid] = vb.y;
      kb[(4 * i + 2) * 512 + tid] = vb.z; kb[(4 * i + 3) * 512 + tid] = vb.w;
    }
    unsigned long long jp = 0ull;
    float sc[16];
    int ex[16];
#pragma unroll
    for (int r = 0; r < 16; ++r) {
      float best = -3.0e38f;
      int bi = 0, bj = 0;
      for (int i = 0; i <= r; ++i) {
        const int ji = (int)((jp >> (4 * i)) & 15ull);
        const float cand = key_score(ka[i * 512 + tid]) + key_score(kb[ji * 512 + tid]);
        if (cand > best) { best = cand; bi = i; bj = ji; }
      }
      sc[r] = best;
      ex[r] = (int)(ka[bi * 512 + tid] & 127u) * 128 + (int)(kb[bj * 512 + tid] & 127u);
      jp += 1ull << (4 * bi);
    }
    float den = 0.f;
    const float smax = sc[0];
#pragma unroll
    for (int r = 0; r < 16; ++r) { sc[r] = __expf(sc[r] - smax); den += sc[r]; }
    const float inv = 1.f / den;
    i32x4* di = (i32x4*)(IDX + (size_t)item * 16);
    f32x4* dg = (f32x4*)(GATE + (size_t)item * 16);
#pragma unroll
    for (int i = 0; i < 4; ++i) {
      di[i] = mk_i4(ex[4 * i], ex[4 * i + 1], ex[4 * i + 2], ex[4 * i + 3]);
      dg[i] = mk_f4(sc[4 * i] * inv, sc[4 * i + 1] * inv, sc[4 * i + 2] * inv, sc[4 * i + 3] * inv);
    }
  }
}

struct PeerBuf { u32x4 uq[2]; u32x4 vq[2]; float ius; float gt; };
template <class T> DEVI const T* scalar_base(const T* q) {
  const unsigned long long v = (unsigned long long)q;
  const unsigned lo = (unsigned)__builtin_amdgcn_readfirstlane((int)(unsigned)v), hi = (unsigned)__builtin_amdgcn_readfirstlane((int)(unsigned)(v >> 32));
  return (const T*)(const GLB T*)(((unsigned long long)hi << 32) | lo);
}
DEVI float gelu_as(float d) {
  const float ax = fabsf(d);
  const float x = ax * 0.70710678f;
  const float t = __builtin_amdgcn_rcpf(fmaf(0.3275911f, x, 1.f));
  float pl = fmaf(t, 1.061405429f, -1.453152027f);
  pl = fmaf(pl, t, 1.421413741f); pl = fmaf(pl, t, -0.284496736f); pl = fmaf(pl, t, 0.254829592f);
  pl *= t;
  const float ex = __builtin_amdgcn_exp2f(x * x * -1.44269504f);
  const float erfa = fmaf(-pl, ex, 1.f);
  return 0.5f * fmaf(ax, erfa, d);
}
DEVI void peer_issue(PeerBuf& b, int it, int idxr, float iusr, float givr, const unsigned char* __restrict__ U8, const unsigned char* __restrict__ V8,
                     int g, int j, int lane) {
  const int srcl = (it * 4 + g) & 63;
  const int e = __shfl(idxr, srcl, 64);
  b.ius = __shfl(iusr, srcl, 64);
  b.gt = __shfl(givr, srcl, 64);
  const unsigned uo = (unsigned)(e * 512 + j * 16);
  b.uq[0] = *(const u32x4*)(U8 + uo);
  b.uq[1] = *(const u32x4*)(U8 + uo + 256u);
  const int hf = lane >> 5;
#pragma unroll
  for (int q = 0; q < 2; ++q) {
    const int ev = __shfl(idxr, (it * 4 + 2 * q + hf) & 63, 64);
    b.vq[q] = *(const u32x4*)(V8 + (unsigned)(ev * 512 + (lane & 31) * 16));
  }
}
#define FP4_BF16(W, S) __builtin_bit_cast(unsigned, __builtin_amdgcn_cvt_scalef32_pk_bf16_fp4((W), 1.0f, (S)))
DEVI void peer_compute(const PeerBuf& b, const unsigned (&hq)[32], float (&acc)[32], int lane) {
  float d0 = 0.f, d1 = 0.f, d2 = 0.f, d3 = 0.f;
#pragma unroll
  for (int i = 0; i < 2; ++i)
#pragma unroll
    for (int wi = 0; wi < 4; ++wi) {
      const unsigned w = b.uq[i][wi];
      d0 = dot2bf(hq[i * 16 + wi * 4 + 0], FP4_BF16(w, 0), d0);
      d1 = dot2bf(hq[i * 16 + wi * 4 + 1], FP4_BF16(w, 1), d1);
      d2 = dot2bf(hq[i * 16 + wi * 4 + 2], FP4_BF16(w, 2), d2);
      d3 = dot2bf(hq[i * 16 + wi * 4 + 3], FP4_BF16(w, 3), d3);
    }
  float d = (d0 + d1) + (d2 + d3);
  d = row16_allsum(d) * b.ius;
  const float act = gelu_as(d);
  const float cf = b.gt * act;
  const int hf = lane >> 5;
#pragma unroll
  for (int q = 0; q < 2; ++q) {
    const float cc = __shfl(cf, (2 * q + hf) * 16, 64);
#pragma unroll
    for (int wi = 0; wi < 4; ++wi) {
      const unsigned w = b.vq[q][wi];
      const f32x2 f0 = __builtin_amdgcn_cvt_scalef32_pk_f32_fp4(w, 1.0f, 0);
      const f32x2 f1 = __builtin_amdgcn_cvt_scalef32_pk_f32_fp4(w, 1.0f, 1);
      const f32x2 f2 = __builtin_amdgcn_cvt_scalef32_pk_f32_fp4(w, 1.0f, 2);
      const f32x2 f3 = __builtin_amdgcn_cvt_scalef32_pk_f32_fp4(w, 1.0f, 3);
      acc[wi * 8 + 0] += cc * f0.x; acc[wi * 8 + 1] += cc * f0.y;
      acc[wi * 8 + 2] += cc * f1.x; acc[wi * 8 + 3] += cc * f1.y;
      acc[wi * 8 + 4] += cc * f2.x; acc[wi * 8 + 5] += cc * f2.y;
      acc[wi * 8 + 6] += cc * f3.x; acc[wi * 8 + 7] += cc * f3.y;
    }
  }
}
template <bool DRY> DEVI void phase8(const ParamsG& p) {
  int tid_ = threadIdx.x; asm volatile("" : "+v"(tid_));
  const int lane = tid_ & 63;
  const int gw = blockIdx.x * NWAVES + (tid_ >> 6), nw = gridDim.x * NWAVES;
  const bf16* H2 = (const bf16*)(gp(p.ws) + OFF_XB);
  const unsigned char* U8 = scalar_base((const unsigned char*)(gp(p.ws) + OFF_U8));
  const unsigned char* V8 = scalar_base((const unsigned char*)(gp(p.ws) + OFF_V8));
  const float* IUS = (const float*)(gp(p.ws) + OFF_IUS);
  const float* IVS = (const float*)(gp(p.ws) + OFF_IVS);
  const int* IDX = (const int*)(gp(p.ws) + OFF_IDX);
  const float* GATE = (const float*)(gp(p.ws) + OFF_GATE);
  bf16* H3 = (bf16*)(gp(p.ws) + OFF_H3);
  const int g = lane >> 4, j = lane & 15;
  const int ocol = (lane & 31) * 32 + (lane >> 5) * 16;
  f32x4 gpl[4];
#pragma unroll
  for (int i = 0; i < 4; ++i) gpl[i] = *(const f32x4*)(gp(p.norm_ple) + ocol + i * 4);
  for (int t = gw; t < T_TOK; t += nw) {
    unsigned hq[32];
#pragma unroll
    for (int i = 0; i < 2; ++i) {
      const bf16* hp = H2 + (size_t)t * DM + i * 512 + j * 32;
#pragma unroll
      for (int c = 0; c < 4; ++c) {
        const u32x4 a = *(const u32x4*)(hp + c * 8);
        hq[i * 16 + c * 4 + 0] = a.x; hq[i * 16 + c * 4 + 1] = a.y; hq[i * 16 + c * 4 + 2] = a.z; hq[i * 16 + c * 4 + 3] = a.w;
      }
    }
    float rstd;
    {
      float q0 = 0.f, q1 = 0.f;
#pragma unroll
      for (int i = 0; i < 32; i += 2) { q0 = dot2bf(hq[i], hq[i], q0); q1 = dot2bf(hq[i + 1], hq[i + 1], q1); }
      rstd = rsqrtf(row16_allsum(q0 + q1) * (1.f / DM) + 1e-6f);
      rstd = __int_as_float(__builtin_amdgcn_readfirstlane(__float_as_int(rstd)));
    }
    const int idx0 = IDX[(size_t)t * 128 + lane], idx1 = IDX[(size_t)t * 128 + 64 + lane];
    const float iu0 = IUS[idx0] * rstd, iu1 = IUS[idx1] * rstd;
    const float gv0 = GATE[(size_t)t * 128 + lane] * IVS[idx0], gv1 = GATE[(size_t)t * 128 + 64 + lane] * IVS[idx1];
    float acc[32];
#pragma unroll
    for (int i = 0; i < 32; ++i) acc[i] = 0.f;
    PeerBuf ba, bb, bc;
#define PISSUE(B, IT) peer_issue(B, (IT), ((IT) < 16) ? idx0 : idx1, ((IT) < 16) ? iu0 : iu1, ((IT) < 16) ? gv0 : gv1, U8, V8, g, j, lane)
    PISSUE(ba, 0);
    PISSUE(bb, 1);
#pragma unroll 1
    for (int it = 0; it < 30; it += 3) {
      PISSUE(bc, it + 2);
      peer_compute(ba, hq, acc, lane);
      PISSUE(ba, it + 3);
      peer_compute(bb, hq, acc, lane);
      PISSUE(bb, it + 4);
      peer_compute(bc, hq, acc, lane);
    }
    peer_compute(ba, hq, acc, lane);
    peer_compute(bb, hq, acc, lane);
#undef PISSUE
    float keep[16];
    const bool hi = (lane >> 5) != 0;
#pragma unroll
    for (int i = 0; i < 16; ++i) {
      const float mine = hi ? acc[16 + i] : acc[i];
      const float give = hi ? acc[i] : acc[16 + i];
      keep[i] = mine + __shfl_xor(give, 32, 64);
    }
    bf16* xo = (bf16*)(gp(p.ws) + OFF_XB) + (size_t)t * DM + ocol;
    f32x4 xv[4];
    float ss = 0.f;
    {
      const bf16x8 xa = *(const bf16x8*)xo, xc = *(const bf16x8*)(xo + 8);
      bf16x8 ya, yc;
#pragma unroll
      for (int i = 0; i < 2; ++i) {
        xv[i].x = (float)xa[i * 4 + 0] + keep[i * 4 + 0]; xv[i].y = (float)xa[i * 4 + 1] + keep[i * 4 + 1];
        xv[i].z = (float)xa[i * 4 + 2] + keep[i * 4 + 2]; xv[i].w = (float)xa[i * 4 + 3] + keep[i * 4 + 3];
        xv[2 + i].x = (float)xc[i * 4 + 0] + keep[8 + i * 4 + 0]; xv[2 + i].y = (float)xc[i * 4 + 1] + keep[8 + i * 4 + 1];
        xv[2 + i].z = (float)xc[i * 4 + 2] + keep[8 + i * 4 + 2]; xv[2 + i].w = (float)xc[i * 4 + 3] + keep[8 + i * 4 + 3];
        ya[i * 4 + 0] = (bf16)xv[i].x; ya[i * 4 + 1] = (bf16)xv[i].y; ya[i * 4 + 2] = (bf16)xv[i].z; ya[i * 4 + 3] = (bf16)xv[i].w;
        yc[i * 4 + 0] = (bf16)xv[2 + i].x; yc[i * 4 + 1] = (bf16)xv[2 + i].y; yc[i * 4 + 2] = (bf16)xv[2 + i].z; yc[i * 4 + 3] = (bf16)xv[2 + i].w;
      }
#pragma unroll
      for (int i = 0; i < 4; ++i) ss += xv[i].x * xv[i].x + xv[i].y * xv[i].y + xv[i].z * xv[i].z + xv[i].w * xv[i].w;
      if (!DRY) { *(bf16x8*)xo = ya; *(bf16x8*)(xo + 8) = yc; }
    }
    ss = wave_sum(ss);
    const float rs = rsqrtf(ss * (1.f / DM) + 1e-6f);
    bf16x8 o0, o1;
    o0[0] = (bf16)(xv[0].x * rs * gpl[0].x); o0[1] = (bf16)(xv[0].y * rs * gpl[0].y); o0[2] = (bf16)(xv[0].z * rs * gpl[0].z); o0[3] = (bf16)(xv[0].w * rs * gpl[0].w);
    o0[4] = (bf16)(xv[1].x * rs * gpl[1].x); o0[5] = (bf16)(xv[1].y * rs * gpl[1].y); o0[6] = (bf16)(xv[1].z * rs * gpl[1].z); o0[7] = (bf16)(xv[1].w * rs * gpl[1].w);
    o1[0] = (bf16)(xv[2].x * rs * gpl[2].x); o1[1] = (bf16)(xv[2].y * rs * gpl[2].y); o1[2] = (bf16)(xv[2].z * rs * gpl[2].z); o1[3] = (bf16)(xv[2].w * rs * gpl[2].w);
    o1[4] = (bf16)(xv[3].x * rs * gpl[3].x); o1[5] = (bf16)(xv[3].y * rs * gpl[3].y); o1[6] = (bf16)(xv[3].z * rs * gpl[3].z); o1[7] = (bf16)(xv[3].w * rs * gpl[3].w);
    *(bf16x8*)(H3 + (size_t)t * DM + ocol) = o0;
    *(bf16x8*)(H3 + (size_t)t * DM + ocol + 8) = o1;
  }
}

struct EpiX3 {
  static constexpr bool PERM = true, AFTER_DRAIN = false;
  const bf16* pps; bf16* xb;
  DEVI void operator()(PgAcc acc, const pg8::Unit& u, int wr, int wc, int fr, int fq) const {
    bf16x4 lp[2][4]; bf16x4 lx[2][4];
    PG_EPI_PIPELINED(
      lp[slot][c] = *(const bf16x4*)(pps + off); lx[slot][c] = *(const bf16x4*)(xb + off); ,
      const bf16x4 pp = lp[slot][c];
      const bf16x4 xi = lx[slot][c];
      bf16x4 xo;
      xo[0] = (bf16)((float)xi[0] + sigmoid_f(v.x) * (float)pp[0]); xo[1] = (bf16)((float)xi[1] + sigmoid_f(v.y) * (float)pp[1]);
      xo[2] = (bf16)((float)xi[2] + sigmoid_f(v.z) * (float)pp[2]); xo[3] = (bf16)((float)xi[3] + sigmoid_f(v.w) * (float)pp[3]);
      *(bf16x4*)(xb + off) = xo;
    )
  }
};
DEVI void phase10(const ParamsG& p, unsigned char* smem) {
  bf16* PPS = (bf16*)(gp(p.ws) + OFF_H2);
  { EpiMix<0> e; e.D = PPS; e.S = nullptr; run_gemm(smem, (const bf16*)(gp(p.ws) + OFF_PBF), (const bf16*)(gp(p.ws) + OFF_PP_T), T_TOK, DM, 256, e); }
  { EpiX3 e; e.pps = PPS; e.xb = (bf16*)(gp(p.ws) + OFF_XB); run_gemm(smem, (const bf16*)(gp(p.ws) + OFF_H3), (const bf16*)(gp(p.ws) + OFF_PG_T), T_TOK, DM, DM, e); }
}

DEVI void phase11(const ParamsG& p) {
  int tid_ = threadIdx.x; asm volatile("" : "+v"(tid_));
  const int lane = tid_ & 63;
  const int gw = blockIdx.x * NWAVES + (tid_ >> 6), nw = gridDim.x * NWAVES;
  f32x4 gn[4];
#pragma unroll
  for (int i = 0; i < 4; ++i) gn[i] = *(const f32x4*)(gp(p.norm_final) + i * 256 + lane * 4);
  for (int t = gw; t < T_TOK; t += nw) {
    float* xr = gp(p.out) + (size_t)t * DM;
    const bf16* xs = (const bf16*)(gp(p.ws) + OFF_XB) + (size_t)t * DM;
    f32x4 v[4];
    float ss = 0.f;
#pragma unroll
    for (int i = 0; i < 4; ++i) {
      const bf16x4 b4 = *(const bf16x4*)(xs + i * 256 + lane * 4);
      v[i].x = (float)b4[0]; v[i].y = (float)b4[1]; v[i].z = (float)b4[2]; v[i].w = (float)b4[3];
      ss += v[i].x * v[i].x + v[i].y * v[i].y + v[i].z * v[i].z + v[i].w * v[i].w;
    }
    ss = wave_sum(ss);
    const float rs = rsqrtf(ss * (1.f / DM) + 1e-6f);
#pragma unroll
    for (int i = 0; i < 4; ++i) {
      f32x4 o;
      o.x = v[i].x * rs * gn[i].x; o.y = v[i].y * rs * gn[i].y; o.z = v[i].z * rs * gn[i].z; o.w = v[i].w * rs * gn[i].w;
      *(f32x4*)(xr + i * 256 + lane * 4) = o;
    }
  }
}

constexpr int N_PHASES = 15;
__global__ void __launch_bounds__(NTHREADS, 2) hybrid_block_kernel(Params p_arg, int ph0, int ph1) {
  extern __shared__ __attribute__((aligned(1024))) unsigned char smem[];
  cg::grid_group grid = cg::this_grid();
  Params* ptab = (Params*)(p_arg.ws + OFF_PTAB) + blockIdx.x;
  if (threadIdx.x == 0) *ptab = p_arg;
  __syncthreads();
  const ParamsG& p = *(const ParamsG*)ptab;
#ifndef DUP_PHASE
#define DUP_PHASE -1
#endif
  volatile LAS unsigned* xst = (volatile LAS unsigned*)(smem + LDS_BYTES - 256);
  if (threadIdx.x == 0) { xst[0] = 0u; xst[1] = 0u; }
  __syncthreads();
#define GSYNC(K) { if ((K) == 0) { grid.sync(); (void)xcd_barrier_post((unsigned*)(gp(p.ws) + OFF_BAR), xst); } else { XcdBarrier xb_; xb_.bar = (unsigned*)(gp(p.ws) + OFF_BAR); xb_.x = xb_xcc_id(); xb_.st = xst; xcd_barrier(xb_); } }
#define RUN_PHASE(K, CALL) if (ph0 <= (K) && (K) < ph1) { \
    if (DUP_PHASE == (K)) { CALL; GSYNC(1) } \
    CALL; if ((K) + 1 < ph1) GSYNC(K) }
  RUN_PHASE(0, phase0(p, smem))
  RUN_PHASE(1, phase1(p, smem))
  RUN_PHASE(2, phase2a(p))
  RUN_PHASE(3, phase2b(p, smem))
#ifdef SEQ_SCAN
  RUN_PHASE(4, { phase3a(p, smem); __syncthreads(); phase3b(p, smem); })
  RUN_PHASE(5, { })
  RUN_PHASE(6, { })
#else
  RUN_PHASE(4, phase3b(p, smem))
  RUN_PHASE(5, phase3A(p, smem))
  RUN_PHASE(6, phase3B(p, smem))
#endif
  RUN_PHASE(7, phase3c(p))
  RUN_PHASE(8, phase4(p, smem))
  RUN_PHASE(9, phase5(p, smem))
  RUN_PHASE(10, phase7(p, smem))
  RUN_PHASE(11, phase7b(p, smem))
  RUN_PHASE(12, phase8<false>(p))
  RUN_PHASE(13, phase10(p, smem))
  RUN_PHASE(14, phase11(p))
#undef RUN_PHASE
}

extern "C" void kernel_launch(void* const* d_in, const int* in_sizes, int n_in, void* d_out, int out_size, void* d_ws,
                              size_t ws_size, hipStream_t stream) {
  static int grid_blocks = 0;
  if (!grid_blocks) {
    int dev = 0, cus = 0, per_cu = 0;
    hipGetDevice(&dev);
    hipDeviceGetAttribute(&cus, hipDeviceAttributeMultiprocessorCount, dev);
    hipFuncSetAttribute((const void*)hybrid_block_kernel, hipFuncAttributeMaxDynamicSharedMemorySize, LDS_BYTES);
    hipOccupancyMaxActiveBlocksPerMultiprocessor(&per_cu, hybrid_block_kernel, NTHREADS, LDS_BYTES);
    if (per_cu > 1) per_cu = 1;
    if (per_cu < 1) per_cu = 1;
    grid_blocks = cus * per_cu;
  }
  Params p{};
  const float** fp = (const float**)&p;
  for (int i = 0; i < 32; ++i) fp[i] = (const float*)d_in[i];
  p.pos = (const int*)d_in[2];
  p.out = (float*)d_out;
  p.ws = (unsigned char*)d_ws;
#ifndef MULTI_LAUNCH
  int ph0 = 0, ph1 = N_PHASES;
  void* args[] = {&p, &ph0, &ph1};
  hipError_t e = hipLaunchCooperativeKernel((void*)hybrid_block_kernel, dim3(grid_blocks), dim3(NTHREADS), args, LDS_BYTES, stream);
  if (e != hipSuccess) fprintf(stderr, "cooperative launch failed: %s (grid %d)\n", hipGetErrorString(e), grid_blocks);
#else
  for (int ph = 0; ph < N_PHASES; ++ph)
    hipLaunchKernelGGL(hybrid_block_kernel, dim3(grid_blocks), dim3(NTHREADS), LDS_BYTES, stream, p, ph, ph + 1);
#endif
}
```

```cpp
#include <hip/hip_runtime.h>
#include <hip/hip_cooperative_groups.h>
#include <stdint.h>
#include <stdio.h>
namespace cg = cooperative_groups;

typedef __bf16 bf16;
typedef __attribute__((ext_vector_type(8))) __bf16 bf16x8;
typedef __attribute__((ext_vector_type(4))) __bf16 bf16x4;
typedef __attribute__((ext_vector_type(2))) __bf16 bf16x2;
typedef __attribute__((ext_vector_type(16))) float f32x16;
typedef __attribute__((ext_vector_type(4))) float f32x4;
typedef __attribute__((ext_vector_type(2))) float f32x2;
typedef __attribute__((ext_vector_type(4))) unsigned u32x4;
typedef __attribute__((ext_vector_type(2))) unsigned u32x2;
typedef __attribute__((ext_vector_type(4))) int i32x4;

#define DEVI __device__ __forceinline__
#ifndef ABL
#define ABL 0
#endif

constexpr int T_TOK = 32768;
constexpr int SEQ = 4096;
constexpr int DM = 1024;
constexpr int IN_COLS = 4512;
constexpr int RWC = 1792;
constexpr int MLC = 672;
constexpr int NTHREADS = 512;
constexpr int NWAVES = 8;
constexpr int LDS_BYTES = 148480;

constexpr size_t MiB = 1ull << 20;
constexpr size_t OFF_WIN_T = 0;
constexpr size_t OFF_WG_T = 5 * MiB;
constexpr size_t OFF_WLORA_T = 9 * MiB;
constexpr size_t OFF_RWO_T = 10 * MiB;
constexpr size_t OFF_MLO_T = 11 * MiB;
constexpr size_t OFF_WUQ_T = 12 * MiB;
constexpr size_t OFF_WUKV_T = 13 * MiB;
constexpr size_t OFF_PP_T = 13 * MiB + 524288;
constexpr size_t OFF_WOUT_T = 14 * MiB;
constexpr size_t OFF_PG_T = 16 * MiB;
constexpr size_t OFF_WQ_T = 18 * MiB;
constexpr size_t OFF_SK = 22 * MiB;
constexpr size_t OFF_CNT = 22 * MiB + 524288;
constexpr size_t OFF_BAR = 22 * MiB + 524288 + 65536;
constexpr size_t OFF_PTAB = 22 * MiB + 524288 + 131072;
constexpr size_t OFF_CS = 23 * MiB;
constexpr size_t OFF_SN = 25 * MiB;
constexpr size_t OFF_RK = 27 * MiB;
constexpr size_t OFF_PBF = 28 * MiB;
constexpr size_t OFF_U8 = 44 * MiB;
constexpr size_t OFF_V8 = 60 * MiB;
constexpr size_t OFF_IUS = 76 * MiB;
constexpr size_t OFF_IVS = 76 * MiB + 65536;
constexpr size_t OFF_H1 = 108 * MiB;
constexpr size_t OFF_ZRW = 172 * MiB;
constexpr size_t OFF_ZMLA = 284 * MiB;
constexpr size_t OFF_LORA = 326 * MiB;
constexpr size_t OFF_CQ = 342 * MiB;
constexpr size_t OFF_CKV = 366 * MiB;
constexpr size_t OFF_E = 382 * MiB;
constexpr size_t OFF_ICLR = 446 * MiB;
constexpr size_t OFF_G = 478 * MiB;
constexpr size_t OFF_O = 284 * MiB;
constexpr size_t OFF_YRAW = 326 * MiB;
constexpr size_t OFF_YAPRE = 358 * MiB;
constexpr size_t OFF_M = 172 * MiB;
constexpr size_t OFF_M2 = 390 * MiB;
constexpr size_t OFF_H2 = 382 * MiB;
constexpr size_t OFF_TOPK = 236 * MiB;
constexpr size_t OFF_IDX = 446 * MiB;
constexpr size_t OFF_GATE = 462 * MiB;
constexpr size_t OFF_H3 = 172 * MiB;
constexpr size_t OFF_DD = 326 * MiB;
constexpr size_t OFF_XB = 108 * MiB;
constexpr size_t OFF_Q = 0;
constexpr size_t OFF_K = 48 * MiB;
constexpr size_t OFF_VT = 96 * MiB;

struct Params {
  const float* x; const float* p; const int* pos; const float* norm_mix; const float* w_in; const float* rw_mu;
  const float* rw_w0; const float* rw_w2; const float* rw_a0; const float* rw_a2; const float* rw_g2; const float* rw_k_k;
  const float* rw_k_a; const float* rw_r_k; const float* rw_gn_w; const float* rw_gn_b; const float* rw_w_o;
  const float* mla_q_norm; const float* mla_w_uq; const float* mla_kv_norm; const float* mla_w_ukv; const float* mla_w_o;
  const float* w_out; const float* norm_ffn; const float* peer_w_q; const float* peer_sub_keys; const float* peer_u;
  const float* peer_v; const float* norm_ple; const float* ple_w_gate; const float* ple_w_proj; const float* norm_final;
  float* out; unsigned char* ws;
};
#define GLB __attribute__((address_space(1)))
struct ParamsG {
  const GLB float* x; const GLB float* p; const GLB int* pos; const GLB float* norm_mix; const GLB float* w_in; const GLB float* rw_mu;
  const GLB float* rw_w0; const GLB float* rw_w2; const GLB float* rw_a0; const GLB float* rw_a2; const GLB float* rw_g2; const GLB float* rw_k_k;
  const GLB float* rw_k_a; const GLB float* rw_r_k; const GLB float* rw_gn_w; const GLB float* rw_gn_b; const GLB float* rw_w_o;
  const GLB float* mla_q_norm; const GLB float* mla_w_uq; const GLB float* mla_kv_norm; const GLB float* mla_w_ukv; const GLB float* mla_w_o;
  const GLB float* w_out; const GLB float* norm_ffn; const GLB float* peer_w_q; const GLB float* peer_sub_keys; const GLB float* peer_u;
  const GLB float* peer_v; const GLB float* norm_ple; const GLB float* ple_w_gate; const GLB float* ple_w_proj; const GLB float* norm_final;
  GLB float* out; GLB unsigned char* ws;
};
template <class T> DEVI T* gp(GLB T* q) { return (T*)q; }

DEVI u32x4 mk_u4(unsigned a, unsigned b, unsigned c, unsigned d) { u32x4 v; v.x = a; v.y = b; v.z = c; v.w = d; return v; }
DEVI u32x2 mk_u2(unsigned a, unsigned b) { u32x2 v; v.x = a; v.y = b; return v; }
DEVI f32x4 mk_f4(float a, float b, float c, float d) { f32x4 v; v.x = a; v.y = b; v.z = c; v.w = d; return v; }
DEVI i32x4 mk_i4(int a, int b, int c, int d) { i32x4 v; v.x = a; v.y = b; v.z = c; v.w = d; return v; }
DEVI float wave_sum(float v) {
#pragma unroll
  for (int o = 32; o > 0; o >>= 1) v += __shfl_xor(v, o, 64);
  return v;
}
template <int CTRL> DEVI float dpp_f(float v) {
  return __int_as_float(__builtin_amdgcn_update_dpp(0, __float_as_int(v), CTRL, 0xf, 0xf, true));
}
DEVI float row16_allsum(float v) {
  v += dpp_f<0xB1>(v);
  v += dpp_f<0x4E>(v);
  v += dpp_f<0x141>(v);
  v += dpp_f<0x140>(v);
  return v;
}
DEVI float row8_allsum(float v) {
  v += dpp_f<0xB1>(v);
  v += dpp_f<0x4E>(v);
  v += dpp_f<0x141>(v);
  return v;
}
DEVI float sigmoid_f(float x) { return 1.f / (1.f + __expf(-x)); }
DEVI float bflo(unsigned u) { return __uint_as_float(u << 16); }
DEVI float bfhi(unsigned u) { return __uint_as_float(u & 0xffff0000u); }
DEVI unsigned pack2(float a, float b) {
  bf16x2 v; v[0] = (bf16)a; v[1] = (bf16)b;
  return __builtin_bit_cast(unsigned, v);
}
DEVI float dot2bf(unsigned a, unsigned b, float c) {
  return __builtin_amdgcn_fdot2_f32_bf16(__builtin_bit_cast(bf16x2, a), __builtin_bit_cast(bf16x2, b), c, false);
}


#define XB_TMO      128
#define XB_XCNT(j)  (256  + 64 * (j))
#define XB_XSUB(j)  (1280 + 64 * (j))
#define XB_XGEN(j)  (2304 + 64 * (j))
#define XB_TOP      3328
#define XB_TOPGEN   3392
#define XCD_BAR_WORDS 3456
#define XB_SPIN_CAP (1u << 22)
#define LAS __attribute__((address_space(3)))
DEVI unsigned xb_ld(unsigned* p) { return __hip_atomic_load(p, __ATOMIC_RELAXED, __HIP_MEMORY_SCOPE_AGENT); }
DEVI unsigned xb_add(unsigned* p, unsigned v) { return __hip_atomic_fetch_add(p, v, __ATOMIC_RELAXED, __HIP_MEMORY_SCOPE_AGENT); }
DEVI unsigned xb_xcc_id() { return (unsigned)__builtin_amdgcn_s_getreg((3 << 11) | 20) & 0xFu; }
#define XB_SPIN(cond, bar) do { unsigned _sp = 0; while (cond) { __builtin_amdgcn_s_sleep(1); \
    if ((++_sp & 255u) == 0u) { if (xb_ld(&(bar)[XB_TMO])) break; if (_sp > XB_SPIN_CAP) { atomicAdd(&(bar)[XB_TMO], 1u); break; } } } } while (0)
struct XcdBarrier { unsigned* bar; unsigned x; volatile LAS unsigned* st; };
DEVI XcdBarrier xcd_barrier_post(unsigned* bar, volatile LAS unsigned* st) {
  XcdBarrier b; b.bar = bar; b.x = xb_xcc_id(); b.st = st;
  if (threadIdx.x == 0) (void)xb_add(&bar[XB_XCNT(b.x)], 1u);
  return b;
}
DEVI void xcd_barrier_complete(unsigned* bar, unsigned x, unsigned& nloc, unsigned& nx) {
  const unsigned G = gridDim.x * gridDim.y * gridDim.z;
  unsigned sum, cnt, mine, sp = 0u;
  for (;;) {
    sum = 0u; cnt = 0u; mine = 0u;
#pragma unroll
    for (unsigned j = 0; j < 16; ++j) { const unsigned c = xb_ld(&bar[XB_XCNT(j)]); sum += c; cnt += (c > 0u) ? 1u : 0u; mine = (j == x) ? c : mine; }
    if (sum == G) break;
    __builtin_amdgcn_s_sleep(1);
    if ((++sp & 255u) == 0u) { if (xb_ld(&bar[XB_TMO])) break; if (sp > XB_SPIN_CAP) { atomicAdd(&bar[XB_TMO], 1u); break; } }
  }
  nloc = mine > 0u ? mine : 1u; nx = cnt > 0u ? cnt : 1u;
}
DEVI void xcd_barrier(const XcdBarrier& b) {
  asm volatile("s_waitcnt vmcnt(0)" ::: "memory");
  __syncthreads();
  if (threadIdx.x == 0) {
    unsigned* bar = b.bar;
    __builtin_amdgcn_s_waitcnt(0);
    unsigned nloc = b.st[0], nx = b.st[1];
    if (nloc == 0u) { xcd_barrier_complete(bar, b.x, nloc, nx); b.st[0] = nloc; b.st[1] = nx; }
    const unsigned old = xb_add(&bar[XB_XSUB(b.x)], 1u);
    const unsigned gen = old / nloc;
    if (old + 1u == (gen + 1u) * nloc) {
      __builtin_amdgcn_fence(__ATOMIC_RELEASE, "agent");
      asm volatile("s_waitcnt vmcnt(0)" ::: "memory");
      const unsigned og = xb_add(&bar[XB_TOP], 1u);
      const unsigned tg = og / nx;
      if (og + 1u == (tg + 1u) * nx) xb_add(&bar[XB_TOPGEN], 1u);
      else XB_SPIN(xb_ld(&bar[XB_TOPGEN]) == tg, bar);
      __builtin_amdgcn_fence(__ATOMIC_ACQUIRE, "agent");
      xb_add(&bar[XB_XGEN(b.x)], 1u);
      asm volatile("s_waitcnt vmcnt(0)" ::: "memory");
    } else {
      XB_SPIN(xb_ld(&bar[XB_XGEN(b.x)]) == gen, bar);
      __builtin_amdgcn_fence(__ATOMIC_ACQUIRE, "agent");
      asm volatile("s_waitcnt vmcnt(0)" ::: "memory");
    }
  }
  __syncthreads();
}

namespace pg8 {
#define PG8_LAS __attribute__((address_space(3)))
typedef unsigned short bf16_t;
typedef short bf16x8 __attribute__((ext_vector_type(8)));
typedef float f32x4 __attribute__((ext_vector_type(4)));
typedef unsigned u32x4 __attribute__((ext_vector_type(4)));
constexpr int BM = 256, BK = 64, HALF = 128, HTB = HALF * BK * 2  , STAGE_BYTES = 8 * HTB, NXCD = 8, WGM = 8;

__host__ __device__ __forceinline__ int lds_byte(int r, int c) { const int st = (r >> 4) * 2 + (c >> 5), rr = r & 15, cc = c & 31, ob = rr * 64 + cc * 2; return st * 1024 + (ob ^ (((ob >> 9) & 1) << 5)); }
__host__ __device__ __forceinline__ void stage_rc(int b, int& R, int& C) { const int st = b / 1024, sb = b % 1024, swz = sb ^ (((sb >> 9) & 1) << 5); R = (st >> 1) * 16 + swz / 64; C = (st & 1) * 32 + (swz % 64) / 2; }
__host__ __device__ __forceinline__ int perm32(int rho) { const int n = rho >> 4, i = rho & 15; return 8 * (i >> 2) + 4 * n + (i & 3); }

struct Unit { int pm, pn; };
struct Gemm { const bf16_t* A; const bf16_t* Bt; int M, N, K; };

struct StaticOrder {
    int nM, nN, nwg, G, c;
    __host__ __device__ void init(int M, int N, int G_, int c_) { nM = M / BM; nN = N / BM; nwg = nM * nN; G = G_; c = c_; }
    __host__ __device__ bool next(int i, Unit& u) const {
        const long L = (long)i * G + c; if (L >= nwg) return false;
        int wgid = (int)L; { const int q = nwg / NXCD, r = nwg % NXCD, xcd = wgid % NXCD, off = wgid / NXCD; wgid = (xcd < r ? xcd * (q + 1) : r * (q + 1) + (xcd - r) * q) + off; }
        const int nig = WGM * nN, gid = wgid / nig, fm = gid * WGM, gsz = (nM - fm) < WGM ? (nM - fm) : WGM;
        u.pm = fm + ((wgid % nig) % gsz); u.pn = (wgid % nig) / gsz; return true;
    }
    __device__ __forceinline__ void a_ready(const Unit&) const {}
    __device__ __forceinline__ void done(const Unit&) const {}
};

template <class Epi, class Sched, bool STAMP = false>
__device__ __forceinline__ void gemm_phase(PG8_LAS unsigned char* lds, const Gemm g, const Sched& S, const Epi& E, unsigned long long* stamps) {
    int tid_ = threadIdx.x; asm volatile("" : "+v"(tid_));
    const int tid = tid_, wid = __builtin_amdgcn_readfirstlane(tid >> 6), lane = tid & 63, wr = wid >> 2, wc = wid & 3, fr = lane & 15, fq = lane >> 4;
    const int K = g.K, nt = K / BK;
    int ts_lo = 0, ts_hi = 0, nts = 0; const unsigned long long rt_entry = STAMP ? (unsigned long long)wall_clock64() : 0ull;
#define PG8_STAMP() do { if (STAMP && wid == 0 && nts < 64) { const unsigned long long _c = (unsigned long long)clock64(); \
        ts_lo = (lane == nts) ? (int)(unsigned)_c : ts_lo; ts_hi = (lane == nts) ? (int)(unsigned)(_c >> 32) : ts_hi; ++nts; } } while (0)
    PG8_STAMP();
    unsigned voffA[2], voffB[2];
#pragma unroll
    for (int i = 0; i < 2; ++i) { int R, C; stage_rc(tid * 16 + i * 8192, R, C); const int Rb = Epi::PERM ? ((R & ~31) + perm32(R & 31)) : R;
        voffA[i] = (unsigned)(R * K + C) * 2u; voffB[i] = (unsigned)(Rb * K + C) * 2u; }
    const size_t kstep = (size_t)(BK * 2);
    const size_t hstep = (size_t)HALF * K * 2;
    const size_t tstep = 2 * hstep;
    const unsigned ldsw = (unsigned)wid * 1024u;
    const int aoff = lds_byte(wr * 64 + fr, fq * 8), boff = lds_byte(wc * 32 + fr, fq * 8);
#define PG8_SA(b, h) (((b) * 2 + (h)) * HTB)
#define PG8_SB(b, h) ((4 + (b) * 2 + (h)) * HTB)
#define PG8_STAGE(bufoff, gbase, voff) do { _Pragma("unroll") for (int _i = 0; _i < 2; ++_i) \
        __builtin_amdgcn_global_load_lds((const unsigned*)((const char*)(gbase) + (voff)[_i]), (PG8_LAS unsigned*)(lds + (bufoff) + ldsw + _i * 8192), 16, 0, 0); } while (0)
#define PG8_LDA(dst, b, h) do { _Pragma("unroll") for (int m = 0; m < 4; ++m) _Pragma("unroll") for (int k = 0; k < 2; ++k) dst[m][k] = *(const PG8_LAS bf16x8*)(lds + PG8_SA(b, h) + aoff + m * 2048 + k * 1024); } while (0)
#define PG8_LDB(dst, b, h) do { _Pragma("unroll") for (int n = 0; n < 2; ++n) _Pragma("unroll") for (int k = 0; k < 2; ++k) dst[n][k] = *(const PG8_LAS bf16x8*)(lds + PG8_SB(b, h) + boff + n * 2048 + k * 1024); } while (0)
#define PG8_MMA(ai, bj, At, Bt) do { __builtin_amdgcn_s_setprio(1); _Pragma("unroll") for (int m = 0; m < 4; ++m) _Pragma("unroll") for (int n = 0; n < 2; ++n) _Pragma("unroll") for (int k = 0; k < 2; ++k) \
        acc[ai][bj][m][n] = __builtin_amdgcn_mfma_f32_16x16x32_bf16(Bt[n][k], At[m][k], acc[ai][bj][m][n], 0, 0, 0); __builtin_amdgcn_s_setprio(0); } while (0)
#define PG8_WAIT_V(n) asm volatile("s_waitcnt vmcnt(" #n ")" ::: "memory")
#define PG8_WAIT_L(n) asm volatile("s_waitcnt lgkmcnt(" #n ")" ::: "memory")
#define PG8_BAR __builtin_amdgcn_s_barrier()
#define PG8_SCHED __builtin_amdgcn_sched_barrier(0)
    Unit cur, nxt; int ui = 0;
    if (!S.next(0, cur)) return;
    f32x4 acc[2][2][4][2];
#pragma unroll
    for (int a = 0; a < 2; ++a)
#pragma unroll
        for (int b = 0; b < 2; ++b)
#pragma unroll
            for (int m = 0; m < 4; ++m)
#pragma unroll
                for (int n = 0; n < 2; ++n) acc[a][b][m][n] = (f32x4){0.f, 0.f, 0.f, 0.f};
    bf16x8 At[4][2], B0[2][2], B1[2][2];
    const char* cA = (const char*)g.A + (size_t)cur.pm * tstep; const char* cB = (const char*)g.Bt + (size_t)cur.pn * tstep;
    S.a_ready(cur);
    PG8_STAGE(PG8_SB(0, 0), cB, voffB); PG8_STAGE(PG8_SA(0, 0), cA, voffA); PG8_STAGE(PG8_SB(0, 1), cB + hstep, voffB); PG8_STAGE(PG8_SA(0, 1), cA + hstep, voffA);
    if (wr == 1) PG8_BAR;
    PG8_WAIT_V(4); PG8_BAR;
    PG8_STAGE(PG8_SB(1, 0), cB + kstep, voffB); PG8_STAGE(PG8_SA(1, 0), cA + kstep, voffA); PG8_STAGE(PG8_SB(1, 1), cB + hstep + kstep, voffB);
    PG8_WAIT_V(6); PG8_BAR;
    PG8_STAMP();
    for (;;) {
        const bool has_next = S.next(ui + 1, nxt);
        const char* nA = has_next ? (const char*)g.A + (size_t)nxt.pm * tstep : cA; const char* nB = has_next ? (const char*)g.Bt + (size_t)nxt.pn * tstep : cB;
        for (int t = 0; t < nt; t += 2) {
            const bool last = (t == nt - 2);
            const char* a1 = cA + (size_t)(t + 1) * kstep;
            const char* a2 = last ? nA : cA + (size_t)(t + 2) * kstep; const char* b2 = last ? nB : cB + (size_t)(t + 2) * kstep;
            const char* a3 = a2 + kstep; const char* b3 = b2 + kstep;
            if (last && has_next) S.a_ready(nxt);
            PG8_LDB(B0, 0, 0); PG8_SCHED; PG8_LDA(At, 0, 0); PG8_STAGE(PG8_SA(1, 1), a1 + hstep, voffA);
            PG8_WAIT_L(8); PG8_BAR; PG8_WAIT_L(0); PG8_MMA(0, 0, At, B0); PG8_BAR; PG8_SCHED;
            PG8_LDB(B1, 0, 1); PG8_STAGE(PG8_SB(0, 0), b2, voffB);
            PG8_BAR; PG8_WAIT_L(0); PG8_MMA(0, 1, At, B1); PG8_BAR;
            PG8_LDA(At, 0, 1); PG8_STAGE(PG8_SA(0, 0), a2, voffA);
            PG8_BAR; PG8_WAIT_L(0); PG8_MMA(1, 0, At, B0); PG8_BAR; PG8_SCHED;
            PG8_STAGE(PG8_SB(0, 1), b2 + hstep, voffB);
            PG8_WAIT_V(6); PG8_BAR; PG8_MMA(1, 1, At, B1); PG8_BAR;
            PG8_LDB(B0, 1, 0); PG8_SCHED; PG8_LDA(At, 1, 0); PG8_STAGE(PG8_SA(0, 1), a2 + hstep, voffA);
            PG8_WAIT_L(8); PG8_BAR; PG8_WAIT_L(0); PG8_MMA(0, 0, At, B0); PG8_BAR; PG8_SCHED;
            PG8_LDB(B1, 1, 1); PG8_STAGE(PG8_SB(1, 0), b3, voffB);
            PG8_BAR; PG8_WAIT_L(0); PG8_MMA(0, 1, At, B1); PG8_BAR;
            PG8_LDA(At, 1, 1); PG8_STAGE(PG8_SA(1, 0), a3, voffA);
            PG8_BAR; PG8_WAIT_L(0); PG8_MMA(1, 0, At, B0); PG8_BAR; PG8_SCHED;
            PG8_STAGE(PG8_SB(1, 1), b3 + hstep, voffB);
            PG8_WAIT_V(6); PG8_BAR; PG8_MMA(1, 1, At, B1); PG8_BAR;
        }
        PG8_STAMP();
        if constexpr (!Epi::AFTER_DRAIN) { E(acc, cur, wr, wc, fr, fq); S.done(cur); }
        PG8_STAMP();
        if (!has_next) break;
#pragma unroll
        for (int a = 0; a < 2; ++a)
#pragma unroll
            for (int b = 0; b < 2; ++b)
#pragma unroll
                for (int m = 0; m < 4; ++m)
#pragma unroll
                    for (int n = 0; n < 2; ++n) acc[a][b][m][n] = (f32x4){0.f, 0.f, 0.f, 0.f};
        cur = nxt; cA = nA; cB = nB; ++ui;
    }
    PG8_WAIT_V(0);
    if (wr == 0) PG8_BAR;
    PG8_BAR;
    if constexpr (Epi::AFTER_DRAIN) { E.fused(acc, cur, wr, wc, fr, fq, lds, wid, lane); S.done(cur); }
    PG8_STAMP();
    if (STAMP && wid == 0) { stamps[lane] = lane < nts ? (((unsigned long long)(unsigned)ts_hi << 32) | (unsigned)ts_lo) : 0ull;
        if (lane == 62) stamps[62] = rt_entry; if (lane == 63) stamps[63] = (unsigned long long)wall_clock64(); }
#undef PG8_STAMP
#undef PG8_SA
#undef PG8_SB
#undef PG8_STAGE
#undef PG8_LDA
#undef PG8_LDB
#undef PG8_MMA
#undef PG8_WAIT_V
#undef PG8_WAIT_L
#undef PG8_BAR
#undef PG8_SCHED
}
}


#define PG_EPI_ROWS(ROWBODY)                                                                     \
  _Pragma("unroll") for (int ai = 0; ai < 2; ++ai) _Pragma("unroll") for (int m = 0; m < 4; ++m) { \
    int row = u.pm * 256 + ai * 128 + wr * 64 + m * 16 + fr;                                      \
    asm volatile("" : "+v"(row));                                                                 \
    ROWBODY                                                                                       \
    asm volatile("" ::: "memory"); }
#define PG_EPI_COLS(COLBODY)                                                                      \
  _Pragma("unroll") for (int bj = 0; bj < 2; ++bj) _Pragma("unroll") for (int n = 0; n < 2; ++n) { \
    const int col = u.pn * 256 + bj * 128 + wc * 32 + 8 * fq + 4 * n;                             \
    const f32x4 v = acc[ai][bj][m][n];                                                            \
    COLBODY }
typedef const f32x4 (&PgAcc)[2][2][4][2];
#define PG_ROW_OF(r) (u.pm * 256 + ((r) >> 2) * 128 + wr * 64 + ((r) & 3) * 16 + fr)
#define PG_EPI_PIPELINED(LOADS, USE)                                                            \
  {                                                                                             \
    const int colb = u.pn * 256 + wc * 32 + 8 * fq;                                             \
    int row = PG_ROW_OF(0);                                                                     \
    asm volatile("" : "+v"(row));                                                               \
    { const int lrow = row; _Pragma("unroll") for (int c = 0; c < 4; ++c) { const int slot = 0; const unsigned off = (unsigned)(lrow * DM + colb + (c >> 1) * 128 + (c & 1) * 4); LOADS } } \
    _Pragma("unroll") for (int r = 0; r < 8; ++r) {                                             \
      int rown = PG_ROW_OF((r + 1) & 7);                                                        \
      asm volatile("" : "+v"(rown));                                                            \
      if (r < 7) { const int lrow = rown; _Pragma("unroll") for (int c = 0; c < 4; ++c) { const int slot = (r + 1) & 1; const unsigned off = (unsigned)(lrow * DM + colb + (c >> 1) * 128 + (c & 1) * 4); LOADS } } \
      _Pragma("unroll") for (int c = 0; c < 4; ++c) {                                           \
        const int slot = r & 1;                                                                 \
        const unsigned off = (unsigned)(row * DM + colb + (c >> 1) * 128 + (c & 1) * 4);       \
        const f32x4 v = acc[r >> 2][c >> 1][r & 3][c & 1];                                      \
        USE }                                                                                   \
      asm volatile("" ::: "memory");                                                            \
      row = rown;                                                                               \
    }                                                                                           \
  }
DEVI bf16x4 to_bf4(f32x4 v) { bf16x4 o; o[0] = (bf16)v.x; o[1] = (bf16)v.y; o[2] = (bf16)v.z; o[3] = (bf16)v.w; return o; }
template <class Epi> DEVI void run_gemm(unsigned char* smem, const bf16* A, const bf16* Bt, int M, int N, int K, const Epi& E) {
  pg8::Gemm g; g.A = (const pg8::bf16_t*)A; g.Bt = (const pg8::bf16_t*)Bt; g.M = M; g.N = N; g.K = K;
  pg8::StaticOrder S; S.init(M, N, (int)gridDim.x, (int)blockIdx.x);
  pg8::gemm_phase<Epi, pg8::StaticOrder, false>((PG8_LAS unsigned char*)smem, g, S, E, nullptr);
}

template <int MTILES, int NTILES, int R>
DEVI bool tile_map(int it, int& mt, int& nt) {
  const int xcd = blockIdx.x & 7, slot = blockIdx.x >> 3, nslots = gridDim.x >> 3;
  const int L = it * nslots + slot;
  if (L >= (MTILES / 8) * NTILES) return false;
  const int group = L / (R * NTILES), rem = L % (R * NTILES);
  nt = rem / R;
  mt = (group * R + (rem % R)) * 8 + xcd;
  return true;
}

DEVI void transpose_job(const float* __restrict__ src, int ld, int n0, int nvalid, int npad, int K, bf16* __restrict__ dst, float* smf, const float* __restrict__ kscale = nullptr) {
  const int vb = threadIdx.x >> 8, tid = threadIdx.x & 255;
  float* sm = smf + vb * (64 * 65);
  const int ktiles = K >> 6, ntiles = (npad >> 6) * ktiles;
  const int ty = tid >> 4, tx = tid & 15;
  for (int base = blockIdx.x * 2; base < ntiles; base += gridDim.x * 2) {
    const int tile = base + vb;
    const bool ok = tile < ntiles;
    const int nb = (tile / ktiles) << 6, kb = (tile % ktiles) << 6;
    if (ok) {
#pragma unroll
      for (int i = 0; i < 4; ++i) {
        const int k = kb + ty + 16 * i, n = nb + tx * 4;
        f32x4 v = mk_f4(0.f, 0.f, 0.f, 0.f);
        if (n < nvalid) v = *(const f32x4*)(src + (size_t)k * ld + n0 + n);
        if (kscale) v = v * kscale[k];
        float* q = sm + (ty + 16 * i) * 65 + tx * 4;
        q[0] = v.x; q[1] = v.y; q[2] = v.z; q[3] = v.w;
      }
    }
    __syncthreads();
    if (ok) {
      const int n = tid >> 2, kq = tid & 3;
      bf16x8 o0, o1;
#pragma unroll
      for (int j = 0; j < 8; ++j) {
        o0[j] = (bf16)sm[(kq * 16 + j) * 65 + n];
        o1[j] = (bf16)sm[(kq * 16 + 8 + j) * 65 + n];
      }
      bf16* d = dst + (size_t)(nb + n) * K + kb + kq * 16;
      *(bf16x8*)d = o0;
      *(bf16x8*)(d + 8) = o1;
    }
    __syncthreads();
  }
}

DEVI void convert_job(const float* __restrict__ src, bf16* __restrict__ dst, size_t n) {
  const size_t n4 = n >> 2;
  for (size_t i = (size_t)blockIdx.x * NTHREADS + threadIdx.x; i < n4; i += (size_t)gridDim.x * NTHREADS) {
    const f32x4 v = ((const f32x4*)src)[i];
    bf16x4 o; o[0] = (bf16)v.x; o[1] = (bf16)v.y; o[2] = (bf16)v.z; o[3] = (bf16)v.w;
    ((bf16x4*)dst)[i] = o;
  }
}


DEVI void fp4_rows_job(const float* __restrict__ src, unsigned char* __restrict__ dst, float* __restrict__ inv, const float* __restrict__ cscale = nullptr) {
  const int lane = threadIdx.x & 63;
  const int gw = blockIdx.x * NWAVES + (threadIdx.x >> 6), nw = gridDim.x * NWAVES;
  for (int r = gw; r < 16384; r += nw) {
    const float* sp = src + (size_t)r * 1024 + lane * 16;
    f32x4 v[4];
    float mx = 0.f;
#pragma unroll
    for (int i = 0; i < 4; ++i) {
      v[i] = *(const f32x4*)(sp + i * 4);
      if (cscale) v[i] = v[i] * *(const f32x4*)(cscale + lane * 16 + i * 4);
      mx = fmaxf(mx, fmaxf(fmaxf(fabsf(v[i].x), fabsf(v[i].y)), fmaxf(fabsf(v[i].z), fabsf(v[i].w))));
    }
#pragma unroll
    for (int o = 32; o > 0; o >>= 1) mx = fmaxf(mx, __shfl_xor(mx, o, 64));
    const float sc = (mx > 0.f) ? 6.f / mx : 1.f;
    u32x2 o2;
#pragma unroll
    for (int d = 0; d < 2; ++d) {
      unsigned w = 0u;
      w = __builtin_amdgcn_cvt_scalef32_pk_fp4_f32(w, v[2 * d].x * sc, v[2 * d].y * sc, 1.0f, 0);
      w = __builtin_amdgcn_cvt_scalef32_pk_fp4_f32(w, v[2 * d].z * sc, v[2 * d].w * sc, 1.0f, 1);
      w = __builtin_amdgcn_cvt_scalef32_pk_fp4_f32(w, v[2 * d + 1].x * sc, v[2 * d + 1].y * sc, 1.0f, 2);
      w = __builtin_amdgcn_cvt_scalef32_pk_fp4_f32(w, v[2 * d + 1].z * sc, v[2 * d + 1].w * sc, 1.0f, 3);
      o2[d] = w;
    }
    *(u32x2*)(dst + (size_t)r * 512 + lane * 8) = o2;
    if (lane == 0) inv[r] = 1.f / sc;
  }
}

DEVI void rmsnorm_rows_bf16(const float* src, const float* __restrict__ gain, bf16* __restrict__ dst) {
  const int lane = threadIdx.x & 63;
  const int gw = blockIdx.x * NWAVES + (threadIdx.x >> 6), nw = gridDim.x * NWAVES;
  f32x4 gn[4];
#pragma unroll
  for (int i = 0; i < 4; ++i) gn[i] = *(const f32x4*)(gain + i * 256 + lane * 4);
  for (int t = gw; t < T_TOK; t += nw) {
    const float* xr = src + (size_t)t * DM;
    f32x4 v[4];
    float ss = 0.f;
#pragma unroll
    for (int i = 0; i < 4; ++i) {
      v[i] = *(const f32x4*)(xr + i * 256 + lane * 4);
      ss += v[i].x * v[i].x + v[i].y * v[i].y + v[i].z * v[i].z + v[i].w * v[i].w;
    }
    ss = wave_sum(ss);
    const float rs = rsqrtf(ss * (1.f / DM) + 1e-6f);
#pragma unroll
    for (int i = 0; i < 4; ++i) {
      bf16x4 o;
      o[0] = (bf16)(v[i].x * rs * gn[i].x); o[1] = (bf16)(v[i].y * rs * gn[i].y);
      o[2] = (bf16)(v[i].z * rs * gn[i].z); o[3] = (bf16)(v[i].w * rs * gn[i].w);
      *(bf16x4*)(dst + (size_t)t * DM + i * 256 + lane * 4) = o;
    }
  }
}

DEVI void rmsnorm_rows_bf16_from_bf16(const bf16* __restrict__ src, const float* __restrict__ gain, bf16* __restrict__ dst) {
  const int lane = threadIdx.x & 63;
  const int gw = blockIdx.x * NWAVES + (threadIdx.x >> 6), nw = gridDim.x * NWAVES;
  f32x4 gn[4];
#pragma unroll
  for (int i = 0; i < 4; ++i) gn[i] = *(const f32x4*)(gain + i * 256 + lane * 4);
  for (int t = gw; t < T_TOK; t += nw) {
    const bf16* xr = src + (size_t)t * DM;
    bf16x4 v[4];
    float ss = 0.f;
#pragma unroll
    for (int i = 0; i < 4; ++i) {
      v[i] = *(const bf16x4*)(xr + i * 256 + lane * 4);
#pragma unroll
      for (int j = 0; j < 4; ++j) ss += (float)v[i][j] * (float)v[i][j];
    }
    ss = wave_sum(ss);
    const float rs = rsqrtf(ss * (1.f / DM) + 1e-6f);
#pragma unroll
    for (int i = 0; i < 4; ++i) {
      bf16x4 o;
      o[0] = (bf16)((float)v[i][0] * rs * gn[i].x); o[1] = (bf16)((float)v[i][1] * rs * gn[i].y);
      o[2] = (bf16)((float)v[i][2] * rs * gn[i].z); o[3] = (bf16)((float)v[i][3] * rs * gn[i].w);
      *(bf16x4*)(dst + (size_t)t * DM + i * 256 + lane * 4) = o;
    }
  }
}

DEVI void phase0(const ParamsG& p, unsigned char* smem) {
  unsigned char* ws = gp(p.ws);
  float* smf = (float*)smem;
#define TJOB(SRC, LD, N0, NVALID, NPAD, KK, OFF) transpose_job((SRC), (LD), (N0), (NVALID), (NPAD), (KK), (bf16*)(ws + (OFF)), smf);
  TJOB(gp(p.w_in), IN_COLS, 0, 2464, 2560, 1024, OFF_WIN_T)
  TJOB(gp(p.w_in), IN_COLS, 2464, 2048, 2048, 1024, OFF_WG_T)
  TJOB(gp(p.rw_w_o), 1024, 0, 1024, 1024, 512, OFF_RWO_T)
  TJOB(gp(p.mla_w_o), 1024, 0, 1024, 1024, 512, OFF_MLO_T)
  TJOB(gp(p.mla_w_uq), 768, 0, 768, 768, 384, OFF_WUQ_T)
  TJOB(gp(p.mla_w_ukv), 1024, 0, 1024, 1024, 256, OFF_WUKV_T)
  TJOB(gp(p.w_out), 1024, 0, 1024, 1024, 1024, OFF_WOUT_T)
  transpose_job(gp(p.peer_w_q), 2048, 0, 2048, 2048, 1024, (bf16*)(ws + OFF_WQ_T), smf, gp(p.norm_ffn));
  TJOB(gp(p.ple_w_gate), 1024, 0, 1024, 1024, 1024, OFF_PG_T)
  TJOB(gp(p.ple_w_proj), 1024, 0, 1024, 1024, 256, OFF_PP_T)
#undef TJOB
  {
    bf16* wl = (bf16*)(ws + OFF_WLORA_T);
    for (int i = blockIdx.x * NTHREADS + threadIdx.x; i < 1536 * 256; i += gridDim.x * NTHREADS) {
      const int n = i >> 8, k = i & 255;
      float v = 0.f;
      if (n < 512) { if (k < 64) v = gp(p.rw_w2)[k * 512 + n]; }
      else if (n < 1024) { if (k >= 64 && k < 128) v = gp(p.rw_a2)[(k - 64) * 512 + (n - 512)]; }
      else { if (k >= 128) v = gp(p.rw_g2)[(k - 128) * 512 + (n - 1024)]; }
      wl[i] = (bf16)v;
    }
  }
  convert_job(gp(p.peer_sub_keys), (bf16*)(ws + OFF_SK), (size_t)8 * 2 * 128 * 128);
  fp4_rows_job(gp(p.peer_u), ws + OFF_U8, (float*)(ws + OFF_IUS), gp(p.norm_ffn));
  fp4_rows_job(gp(p.peer_v), ws + OFF_V8, (float*)(ws + OFF_IVS));
  convert_job(gp(p.p), (bf16*)(ws + OFF_PBF), (size_t)T_TOK * 256);
  rmsnorm_rows_bf16(gp(p.x), gp(p.norm_mix), (bf16*)(ws + OFF_H1));
  {
    float* cs = (float*)(ws + OFF_CS);
    float* sn = (float*)(ws + OFF_SN);
    for (int i = blockIdx.x * NTHREADS + threadIdx.x; i < T_TOK * 16; i += gridDim.x * NTHREADS) {
      const int t = i >> 4, f = i & 15;
      const float inv = powf(10000.f, -(float)(2 * f) / 32.f);
      const float ang = (float)gp(p.pos)[t] * inv;
      double s, c;
      sincos((double)ang, &s, &c);
      cs[i] = (float)c; sn[i] = (float)s;
    }
  }
  if (blockIdx.x == 0 && threadIdx.x < 64) ((unsigned*)(ws + OFF_CNT))[threadIdx.x] = 0u;
  if (blockIdx.x == 0) for (int i = threadIdx.x; i < XCD_BAR_WORDS; i += NTHREADS) ((unsigned*)(ws + OFF_BAR))[i] = 0u;
}

struct EpiZ {
  static constexpr bool PERM = true, AFTER_DRAIN = false;
  bf16* zrw; bf16* zmla;
  DEVI void operator()(PgAcc acc, const pg8::Unit& u, int wr, int wc, int fr, int fq) const {
    PG_EPI_ROWS(PG_EPI_COLS(
      if (col < RWC) *(bf16x4*)(zrw + (unsigned)(row * RWC + col)) = to_bf4(v);
      else if (col < RWC + MLC) *(bf16x4*)(zmla + (unsigned)(row * MLC + (col - RWC))) = to_bf4(v);
    ))
  }
};
DEVI void phase1(const ParamsG& p, unsigned char* smem) {
  EpiZ e; e.zrw = (bf16*)(gp(p.ws) + OFF_ZRW); e.zmla = (bf16*)(gp(p.ws) + OFF_ZMLA);
  run_gemm(smem, (const bf16*)(gp(p.ws) + OFF_H1), (const bf16*)(gp(p.ws) + OFF_WIN_T), T_TOK, 2560, DM, e);
}

DEVI void phase2a(const ParamsG& p) {
  const int lane = threadIdx.x & 63;
  const int gw = blockIdx.x * NWAVES + (threadIdx.x >> 6), nw = gridDim.x * NWAVES;
  const bf16* zrw = (const bf16*)(gp(p.ws) + OFF_ZRW);
  const bf16* zmla = (const bf16*)(gp(p.ws) + OFF_ZMLA);
  bf16* lora = (bf16*)(gp(p.ws) + OFF_LORA);
  bf16* cq = (bf16*)(gp(p.ws) + OFF_CQ);
  bf16* ckv = (bf16*)(gp(p.ws) + OFF_CKV);
  bf16* Kd = (bf16*)((unsigned char*)gp(p.out) + OFF_K);
  const float* cs = (const float*)(gp(p.ws) + OFF_CS);
  const float* sn = (const float*)(gp(p.ws) + OFF_SN);
  const f32x4 mu = *(const f32x4*)(gp(p.rw_mu) + 1536 + lane * 4);
  const f32x4 qg0 = *(const f32x4*)(gp(p.mla_q_norm) + lane * 4);
  const f32x2 qg1 = *(const f32x2*)(gp(p.mla_q_norm) + 256 + lane * 2);
  const f32x4 kg = *(const f32x4*)(gp(p.mla_kv_norm) + lane * 4);
  const float mua[4] = {mu.x, mu.y, mu.z, mu.w};
  for (int t = gw; t < T_TOK; t += nw) {
    const int s = t & (SEQ - 1), b = t >> 12;
    {
      const bf16* zp = zrw + (size_t)t * RWC + 1536 + lane * 4;
      const bf16x4 zc = *(const bf16x4*)zp;
      bf16x4 zv;
      if (s > 0) zv = *(const bf16x4*)(zp - RWC);
      else { zv[0] = (bf16)0.f; zv[1] = (bf16)0.f; zv[2] = (bf16)0.f; zv[3] = (bf16)0.f; }
      bf16x4 o;
#pragma unroll
      for (int j = 0; j < 4; ++j) {
        const float c = (float)zc[j], pv = (float)zv[j];
        const float zs = c + mua[j] * (pv - c);
        float val;
        if (lane < 16) val = tanhf(zs);
        else if (lane < 32) val = zs;
        else val = sigmoid_f(zs);
        o[j] = (bf16)val;
      }
      *(bf16x4*)(lora + (size_t)t * 256 + lane * 4) = o;
    }
    {
      const bf16* zq = zmla + (size_t)t * MLC;
      const bf16x4 q0 = *(const bf16x4*)(zq + lane * 4);
      const bf16x2 q1 = *(const bf16x2*)(zq + 256 + lane * 2);
      float f[6] = {(float)q0[0], (float)q0[1], (float)q0[2], (float)q0[3], (float)q1[0], (float)q1[1]};
      float ss = 0.f;
#pragma unroll
      for (int j = 0; j < 6; ++j) ss += f[j] * f[j];
      ss = wave_sum(ss);
      const float rs = rsqrtf(ss * (1.f / 384.f) + 1e-6f);
      bf16x4 o0; bf16x2 o1;
      o0[0] = (bf16)(f[0] * rs * qg0.x); o0[1] = (bf16)(f[1] * rs * qg0.y);
      o0[2] = (bf16)(f[2] * rs * qg0.z); o0[3] = (bf16)(f[3] * rs * qg0.w);
      o1[0] = (bf16)(f[4] * rs * qg1.x); o1[1] = (bf16)(f[5] * rs * qg1.y);
      *(bf16x4*)(cq + (size_t)t * 384 + lane * 4) = o0;
      *(bf16x2*)(cq + (size_t)t * 384 + 256 + lane * 2) = o1;
    }
    {
      const bf16x4 k0 = *(const bf16x4*)(zmla + (size_t)t * MLC + 384 + lane * 4);
      float f[4] = {(float)k0[0], (float)k0[1], (float)k0[2], (float)k0[3]};
      float ss = f[0] * f[0] + f[1] * f[1] + f[2] * f[2] + f[3] * f[3];
      ss = wave_sum(ss);
      const float rs = rsqrtf(ss * (1.f / 256.f) + 1e-6f);
      bf16x4 o;
      o[0] = (bf16)(f[0] * rs * kg.x); o[1] = (bf16)(f[1] * rs * kg.y);
      o[2] = (bf16)(f[2] * rs * kg.z); o[3] = (bf16)(f[3] * rs * kg.w);
      *(bf16x4*)(ckv + (size_t)t * 256 + lane * 4) = o;
    }
    {
      const float xr = (float)zmla[(size_t)t * MLC + 640 + (lane & 31)];
      const float xp = __shfl_xor(xr, 16, 64);
      const int f = lane & 15;
      const float c = cs[t * 16 + f], sv = sn[t * 16 + f];
      const float o = (lane & 16) ? (xr * c + xp * sv) : (xr * c - xp * sv);
      if (lane < 32) {
        const bf16 ob = (bf16)o;
#pragma unroll
        for (int h = 0; h < 8; ++h) Kd[((size_t)(b * 8 + h) * SEQ + s) * 96 + 64 + lane] = ob;
      }
    }
  }
}

constexpr float QSCALE = 0.14724444f;
template <bool SSQ = false>
DEVI void route_mainloop(f32x16 (&acc)[4], const bf16* __restrict__ A, int lda, const bf16* __restrict__ B, int ldb, int nk, unsigned char* base,
                         const bf16* __restrict__ sk = nullptr, float* ssq = nullptr) {
  const int tid = threadIdx.x, lane = tid & 63, w = tid >> 6;
  unsigned ao[2], bo[4];
#pragma unroll
  for (int i = 0; i < 2; ++i) { const int r = (w + 8 * i) * 8 + (lane >> 3); ao[i] = (unsigned)(r * lda + (((lane & 7) ^ ((r >> 1) & 7)) * 8)) * 2u; }
#pragma unroll
  for (int i = 0; i < 4; ++i) { const int r = (w + 8 * i) * 8 + (lane >> 3); bo[i] = (unsigned)(r * ldb + (((lane & 7) ^ ((r >> 1) & 7)) * 8)) * 2u; }
  const int sw = (lane >> 1) & 7, hh = lane >> 5;
  const int arow = (lane & 31) * 128, brow = (w * 32 + (lane & 31)) * 128;
  auto issue = [&](int kt, int slot) {
    unsigned char* nb = base + slot * 49152;
#pragma unroll
    for (int i = 0; i < 2; ++i)
      __builtin_amdgcn_global_load_lds((const unsigned*)((const char*)A + (ao[i] + (unsigned)kt * 128u)), (__attribute__((address_space(3))) unsigned*)(nb + (w + 8 * i) * 1024), 16, 0, 0);
#pragma unroll
    for (int i = 0; i < 4; ++i)
      __builtin_amdgcn_global_load_lds((const unsigned*)((const char*)B + (bo[i] + (unsigned)kt * 128u)), (__attribute__((address_space(3))) unsigned*)(nb + 16384 + (w + 8 * i) * 1024), 16, 0, 0);
  };
  float ss0 = 0.f, ss1 = 0.f;
  __syncthreads();
  issue(0, 0);
  issue(1, 1);
  int cur = 0;
  for (int kt = 0; kt < nk; ++kt) {
    if (kt + 1 < nk) asm volatile("s_waitcnt vmcnt(6)" ::: "memory");
    else if (sk) asm volatile("s_waitcnt vmcnt(4)" ::: "memory");
    else asm volatile("s_waitcnt vmcnt(0)" ::: "memory");
    __syncthreads();
    int nx2 = cur + 2; if (nx2 >= 3) nx2 -= 3;
    if (kt + 2 < nk) issue(kt + 2, nx2);
    else if (kt + 2 == nk && sk) {
#pragma unroll
      for (int i = 0; i < 4; ++i) {
        const int r = (w * 4 + i) * 4 + (lane >> 4);
        const int ch = (lane & 15) ^ (r & 15);
        __builtin_amdgcn_global_load_lds((const unsigned*)((const char*)sk + (unsigned)(r * 128 + ch * 8) * 2u), (__attribute__((address_space(3))) unsigned*)(base + nx2 * 49152 + (w * 4 + i) * 1024), 16, 0, 0);
      }
    }
    const unsigned char* cb = base + cur * 49152;
    cur = (cur == 2) ? 0 : cur + 1;
#pragma unroll
    for (int ks = 0; ks < 4; ++ks) {
      const int co = ((ks * 2 + hh) ^ sw) * 16;
      const bf16x8 bfr = *(const bf16x8*)(cb + 16384 + brow + co);
      if (SSQ) {
        const u32x4 bu = __builtin_bit_cast(u32x4, bfr);
        ss0 = dot2bf(bu.x, bu.x, ss0); ss1 = dot2bf(bu.y, bu.y, ss1);
        ss0 = dot2bf(bu.z, bu.z, ss0); ss1 = dot2bf(bu.w, bu.w, ss1);
      }
#pragma unroll
      for (int mt = 0; mt < 4; ++mt) {
        const bf16x8 af = *(const bf16x8*)(cb + arow + mt * 4096 + co);
        acc[mt] = __builtin_amdgcn_mfma_f32_32x32x16_bf16(af, bfr, acc[mt], 0, 0, 0);
      }
    }
  }
  if (SSQ) *ssq = ss0 + ss1;
  if (sk) { asm volatile("s_waitcnt vmcnt(0)" ::: "memory"); __syncthreads(); }
}
DEVI void phase2b(const ParamsG& p, unsigned char* smem) {
  unsigned char* ws = gp(p.ws);
  const bf16* LORA = (const bf16*)(ws + OFF_LORA);
  const bf16* CQ = (const bf16*)(ws + OFF_CQ);
  const bf16* CKV = (const bf16*)(ws + OFF_CKV);
  bf16* E = (bf16*)(ws + OFF_E);
  bf16* ICLR = (bf16*)(ws + OFF_ICLR);
  bf16* G = (bf16*)(ws + OFF_G);
  bf16* Qd = (bf16*)((unsigned char*)gp(p.out) + OFF_Q);
  bf16* Kd = (bf16*)((unsigned char*)gp(p.out) + OFF_K);
  bf16* Vd = (bf16*)((unsigned char*)gp(p.out) + OFF_VT);
  const int lane = threadIdx.x & 63, w = threadIdx.x >> 6, hh = lane >> 5;
  for (int it = 0;; ++it) {
    int tm, j;
    if (!tile_map<128, 26, 2>(it, tm, j)) break;
    const int m0 = tm * 256;
    const bf16* A; const bf16* Bm; int K, kind, n0;
    if (j < 12) { kind = 0; n0 = j * 128; K = 256; A = (const bf16*)(ws + OFF_WLORA_T) + (size_t)n0 * 256; Bm = LORA + (size_t)m0 * 256; }
    else if (j < 18) { kind = 1; n0 = (j - 12) * 128; K = 384; A = (const bf16*)(ws + OFF_WUQ_T) + (size_t)n0 * 384; Bm = CQ + (size_t)m0 * 384; }
    else { kind = 2; n0 = (j - 18) * 128; K = 256; A = (const bf16*)(ws + OFF_WUKV_T) + (size_t)n0 * 256; Bm = CKV + (size_t)m0 * 256; }
    f32x16 acc[4];
#pragma unroll
    for (int mt = 0; mt < 4; ++mt)
#pragma unroll
      for (int r = 0; r < 16; ++r) acc[mt][r] = 0.f;
    route_mainloop(acc, A, K, Bm, K, K >> 6, smem);
    {
      bf16* wb = (bf16*)(smem + w * 8704);
      __syncthreads();
#pragma unroll
      for (int mt = 0; mt < 4; ++mt)
#pragma unroll
        for (int rg = 0; rg < 4; ++rg) {
          f32x4 v; v.x = acc[mt][4 * rg + 0]; v.y = acc[mt][4 * rg + 1]; v.z = acc[mt][4 * rg + 2]; v.w = acc[mt][4 * rg + 3];
          if (kind == 1) v = v * QSCALE;
          *(bf16x4*)(wb + (lane & 31) * 136 + mt * 32 + 8 * rg + 4 * hh) = to_bf4(v);
        }
      __builtin_amdgcn_fence(__ATOMIC_RELEASE, "wavefront");
#pragma unroll
      for (int ps = 0; ps < 8; ++ps) {
        const int tl = ps * 4 + (lane >> 4), f0 = (lane & 15) * 8;
        const u32x4 v = *(const u32x4*)(wb + tl * 136 + f0);
        const size_t tok = (size_t)m0 + w * 32 + tl;
        const size_t bb = tok >> 12, ss = tok & (SEQ - 1);
        if (kind == 0) {
          bf16* D = (n0 < 512) ? E : ((n0 < 1024) ? ICLR : G);
          *(u32x4*)(D + tok * 512 + (n0 & 511) + f0) = v;
        } else if (kind == 1) {
          const int f = n0 + f0, head = f / 96, d = f - head * 96;
          *(u32x4*)(Qd + ((bb * 8 + head) * SEQ + ss) * 96 + d) = v;
        } else {
          const int head = n0 >> 7;
          if (f0 < 64) *(u32x4*)(Kd + ((bb * 8 + head) * SEQ + ss) * 96 + f0) = v;
          else *(u32x4*)(Vd + ((bb * 8 + head) * SEQ + ss) * 64 + (f0 - 64)) = v;
        }
      }
    }
  }
}

struct ScanBuf { float A[16][64], B[16][64], W[16][64], K2[16][64], R[16][64]; float V[16][16]; };
DEVI void phase3a(const ParamsG& p, unsigned char* smem) {
  ScanBuf* sb = (ScanBuf*)smem;
  const bf16* zrw = (const bf16*)(gp(p.ws) + OFF_ZRW);
  const bf16* E = (const bf16*)(gp(p.ws) + OFF_E);
  const bf16* ICLR = (const bf16*)(gp(p.ws) + OFF_ICLR);
  bf16* YRAW = (bf16*)(gp(p.ws) + OFF_YRAW);
  float* RK = (float*)(gp(p.ws) + OFF_RK);
  const int role = threadIdx.x >> 8;
  const int tid = threadIdx.x & 255, lane = tid & 63, w = tid >> 6;
  const int pi = tid >> 4, kq = tid & 15;
  const int rloc = 4 * w + (lane >> 4), kg = lane & 15;
  if (role == 0) __builtin_amdgcn_s_setprio(3);
  for (int item = blockIdx.x; item < 256; item += gridDim.x) {
    const int bh = item >> 2, quarter = item & 3, b = bh >> 3, h = bh & 7;
    const int c0 = h * 64 + 4 * kq;
    if (role == 1) {
      const f32x4 mur = *(const f32x4*)(gp(p.rw_mu) + c0);
      const f32x4 muk = *(const f32x4*)(gp(p.rw_mu) + 512 + c0);
      const f32x4 muv = *(const f32x4*)(gp(p.rw_mu) + 1024 + c0);
      const f32x4 kkw = *(const f32x4*)(gp(p.rw_k_k) + c0);
      const f32x4 kaw = *(const f32x4*)(gp(p.rw_k_a) + c0);
      const f32x4 rkw = *(const f32x4*)(gp(p.rw_r_k) + c0);
      const f32x4 w0v = *(const f32x4*)(gp(p.rw_w0) + c0);
      const f32x4 a0v = *(const f32x4*)(gp(p.rw_a0) + c0);
      const float w0_[4] = {w0v.x, w0v.y, w0v.z, w0v.w}, a0_[4] = {a0v.x, a0v.y, a0v.z, a0v.w};
      const float mur_[4] = {mur.x, mur.y, mur.z, mur.w}, muk_[4] = {muk.x, muk.y, muk.z, muk.w},
                  muv_[4] = {muv.x, muv.y, muv.z, muv.w}, kkw_[4] = {kkw.x, kkw.y, kkw.z, kkw.w},
                  kaw_[4] = {kaw.x, kaw.y, kaw.z, kaw.w}, rkw_[4] = {rkw.x, rkw.y, rkw.z, rkw.w};
      bf16x4 zr, zk, zv, pr, pk, pv, ic;
      f32x4 ee;
      auto load_raw = [&](int c) {
        const int s = c * 16 + pi;
        const size_t t = (size_t)b * SEQ + s;
        const bf16* zp = zrw + t * RWC + c0;
        zr = *(const bf16x4*)zp; zk = *(const bf16x4*)(zp + 512); zv = *(const bf16x4*)(zp + 1024);
        if (s > 0) {
          pr = *(const bf16x4*)(zp - RWC); pk = *(const bf16x4*)(zp - RWC + 512); pv = *(const bf16x4*)(zp - RWC + 1024);
        } else {
#pragma unroll
          for (int j = 0; j < 4; ++j) { pr[j] = (bf16)0.f; pk[j] = (bf16)0.f; pv[j] = (bf16)0.f; }
        }
        { const bf16x4 e4 = *(const bf16x4*)(E + t * 512 + c0); ee = mk_f4((float)e4[0], (float)e4[1], (float)e4[2], (float)e4[3]); }
        ic = *(const bf16x4*)(ICLR + t * 512 + c0);
      };
      auto prep = [&](int c) {
        ScanBuf& bf = sb[c & 1];
        const float ee_[4] = {ee.x, ee.y, ee.z, ee.w};
        float r[4], k[4], v[4], kx[4], icl[4];
        float n2 = 0.f;
#pragma unroll
        for (int j = 0; j < 4; ++j) {
          const float zrj = (float)zr[j], zkj = (float)zk[j], zvj = (float)zv[j];
          r[j] = zrj + mur_[j] * ((float)pr[j] - zrj);
          k[j] = zkj + muk_[j] * ((float)pk[j] - zkj);
          v[j] = zvj + muv_[j] * ((float)pv[j] - zvj);
          kx[j] = k[j] * kkw_[j];
          n2 += kx[j] * kx[j];
          icl[j] = sigmoid_f(a0_[j] + (float)ic[j]);
        }
        n2 = row16_allsum(n2);
        const float inv = 1.f / fmaxf(sqrtf(n2), 1e-12f);
        float av[4], bv[4], wv[4], k2[4];
        float rkp = 0.f;
#pragma unroll
        for (int j = 0; j < 4; ++j) {
          const float kkn = kx[j] * inv;
          k2[j] = k[j] * (1.f + (icl[j] - 1.f) * kaw_[j]);
          av[j] = -kkn;
          bv[j] = kkn * icl[j];
          wv[j] = __expf(-0.60653066f * sigmoid_f(w0_[j] + ee_[j]));
          rkp += r[j] * k2[j] * rkw_[j];
        }
        rkp = row16_allsum(rkp);
        *(f32x4*)&bf.A[pi][4 * kq] = mk_f4(av[0], av[1], av[2], av[3]);
        *(f32x4*)&bf.B[pi][4 * kq] = mk_f4(bv[0], bv[1], bv[2], bv[3]);
        *(f32x4*)&bf.W[pi][4 * kq] = mk_f4(wv[0], wv[1], wv[2], wv[3]);
        *(f32x4*)&bf.K2[pi][4 * kq] = mk_f4(k2[0], k2[1], k2[2], k2[3]);
        *(f32x4*)&bf.R[pi][4 * kq] = mk_f4(r[0], r[1], r[2], r[3]);
        if ((kq >> 2) == quarter) *(f32x4*)&bf.V[pi][(kq & 3) * 4] = mk_f4(v[0], v[1], v[2], v[3]);
        if (quarter == 0 && kq == 0) RK[((size_t)b * SEQ + c * 16 + pi) * 8 + h] = rkp;
      };
      load_raw(0);
      prep(0);
      load_raw(1);
      __syncthreads();
      for (int c = 0; c < 256; ++c) {
        if (c + 1 < 256) prep(c + 1);
        if (c + 2 < 256) load_raw(c + 2);
        __syncthreads();
      }
    } else {
      float s0 = 0.f, s1 = 0.f, s2 = 0.f, s3 = 0.f;
      __syncthreads();
      for (int c = 0; c < 256; ++c) {
        const ScanBuf& bf = sb[c & 1];
        float yv = 0.f;
#pragma unroll
        for (int i = 0; i < 16; ++i) {
          const f32x4 A4 = *(const f32x4*)&bf.A[i][4 * kg];
          const f32x4 B4 = *(const f32x4*)&bf.B[i][4 * kg];
          const f32x4 W4 = *(const f32x4*)&bf.W[i][4 * kg];
          const f32x4 K4 = *(const f32x4*)&bf.K2[i][4 * kg];
          const f32x4 R4 = *(const f32x4*)&bf.R[i][4 * kg];
          const float vv = bf.V[i][rloc];
          float pd = s0 * A4.x + s1 * A4.y + s2 * A4.z + s3 * A4.w;
          const float sa = row16_allsum(pd);
          s0 = s0 * W4.x + vv * K4.x + sa * B4.x;
          s1 = s1 * W4.y + vv * K4.y + sa * B4.y;
          s2 = s2 * W4.z + vv * K4.z + sa * B4.z;
          s3 = s3 * W4.w + vv * K4.w + sa * B4.w;
          float yp = s0 * R4.x + s1 * R4.y + s2 * R4.z + s3 * R4.w;
          const float y = row16_allsum(yp);
          yv = (kg == i) ? y : yv;
        }
        YRAW[((size_t)b * SEQ + c * 16 + kg) * 512 + h * 64 + quarter * 16 + rloc] = (bf16)yv;
        __syncthreads();
      }
    }
    __syncthreads();
  }
  __builtin_amdgcn_s_setprio(0);
}

struct AttnSmem { bf16 k[2][64][104]; bf16 v[2][64][68]; int tile; };
DEVI void phase3b(const ParamsG& p, unsigned char* smem) {
  AttnSmem& sm = *(AttnSmem*)smem;
  const bf16* Qd = (const bf16*)((const unsigned char*)gp(p.out) + OFF_Q);
  const bf16* Kd = (const bf16*)((const unsigned char*)gp(p.out) + OFF_K);
  const bf16* Vd = (const bf16*)((const unsigned char*)gp(p.out) + OFF_VT);
  bf16* O = (bf16*)(gp(p.ws) + OFF_O);
  unsigned* cnt = (unsigned*)(gp(p.ws) + OFF_CNT);
  const int tid = threadIdx.x, lane = tid & 63, w = tid >> 6;
  const int q = lane & 31, hh = lane >> 5;
  for (;;) {
    __syncthreads();
    if (tid == 0) sm.tile = (int)atomicAdd(cnt, 1u);
    __syncthreads();
    const int tile = sm.tile;
    if (tile >= 1024) break;
    const int qt = 15 - (tile >> 6), bh = tile & 63;
    const int s0 = qt * 256;
    const int nkt = 4 * qt + 4;
    const int my_nkt = 4 * qt + 1 + (w >> 1);
    bf16x8 qf[6];
    {
      const bf16* qp = Qd + ((size_t)bh * SEQ + s0 + w * 32 + q) * 96 + hh * 8;
#pragma unroll
      for (int ks = 0; ks < 6; ++ks) qf[ks] = *(const bf16x8*)(qp + ks * 16);
      const size_t trow = (size_t)(bh >> 3) * SEQ + s0 + w * 32 + q;
      const float* cp = (const float*)(gp(p.ws) + OFF_CS) + trow * 16 + hh * 8;
      const float* sp = (const float*)(gp(p.ws) + OFF_SN) + trow * 16 + hh * 8;
#pragma unroll
      for (int j = 0; j < 8; ++j) {
        const float c = cp[j], sv = sp[j];
        const float x1 = (float)qf[4][j], x2 = (float)qf[5][j];
        qf[4][j] = (bf16)(x1 * c - x2 * sv);
        qf[5][j] = (bf16)(x2 * c + x1 * sv);
      }
    }
    f32x16 ot[2];
#pragma unroll
    for (int vb = 0; vb < 2; ++vb)
#pragma unroll
      for (int r = 0; r < 16; ++r) ot[vb][r] = 0.f;
    float mref = 0.f, lsum = 0.f;
    u32x4 kr0, kr1, vr;
    kr1 = mk_u4(0u, 0u, 0u, 0u);
    auto gload = [&](int kt) {
      const bf16* kb = Kd + ((size_t)bh * SEQ + kt * 64) * 96;
      kr0 = *(const u32x4*)(kb + (size_t)tid * 8);
      if (tid < 256) kr1 = *(const u32x4*)(kb + (size_t)(tid + 512) * 8);
      const bf16* vb = Vd + ((size_t)bh * SEQ + kt * 64) * 64;
      vr = *(const u32x4*)(vb + (size_t)tid * 8);
    };
    auto lwrite = [&](int buf) {
      const int row = tid / 12, cc = tid % 12;
      *(u32x4*)&sm.k[buf][row][cc * 8] = kr0;
      if (tid < 256) { const int id = tid + 512; *(u32x4*)&sm.k[buf][id / 12][(id % 12) * 8] = kr1; }
      const int key = tid >> 3, vd0 = (tid & 7) * 8;
      unsigned short* vs = (unsigned short*)&sm.v[buf][0][0];
#pragma unroll
      for (int j = 0; j < 4; ++j) {
        vs[(vd0 + 2 * j) * 68 + key] = (unsigned short)(vr[j] & 0xffffu);
        vs[(vd0 + 2 * j + 1) * 68 + key] = (unsigned short)(vr[j] >> 16);
      }
    };
    gload(0);
    lwrite(0);
    if (nkt > 1) gload(1);
    __syncthreads();
    for (int kt = 0; kt < nkt; ++kt) {
      const int cb_ = kt & 1;
      if (kt + 1 < nkt) lwrite(cb_ ^ 1);
      if (kt + 2 < nkt) gload(kt + 2);
      if (kt < my_nkt) {
        f32x16 st[2];
        const float nmref = -mref;
#pragma unroll
        for (int kb2 = 0; kb2 < 2; ++kb2) {
#pragma unroll
          for (int r = 0; r < 16; ++r) st[kb2][r] = nmref;
#pragma unroll
          for (int ks = 0; ks < 6; ++ks) {
            const bf16x8 a = *(const bf16x8*)&sm.k[cb_][kb2 * 32 + q][ks * 16 + hh * 8];
            st[kb2] = __builtin_amdgcn_mfma_f32_32x32x16_bf16(a, qf[ks], st[kb2], 0, 0, 0);
          }
        }
        float mx = st[0][0];
#pragma unroll
        for (int kb2 = 0; kb2 < 2; ++kb2)
#pragma unroll
          for (int r = 0; r < 16; ++r) mx = fmaxf(mx, st[kb2][r]);
        mx = fmaxf(mx, __shfl_xor(mx, 32, 64));
        if (kt == 0) {
          mref = mx;
#pragma unroll
          for (int kb2 = 0; kb2 < 2; ++kb2)
#pragma unroll
            for (int r = 0; r < 16; ++r) st[kb2][r] -= mx;
        } else if (__builtin_amdgcn_ballot_w64(mx > 8.f) != 0ull) {
          const float delta = fmaxf(mx, 0.f);
          const float alpha = __builtin_amdgcn_exp2f(-delta);
          mref += delta;
          lsum *= alpha;
#pragma unroll
          for (int kb2 = 0; kb2 < 2; ++kb2)
#pragma unroll
            for (int r = 0; r < 16; ++r) st[kb2][r] -= delta;
#pragma unroll
          for (int vb = 0; vb < 2; ++vb)
#pragma unroll
            for (int r = 0; r < 16; ++r) ot[vb][r] *= alpha;
        }
        float ps = 0.f;
#pragma unroll
        for (int kb2 = 0; kb2 < 2; ++kb2)
#pragma unroll
          for (int r = 0; r < 16; ++r) {
            const float pv = __builtin_amdgcn_exp2f(st[kb2][r]);
            st[kb2][r] = pv;
            ps += pv;
          }
        lsum += ps;
#pragma unroll
        for (int kb2 = 0; kb2 < 2; ++kb2)
#pragma unroll
          for (int s2 = 0; s2 < 2; ++s2) {
            bf16x8 pf;
#pragma unroll
            for (int j = 0; j < 8; ++j) pf[j] = (bf16)st[kb2][8 * s2 + j];
#pragma unroll
            for (int vb = 0; vb < 2; ++vb) {
              const bf16x4 lo = *(const bf16x4*)&sm.v[cb_][vb * 32 + q][kb2 * 32 + 16 * s2 + 4 * hh];
              const bf16x4 hi = *(const bf16x4*)&sm.v[cb_][vb * 32 + q][kb2 * 32 + 16 * s2 + 8 + 4 * hh];
              bf16x8 a;
              a[0] = lo[0]; a[1] = lo[1]; a[2] = lo[2]; a[3] = lo[3];
              a[4] = hi[0]; a[5] = hi[1]; a[6] = hi[2]; a[7] = hi[3];
              ot[vb] = __builtin_amdgcn_mfma_f32_32x32x16_bf16(a, pf, ot[vb], 0, 0, 0);
            }
          }
      }
      __syncthreads();
    }
    const float ltot = lsum + __shfl_xor(lsum, 32, 64);
    const float inv = 1.f / ltot;
    const int b = bh >> 3, h = bh & 7;
    bf16* op = O + ((size_t)b * SEQ + s0 + w * 32 + q) * 512 + h * 64;
#pragma unroll
    for (int vb = 0; vb < 2; ++vb)
#pragma unroll
      for (int rg = 0; rg < 4; ++rg) {
        bf16x4 o;
        o[0] = (bf16)(ot[vb][4 * rg + 0] * inv); o[1] = (bf16)(ot[vb][4 * rg + 1] * inv);
        o[2] = (bf16)(ot[vb][4 * rg + 2] * inv); o[3] = (bf16)(ot[vb][4 * rg + 3] * inv);
        *(bf16x4*)(op + vb * 32 + 8 * rg + 4 * hh) = o;
      }
  }
}

constexpr int CS_LD = 72;
constexpr int CS_SLOT = 64 * CS_LD * 2;
constexpr size_t CS_ITEM = 64 * 64;
constexpr size_t OFF_CS_PH = 0;
constexpr size_t OFF_CS_PL = 32 * MiB;
constexpr size_t OFF_CS_QA = 64 * MiB;
constexpr size_t OFF_CS_SL = 96 * MiB;
constexpr size_t OFF_CS_YL1 = 358 * MiB;
constexpr size_t OFF_CS_YL2 = 316 * MiB;
DEVI size_t cs_yl_off(int item) { return (item < 3072) ? OFF_CS_YL1 + (size_t)item * CS_ITEM * 2 : OFF_CS_YL2 + (size_t)(item - 3072) * CS_ITEM * 2; }

DEVI f32x4 mfma16(bf16x8 a, bf16x8 b, f32x4 c) { return __builtin_amdgcn_mfma_f32_16x16x32_bf16(a, b, c, 0, 0, 0); }
DEVI f32x4 cs_block(const bf16* X, const bf16* Y, int rb, int cb, int lane, f32x4 acc) {
  const int r = lane & 15, g = lane >> 4;
#pragma unroll
  for (int ks = 0; ks < 2; ++ks) {
    const bf16x8 a = *(const bf16x8*)(X + (rb * 16 + r) * CS_LD + ks * 32 + g * 8);
    const bf16x8 b = *(const bf16x8*)(Y + (cb * 16 + r) * CS_LD + ks * 32 + g * 8);
    acc = mfma16(a, b, acc);
  }
  return acc;
}
DEVI void cs_store_rowmajor(bf16* D, int rb, int cb, int lane, f32x4 v) {
  const int row0 = rb * 16 + 4 * (lane >> 4), col = cb * 16 + (lane & 15);
  D[(row0 + 0) * CS_LD + col] = (bf16)v.x; D[(row0 + 1) * CS_LD + col] = (bf16)v.y;
  D[(row0 + 2) * CS_LD + col] = (bf16)v.z; D[(row0 + 3) * CS_LD + col] = (bf16)v.w;
}
DEVI void cs_store_transposed(bf16* DT, int rb, int cb, int lane, f32x4 v) {
  const int row0 = rb * 16 + 4 * (lane >> 4), col = cb * 16 + (lane & 15);
  *(bf16x4*)(DT + col * CS_LD + row0) = to_bf4(v);
}

DEVI void phase3A(const ParamsG& p, unsigned char* smem) {
  const bf16* zrw = (const bf16*)(gp(p.ws) + OFF_ZRW);
  const bf16* E = (const bf16*)(gp(p.ws) + OFF_E);
  const bf16* ICLR = (const bf16*)(gp(p.ws) + OFF_ICLR);
  float* RK = (float*)(gp(p.ws) + OFF_RK);
  bf16* gPH = (bf16*)((unsigned char*)gp(p.out) + OFF_CS_PH);
  bf16* gPL = (bf16*)((unsigned char*)gp(p.out) + OFF_CS_PL);
  bf16* gQA = (bf16*)((unsigned char*)gp(p.out) + OFF_CS_QA);
  bf16* gSL = (bf16*)((unsigned char*)gp(p.out) + OFF_CS_SL);
  bf16* SLOT[14];
#pragma unroll
  for (int i = 0; i < 14; ++i) SLOT[i] = (bf16*)(smem + i * CS_SLOT);
  float* GL = (float*)smem;
  bf16* RAWA = SLOT[2]; bf16* RAWB = SLOT[3]; bf16* RAWK = SLOT[4]; bf16* RAWV = SLOT[5];
  bf16* At = SLOT[6]; bf16* Rt = SLOT[7]; bf16* Bt = SLOT[8]; bf16* Kt = SLOT[9];
  bf16* AT = SLOT[10]; bf16* BH = SLOT[11]; bf16* KH = SLOT[12]; bf16* VT = SLOT[13];
  float* BTOT = (float*)(smem + 14 * CS_SLOT);
  float* G63 = BTOT + 8 * 64;
  bf16* Lm = SLOT[0]; bf16* LmT = SLOT[1]; bf16* Lak = SLOT[2]; bf16* Mrb = SLOT[3]; bf16* Mrk = SLOT[4];
  const int tid = threadIdx.x, lane = tid & 63, w = tid >> 6;
  const int rb = w >> 1, cb0 = 2 * (w & 1);
  bf16x8 zr, zk, zv, pr, pk, pv, ic, e8;
  auto fetch = [&](int item) {
    const int bh = item >> 6, ch = item & 63, b = bh >> 3, h = bh & 7;
    const int tt = tid >> 3, kc = (tid & 7) * 8;
    const int s = ch * 64 + tt;
    const size_t t = (size_t)b * SEQ + s;
    const int c0 = h * 64 + kc;
    const bf16* zp = zrw + t * RWC + c0;
    zr = *(const bf16x8*)zp; zk = *(const bf16x8*)(zp + 512); zv = *(const bf16x8*)(zp + 1024);
    if (s > 0) { pr = *(const bf16x8*)(zp - RWC); pk = *(const bf16x8*)(zp - RWC + 512); pv = *(const bf16x8*)(zp - RWC + 1024); }
    else {
#pragma unroll
      for (int j = 0; j < 8; ++j) { pr[j] = (bf16)0.f; pk[j] = (bf16)0.f; pv[j] = (bf16)0.f; }
    }
    e8 = *(const bf16x8*)(E + t * 512 + c0);
    ic = *(const bf16x8*)(ICLR + t * 512 + c0);
  };
  if ((int)blockIdx.x < 4096) fetch(blockIdx.x);
  for (int item = blockIdx.x; item < 4096; item += gridDim.x) {
    const int bh = item >> 6, ch = item & 63, b = bh >> 3, h = bh & 7;
    const int tbase = ch * 64;
    float a_[8], b_[8], k2_[8], r_[8];
    {
      const int tt = tid >> 3, kc = (tid & 7) * 8;
      const int s = tbase + tt;
      const size_t t = (size_t)b * SEQ + s;
      const int c0 = h * 64 + kc;
      const float ee[8] = {(float)e8[0], (float)e8[1], (float)e8[2], (float)e8[3], (float)e8[4], (float)e8[5], (float)e8[6], (float)e8[7]};
      float k_[8], v_[8], kx[8], icl[8], lw[8];
      float n2 = 0.f;
#pragma unroll
      for (int j = 0; j < 8; ++j) {
        const float zrj = (float)zr[j], zkj = (float)zk[j], zvj = (float)zv[j];
        r_[j] = zrj + gp(p.rw_mu)[c0 + j] * ((float)pr[j] - zrj);
        k_[j] = zkj + gp(p.rw_mu)[512 + c0 + j] * ((float)pk[j] - zkj);
        v_[j] = zvj + gp(p.rw_mu)[1024 + c0 + j] * ((float)pv[j] - zvj);
        kx[j] = k_[j] * gp(p.rw_k_k)[c0 + j];
        n2 += kx[j] * kx[j];
        icl[j] = sigmoid_f(gp(p.rw_a0)[c0 + j] + (float)ic[j]);
        lw[j] = -0.60653066f * sigmoid_f(gp(p.rw_w0)[c0 + j] + ee[j]);
      }
      n2 = row8_allsum(n2);
      const float inv = 1.f / fmaxf(sqrtf(n2), 1e-12f);
      float rkp = 0.f;
#pragma unroll
      for (int j = 0; j < 8; ++j) {
        const float kkn = kx[j] * inv;
        k2_[j] = k_[j] * (1.f + (icl[j] - 1.f) * gp(p.rw_k_a)[c0 + j]);
        a_[j] = -kkn;
        b_[j] = kkn * icl[j];
        rkp += r_[j] * k2_[j] * gp(p.rw_r_k)[c0 + j];
      }
      rkp = row8_allsum(rkp);
      if ((tid & 7) == 0) RK[t * 8 + h] = rkp;
      *(f32x4*)&GL[tt * 64 + kc] = mk_f4(lw[0], lw[1], lw[2], lw[3]);
      *(f32x4*)&GL[tt * 64 + kc + 4] = mk_f4(lw[4], lw[5], lw[6], lw[7]);
      bf16x8 oa, ob, ok, ov;
#pragma unroll
      for (int j = 0; j < 8; ++j) { oa[j] = (bf16)a_[j]; ob[j] = (bf16)b_[j]; ok[j] = (bf16)k2_[j]; ov[j] = (bf16)v_[j]; }
      *(bf16x8*)(RAWA + tt * CS_LD + kc) = oa; *(bf16x8*)(RAWB + tt * CS_LD + kc) = ob;
      *(bf16x8*)(RAWK + tt * CS_LD + kc) = ok; *(bf16x8*)(RAWV + tt * CS_LD + kc) = ov;
    }
    if (item + (int)gridDim.x < 4096) fetch(item + gridDim.x);
    __syncthreads();
    {
      const int kch = tid & 63, tb = tid >> 6;
      float run = 0.f;
#pragma unroll
      for (int i = 0; i < 8; ++i) { run += GL[(tb * 8 + i) * 64 + kch]; GL[(tb * 8 + i) * 64 + kch] = run; }
      BTOT[tb * 64 + kch] = run;
    }
    __syncthreads();
    {
      const int kch = tid & 63, tb = tid >> 6;
      float off = 0.f;
      for (int i = 0; i < tb; ++i) off += BTOT[i * 64 + kch];
#pragma unroll
      for (int i = 0; i < 8; ++i) GL[(tb * 8 + i) * 64 + kch] += off;
    }
    __syncthreads();
    {
      const int tt = tid >> 3, kc = (tid & 7) * 8;
      bf16x8 oA, oR, oB, oK;
#pragma unroll
      for (int j = 0; j < 8; ++j) {
        const float g = GL[tt * 64 + kc + j];
        const float gm = (tt > 0) ? GL[(tt - 1) * 64 + kc + j] : 0.f;
        const float ig = __expf(-g);
        oA[j] = (bf16)(a_[j] * __expf(gm));
        oR[j] = (bf16)(r_[j] * __expf(g));
        oB[j] = (bf16)(b_[j] * ig);
        oK[j] = (bf16)(k2_[j] * ig);
      }
      *(bf16x8*)(At + tt * CS_LD + kc) = oA; *(bf16x8*)(Rt + tt * CS_LD + kc) = oR;
      *(bf16x8*)(Bt + tt * CS_LD + kc) = oB; *(bf16x8*)(Kt + tt * CS_LD + kc) = oK;
    }
    {
      const int kch = tid & 63, tb = tid >> 6;
      const float g63 = GL[63 * 64 + kch];
      bf16x8 oAT, oBH, oKH, oVT;
#pragma unroll
      for (int i = 0; i < 8; ++i) {
        const int t = tb * 8 + i;
        const float g = GL[t * 64 + kch];
        const float gm = (t > 0) ? GL[(t - 1) * 64 + kch] : 0.f;
        const float sc = __expf(g63 - g);
        oAT[i] = (bf16)((float)RAWA[t * CS_LD + kch] * __expf(gm));
        oBH[i] = (bf16)((float)RAWB[t * CS_LD + kch] * sc);
        oKH[i] = (bf16)((float)RAWK[t * CS_LD + kch] * sc);
        oVT[i] = RAWV[t * CS_LD + kch];
      }
      *(bf16x8*)(AT + kch * CS_LD + tb * 8) = oAT; *(bf16x8*)(BH + kch * CS_LD + tb * 8) = oBH;
      *(bf16x8*)(KH + kch * CS_LD + tb * 8) = oKH; *(bf16x8*)(VT + kch * CS_LD + tb * 8) = oVT;
      if (tb == 0) G63[kch] = __expf(g63);
    }
    __syncthreads();
    f32x4 tacc[2];
#pragma unroll
    for (int q = 0; q < 2; ++q) {
      const int cb = cb0 + q;
      const f32x4 z4 = mk_f4(0.f, 0.f, 0.f, 0.f);
      f32x4 dab = cs_block(At, Bt, rb, cb, lane, z4);
      f32x4 dak = cs_block(At, Kt, rb, cb, lane, z4);
      f32x4 drb = cs_block(Rt, Bt, rb, cb, lane, z4);
      f32x4 drk = cs_block(Rt, Kt, rb, cb, lane, z4);
      const int row0 = rb * 16 + 4 * (lane >> 4), col = cb * 16 + (lane & 15);
#pragma unroll
      for (int i = 0; i < 4; ++i) {
        const int row = row0 + i;
        if (col >= row) { dab[i] = 0.f; dak[i] = 0.f; }
        if (col > row) { drb[i] = 0.f; drk[i] = 0.f; }
      }
      tacc[q] = dab;
#pragma unroll
      for (int i = 0; i < 4; ++i) if (col == row0 + i) tacc[q][i] += 1.f;
      asm volatile("" ::: "memory");
      cs_store_rowmajor(Lm, rb, cb, lane, dab);
      cs_store_transposed(LmT, rb, cb, lane, dab);
      cs_store_rowmajor(Lak, rb, cb, lane, dak);
      cs_store_rowmajor(Mrb, rb, cb, lane, drb);
      cs_store_rowmajor(Mrk, rb, cb, lane, drk);
      cs_store_transposed(SLOT[5], rb, cb, lane, tacc[q]);
    }
    __syncthreads();
    {
      bf16* Pc = Lm; bf16* PcT = LmT; bf16* Pn = At; bf16* PnT = Bt;
      bf16* TTc = SLOT[5]; bf16* TTn = Kt;
#pragma unroll 1
      for (int it = 0; it < 5; ++it) {
        f32x4 pp[2];
#pragma unroll
        for (int q = 0; q < 2; ++q) pp[q] = cs_block(Pc, PcT, rb, cb0 + q, lane, mk_f4(0.f, 0.f, 0.f, 0.f));
#pragma unroll
        for (int q = 0; q < 2; ++q) { cs_store_rowmajor(Pn, rb, cb0 + q, lane, pp[q]); cs_store_transposed(PnT, rb, cb0 + q, lane, pp[q]); }
        __syncthreads();
#pragma unroll
        for (int q = 0; q < 2; ++q) tacc[q] = cs_block(Pn, TTc, rb, cb0 + q, lane, tacc[q]);
#pragma unroll
        for (int q = 0; q < 2; ++q) cs_store_transposed(TTn, rb, cb0 + q, lane, tacc[q]);
        __syncthreads();
        bf16* t1 = Pc; Pc = Pn; Pn = t1; t1 = PcT; PcT = PnT; PnT = t1; t1 = TTc; TTc = TTn; TTn = t1;
      }
    }
    bf16* Tm = SLOT[0]; bf16* WT = SLOT[1]; bf16* TAT = SLOT[5]; bf16* ULT = SLOT[6];
#pragma unroll
    for (int q = 0; q < 2; ++q) cs_store_rowmajor(Tm, rb, cb0 + q, lane, tacc[q]);
#pragma unroll
    for (int q = 0; q < 2; ++q) cs_store_transposed(WT, rb, cb0 + q, lane, cs_block(Lak, VT, rb, cb0 + q, lane, mk_f4(0.f, 0.f, 0.f, 0.f)));
    __syncthreads();
#pragma unroll
    for (int q = 0; q < 2; ++q) {
      cs_store_transposed(TAT, rb, cb0 + q, lane, cs_block(Tm, AT, rb, cb0 + q, lane, mk_f4(0.f, 0.f, 0.f, 0.f)));
      cs_store_transposed(ULT, rb, cb0 + q, lane, cs_block(Tm, WT, rb, cb0 + q, lane, mk_f4(0.f, 0.f, 0.f, 0.f)));
    }
    __syncthreads();
    {
      bf16* oQA = SLOT[2]; bf16* oYL = SLOT[8]; bf16* oPH = SLOT[9];
      f32x4 pm_[2], sl_[2];
#pragma unroll
      for (int q = 0; q < 2; ++q) {
        const int cb = cb0 + q;
        const int row0 = rb * 16 + 4 * (lane >> 4), col = cb * 16 + (lane & 15);
        f32x4 qa;
#pragma unroll
        for (int i = 0; i < 4; ++i) qa[i] = (float)Rt[(row0 + i) * CS_LD + col];
        qa = cs_block(Mrb, TAT, rb, cb, lane, qa);
        f32x4 yl = cs_block(Mrb, ULT, rb, cb, lane, mk_f4(0.f, 0.f, 0.f, 0.f));
        yl = cs_block(Mrk, VT, rb, cb, lane, yl);
        f32x4 pm = cs_block(BH, TAT, rb, cb, lane, mk_f4(0.f, 0.f, 0.f, 0.f));
#pragma unroll
        for (int i = 0; i < 4; ++i) if (col == row0 + i) pm[i] += G63[col];
        f32x4 sl = cs_block(BH, ULT, rb, cb, lane, mk_f4(0.f, 0.f, 0.f, 0.f));
        sl = cs_block(KH, VT, rb, cb, lane, sl);
        cs_store_rowmajor(oQA, rb, cb, lane, qa);
        cs_store_rowmajor(oYL, rb, cb, lane, yl);
        cs_store_rowmajor(oPH, rb, cb, lane, pm);
        pm_[q] = pm; sl_[q] = sl;
      }
      __syncthreads();
      bf16* oPL = SLOT[0]; bf16* oSL = SLOT[1];
#pragma unroll
      for (int q = 0; q < 2; ++q) {
        const int cb = cb0 + q;
        const int row0 = rb * 16 + 4 * (lane >> 4), col = cb * 16 + (lane & 15);
        f32x4 lo;
#pragma unroll
        for (int i = 0; i < 4; ++i) lo[i] = pm_[q][i] - (float)oPH[(row0 + i) * CS_LD + col];
        cs_store_rowmajor(oPL, rb, cb, lane, lo);
        cs_store_rowmajor(oSL, rb, cb, lane, sl_[q]);
      }
      __syncthreads();
      const size_t ib = (size_t)item * CS_ITEM + (size_t)tid * 8;
      const int row = tid >> 3, cc = (tid & 7) * 8;
      *(u32x4*)(gQA + ib) = *(const u32x4*)(oQA + row * CS_LD + cc);
      *(u32x4*)((bf16*)(gp(p.ws) + cs_yl_off(item)) + (size_t)tid * 8) = *(const u32x4*)(oYL + row * CS_LD + cc);
      *(u32x4*)(gPH + ib) = *(const u32x4*)(oPH + row * CS_LD + cc);
      *(u32x4*)(gPL + ib) = *(const u32x4*)(oPL + row * CS_LD + cc);
      *(u32x4*)(gSL + ib) = *(const u32x4*)(oSL + row * CS_LD + cc);
    }
    __syncthreads();
  }
}

struct CsStage { bf16 ph[64 * CS_LD]; bf16 pl[64 * CS_LD]; bf16 qa[64 * CS_LD]; bf16 sl[64 * 16]; bf16 yl[64 * 16]; bf16 zh[16 * CS_LD]; bf16 zl[16 * CS_LD]; };
DEVI void phase3B(const ParamsG& p, unsigned char* smem) {
  const bf16* gPH = (const bf16*)((const unsigned char*)gp(p.out) + OFF_CS_PH);
  const bf16* gPL = (const bf16*)((const unsigned char*)gp(p.out) + OFF_CS_PL);
  const bf16* gQA = (const bf16*)((const unsigned char*)gp(p.out) + OFF_CS_QA);
  const bf16* gSL = (const bf16*)((const unsigned char*)gp(p.out) + OFF_CS_SL);
  bf16* YRAW = (bf16*)(gp(p.ws) + OFF_YRAW);
  CsStage* st = (CsStage*)smem;
  const int tid = threadIdx.x, lane = tid & 63, w = tid >> 6;
  const int r = lane & 15, g = lane >> 4;
  for (int item = blockIdx.x; item < 256; item += gridDim.x) {
    const int bh = item >> 2, vb = item & 3, b = bh >> 3, h = bh & 7;
    u32x4 rPH[2], rPL[2], rQA[2]; unsigned rSL[2], rYL[2];
    auto gload = [&](int ch, int sl) {
      const int it2 = bh * 64 + ch;
      const size_t ib = (size_t)it2 * CS_ITEM;
      rPH[sl] = *(const u32x4*)(gPH + ib + (size_t)tid * 8);
      rPL[sl] = *(const u32x4*)(gPL + ib + (size_t)tid * 8);
      rQA[sl] = *(const u32x4*)(gQA + ib + (size_t)tid * 8);
      const size_t o = (size_t)(tid >> 3) * 64 + vb * 16 + (tid & 7) * 2;
      rSL[sl] = *(const unsigned*)(gSL + ib + o);
      rYL[sl] = *(const unsigned*)((const bf16*)(gp(p.ws) + cs_yl_off(it2)) + o);
    };
    auto stage_write = [&](int ch, int sl) {
      CsStage& s2 = st[ch & 1];
      const int row = tid >> 3, cc = (tid & 7) * 8;
      *(u32x4*)(s2.ph + row * CS_LD + cc) = rPH[sl];
      *(u32x4*)(s2.pl + row * CS_LD + cc) = rPL[sl];
      *(u32x4*)(s2.qa + row * CS_LD + cc) = rQA[sl];
      *(unsigned*)(s2.sl + row * 16 + (tid & 7) * 2) = rSL[sl];
      *(unsigned*)(s2.yl + row * 16 + (tid & 7) * 2) = rYL[sl];
    };
    gload(0, 0);
    gload(1, 1);
    __syncthreads();
    for (int i = tid; i < 16 * CS_LD; i += NTHREADS) { st[0].zh[i] = (bf16)0.f; st[0].zl[i] = (bf16)0.f; }
    stage_write(0, 0);
    gload(2, 0);
    __syncthreads();
#pragma unroll 2
    for (int ch = 0; ch < 64; ++ch) {
      if (ch + 1 < 64) stage_write(ch + 1, (ch + 1) & 1);
      if (ch + 3 < 64) gload(ch + 3, (ch + 1) & 1);
      const CsStage& c = st[ch & 1];
      CsStage& n = st[(ch + 1) & 1];
      if (w < 4) {
        f32x4 acc;
#pragma unroll
        for (int i = 0; i < 4; ++i) acc[i] = (float)c.sl[(w * 16 + 4 * g + i) * 16 + r];
#pragma unroll
        for (int ks = 0; ks < 2; ++ks) {
          const bf16x8 ah = *(const bf16x8*)(c.ph + (w * 16 + r) * CS_LD + ks * 32 + g * 8);
          const bf16x8 al = *(const bf16x8*)(c.pl + (w * 16 + r) * CS_LD + ks * 32 + g * 8);
          const bf16x8 bh8 = *(const bf16x8*)(c.zh + r * CS_LD + ks * 32 + g * 8);
          const bf16x8 bl8 = *(const bf16x8*)(c.zl + r * CS_LD + ks * 32 + g * 8);
          acc = mfma16(ah, bh8, acc);
          acc = mfma16(ah, bl8, acc);
          acc = mfma16(al, bh8, acc);
        }
        const bf16x4 hi4 = to_bf4(acc);
        f32x4 res;
#pragma unroll
        for (int i = 0; i < 4; ++i) res[i] = acc[i] - (float)hi4[i];
        *(bf16x4*)(n.zh + r * CS_LD + w * 16 + 4 * g) = hi4;
        *(bf16x4*)(n.zl + r * CS_LD + w * 16 + 4 * g) = to_bf4(res);
      } else {
        const int tb = w - 4;
        f32x4 acc;
#pragma unroll
        for (int i = 0; i < 4; ++i) acc[i] = (float)c.yl[(tb * 16 + 4 * g + i) * 16 + r];
#pragma unroll
        for (int ks = 0; ks < 2; ++ks) {
          const bf16x8 a = *(const bf16x8*)(c.qa + (tb * 16 + r) * CS_LD + ks * 32 + g * 8);
          const bf16x8 bh8 = *(const bf16x8*)(c.zh + r * CS_LD + ks * 32 + g * 8);
          const bf16x8 bl8 = *(const bf16x8*)(c.zl + r * CS_LD + ks * 32 + g * 8);
          acc = mfma16(a, bh8, acc);
          acc = mfma16(a, bl8, acc);
        }
#pragma unroll
        for (int i = 0; i < 4; ++i) {
          const size_t t = (size_t)b * SEQ + ch * 64 + tb * 16 + 4 * g + i;
          YRAW[t * 512 + h * 64 + vb * 16 + r] = (bf16)acc[i];
        }
      }
      __syncthreads();
    }
  }
}

DEVI void phase3c(const ParamsG& p) {
  const int lane = threadIdx.x & 63;
  const int gw = blockIdx.x * NWAVES + (threadIdx.x >> 6), nw = gridDim.x * NWAVES;
  const bf16* zrw = (const bf16*)(gp(p.ws) + OFF_ZRW);
  const bf16* YRAW = (const bf16*)(gp(p.ws) + OFF_YRAW);
  const bf16* G = (const bf16*)(gp(p.ws) + OFF_G);
  const float* RK = (const float*)(gp(p.ws) + OFF_RK);
  bf16* YA = (bf16*)(gp(p.ws) + OFF_YAPRE);
  const int c0 = lane * 8, head = lane >> 3;
  float gw_[8], gb_[8], mu_[8];
#pragma unroll
  for (int j = 0; j < 8; ++j) { gw_[j] = gp(p.rw_gn_w)[c0 + j]; gb_[j] = gp(p.rw_gn_b)[c0 + j]; mu_[j] = gp(p.rw_mu)[1024 + c0 + j]; }
  for (int t = gw; t < T_TOK; t += nw) {
    const int s = t & (SEQ - 1);
    const bf16x8 y8 = *(const bf16x8*)(YRAW + (size_t)t * 512 + c0);
    float y[8];
    float sm = 0.f;
#pragma unroll
    for (int j = 0; j < 8; ++j) { y[j] = (float)y8[j]; sm += y[j]; }
    const float mean = row8_allsum(sm) * (1.f / 64.f);
    float sq = 0.f;
#pragma unroll
    for (int j = 0; j < 8; ++j) { y[j] -= mean; sq += y[j] * y[j]; }
    const float var = row8_allsum(sq) * (1.f / 64.f);
    const float rstd = rsqrtf(var + 64e-5f);
    const bf16* vp = zrw + (size_t)t * RWC + 1024 + c0;
    const bf16x8 vc = *(const bf16x8*)vp;
    bf16x8 vq;
    if (s > 0) vq = *(const bf16x8*)(vp - RWC);
    else {
#pragma unroll
      for (int j = 0; j < 8; ++j) vq[j] = (bf16)0.f;
    }
    const bf16x8 g8 = *(const bf16x8*)(G + (size_t)t * 512 + c0);
    const float rk = RK[(size_t)t * 8 + head];
    bf16x8 o;
#pragma unroll
    for (int j = 0; j < 8; ++j) {
      const float vcur = (float)vc[j];
      const float vs = vcur + mu_[j] * ((float)vq[j] - vcur);
      const float yn = y[j] * rstd * gw_[j] + gb_[j];
      o[j] = (bf16)((yn + rk * vs) * (float)g8[j]);
    }
    *(bf16x8*)(YA + (size_t)t * 512 + c0) = o;
  }
}

template <int MODE> struct EpiMix {
  static constexpr bool PERM = true, AFTER_DRAIN = false;
  bf16* D; const bf16* S;
  DEVI void operator()(PgAcc acc, const pg8::Unit& u, int wr, int wc, int fr, int fq) const {
    if constexpr (MODE == 1) {
      bf16x4 ly[2][4];
      PG_EPI_PIPELINED(
        ly[slot][c] = *(const bf16x4*)(D + off); ,
        const bf16x4 y = ly[slot][c];
        f32x4 o; o.x = (float)y[0] * sigmoid_f(v.x); o.y = (float)y[1] * sigmoid_f(v.y); o.z = (float)y[2] * sigmoid_f(v.z); o.w = (float)y[3] * sigmoid_f(v.w);
        *(bf16x4*)(D + off) = to_bf4(o);
      )
      return;
    }
    if constexpr (MODE == 3) {
      bf16x4 ly[2][4]; bf16x4 ls[2][4];
      PG_EPI_PIPELINED(
        ly[slot][c] = *(const bf16x4*)(D + off); ls[slot][c] = *(const bf16x4*)(S + off); ,
        const bf16x4 y = ly[slot][c]; const bf16x4 y2 = ls[slot][c];
        f32x4 o; o.x = (float)y[0] + (float)y2[0] * sigmoid_f(v.x); o.y = (float)y[1] + (float)y2[1] * sigmoid_f(v.y);
        o.z = (float)y[2] + (float)y2[2] * sigmoid_f(v.z); o.w = (float)y[3] + (float)y2[3] * sigmoid_f(v.w);
        *(bf16x4*)(D + off) = to_bf4(o);
      )
      return;
    }
    PG_EPI_ROWS(PG_EPI_COLS(
      bf16* q = D + (unsigned)(row * DM + col);
      if (MODE == 0) *(bf16x4*)q = to_bf4(v);
      else if (MODE == 1) {
        const bf16x4 y = *(const bf16x4*)q;
        f32x4 o; o.x = (float)y[0] * sigmoid_f(v.x); o.y = (float)y[1] * sigmoid_f(v.y); o.z = (float)y[2] * sigmoid_f(v.z); o.w = (float)y[3] * sigmoid_f(v.w);
        *(bf16x4*)q = to_bf4(o);
      } else {
        const bf16x4 y = *(const bf16x4*)q; const bf16x4 y2 = *(const bf16x4*)(S + (unsigned)(row * DM + col));
        f32x4 o; o.x = (float)y[0] + (float)y2[0] * sigmoid_f(v.x); o.y = (float)y[1] + (float)y2[1] * sigmoid_f(v.y);
        o.z = (float)y[2] + (float)y2[2] * sigmoid_f(v.z); o.w = (float)y[3] + (float)y2[3] * sigmoid_f(v.w);
        *(bf16x4*)q = to_bf4(o);
      }
    ))
  }
};
DEVI void phase4(const ParamsG& p, unsigned char* smem) {
  unsigned char* ws = gp(p.ws);
  const bf16* H1 = (const bf16*)(ws + OFF_H1);
  const bf16* WG = (const bf16*)(ws + OFF_WG_T);
  bf16* M = (bf16*)(ws + OFF_M);
  bf16* M2 = (bf16*)(ws + OFF_M2);
  { EpiMix<0> e; e.D = M; e.S = nullptr; run_gemm(smem, (const bf16*)(ws + OFF_YAPRE), (const bf16*)(ws + OFF_RWO_T), T_TOK, DM, 512, e); }
  { EpiMix<1> e; e.D = M; e.S = nullptr; run_gemm(smem, H1, WG, T_TOK, DM, DM, e); }
  { EpiMix<0> e; e.D = M2; e.S = nullptr; run_gemm(smem, (const bf16*)(ws + OFF_O), (const bf16*)(ws + OFF_MLO_T), T_TOK, DM, 512, e); }
  { EpiMix<3> e; e.D = M; e.S = M2; run_gemm(smem, H1, WG + (size_t)1024 * DM, T_TOK, DM, DM, e); }
}

struct EpiX1 {
  static constexpr bool PERM = true, AFTER_DRAIN = false;
  const float* x; bf16* xb;
  DEVI void operator()(PgAcc acc, const pg8::Unit& u, int wr, int wc, int fr, int fq) const {
    f32x4 lx[2][4];
    PG_EPI_PIPELINED(
      lx[slot][c] = *(const f32x4*)(x + off); ,
      const f32x4 s4 = lx[slot][c] + v;
      bf16x4 o; o[0] = (bf16)s4.x; o[1] = (bf16)s4.y; o[2] = (bf16)s4.z; o[3] = (bf16)s4.w;
      *(bf16x4*)(xb + off) = o;
    )
  }
};
DEVI void phase5(const ParamsG& p, unsigned char* smem) {
  EpiX1 e; e.x = gp(p.x); e.xb = (bf16*)(gp(p.ws) + OFF_XB);
  run_gemm(smem, (const bf16*)(gp(p.ws) + OFF_M), (const bf16*)(gp(p.ws) + OFF_WOUT_T), T_TOK, DM, DM, e);
}

DEVI unsigned pack_key(float s, int n) {
  unsigned u = __float_as_uint(s);
  u = (u & 0x80000000u) ? ~u : (u | 0x80000000u);
  return (u & 0xFFFFFF80u) | (unsigned)n;
}
DEVI float key_score(unsigned k) {
  unsigned u = k & 0xFFFFFF80u;
  u = (u & 0x80000000u) ? (u & 0x7FFFFFFFu) : ~u;
  return __uint_as_float(u);
}
template <int N> DEVI void bitonic_sort_desc(unsigned (&v)[N]) {
#pragma unroll
  for (int k = 2; k <= N; k <<= 1) {
#pragma unroll
    for (int j = k >> 1; j > 0; j >>= 1) {
#pragma unroll
      for (int i = 0; i < N; ++i) {
        const int l = i ^ j;
        if (l > i) {
          const bool desc = ((i & k) == 0);
          const unsigned a = v[i], b = v[l];
          const unsigned mx = a > b ? a : b, mn = a > b ? b : a;
          v[i] = desc ? mx : mn;
          v[l] = desc ? mn : mx;
        }
      }
    }
  }
}
template <int N> DEVI void bitonic_merge_desc(unsigned (&v)[N]) {
#pragma unroll
  for (int j = N >> 1; j > 0; j >>= 1) {
#pragma unroll
    for (int i = 0; i < N; ++i) {
      const int l = i ^ j;
      if (l > i) {
        const unsigned a = v[i], b = v[l];
        v[i] = a > b ? a : b;
        v[l] = a > b ? b : a;
      }
    }
  }
}

DEVI void phase7(const ParamsG& p, unsigned char* smem) {
  const bf16* H2 = (const bf16*)(gp(p.ws) + OFF_XB);
  const bf16* WQ = (const bf16*)(gp(p.ws) + OFF_WQ_T);
  const bf16* SK = (const bf16*)(gp(p.ws) + OFF_SK);
  unsigned* TOPK = (unsigned*)(gp(p.ws) + OFF_TOPK);
  const int lane = threadIdx.x & 63, w = threadIdx.x >> 6;
  const int hh = lane >> 5;
  for (int it = 0;; ++it) {
    int tm, hc;
    if (!tile_map<128, 16, 2>(it, tm, hc)) break;
    const int m0 = tm * 256;
    f32x16 acc[4];
#pragma unroll
    for (int mt = 0; mt < 4; ++mt)
#pragma unroll
      for (int r = 0; r < 16; ++r) acc[mt][r] = 0.f;
    float ssq;
    route_mainloop<true>(acc, WQ + (size_t)(hc * 128) * DM, DM, H2 + (size_t)m0 * DM, DM, 16, smem, SK + (size_t)hc * 128 * 128, &ssq);
    ssq += __shfl_xor(ssq, 32, 64);
    const float rstd = rsqrtf(ssq * (1.f / DM) + 1e-6f);
    bf16x8 qf[4][2];
#pragma unroll
    for (int db = 0; db < 4; ++db)
#pragma unroll
      for (int s2 = 0; s2 < 2; ++s2)
#pragma unroll
        for (int j = 0; j < 8; ++j) qf[db][s2][j] = (bf16)(acc[db][8 * s2 + j] * rstd);
    unsigned key[64];
    int hh4 = 4 * hh; asm volatile("" : "+v"(hh4));
    const unsigned char* skl = smem + (16 % 3) * 49152;
#pragma unroll
    for (int nb = 0; nb < 4; ++nb) {
      f32x16 sc;
#pragma unroll
      for (int r = 0; r < 16; ++r) sc[r] = 0.f;
      const int n = nb * 32 + (lane & 31);
      const unsigned char* rowp = skl + n * 256 + 8 * hh;
#pragma unroll
      for (int db = 0; db < 4; ++db)
#pragma unroll
        for (int s2 = 0; s2 < 2; ++s2) {
          const int c = db * 4 + 2 * s2;
          const bf16x4 lo = *(const bf16x4*)(rowp + ((c ^ (n & 15)) * 16));
          const bf16x4 hi = *(const bf16x4*)(rowp + (((c + 1) ^ (n & 15)) * 16));
          bf16x8 a;
          a[0] = lo[0]; a[1] = lo[1]; a[2] = lo[2]; a[3] = lo[3];
          a[4] = hi[0]; a[5] = hi[1]; a[6] = hi[2]; a[7] = hi[3];
          sc = __builtin_amdgcn_mfma_f32_32x32x16_bf16(a, qf[db][s2], sc, 0, 0, 0);
        }
#pragma unroll
      for (int r = 0; r < 16; ++r) key[nb * 16 + r] = pack_key(sc[r], nb * 32 + (r & 3) + 8 * (r >> 2) + hh4);
    }
    unsigned g0[16], g1[16], g2[16], g3[16];
#pragma unroll
    for (int i = 0; i < 16; ++i) { g0[i] = key[i]; g1[i] = key[16 + i]; g2[i] = key[32 + i]; g3[i] = key[48 + i]; }
    bitonic_sort_desc<16>(g0); bitonic_sort_desc<16>(g1); bitonic_sort_desc<16>(g2); bitonic_sort_desc<16>(g3);
#pragma unroll
    for (int i = 0; i < 16; ++i) { g0[i] = g0[i] > g1[15 - i] ? g0[i] : g1[15 - i]; g2[i] = g2[i] > g3[15 - i] ? g2[i] : g3[15 - i]; }
    bitonic_merge_desc<16>(g0); bitonic_merge_desc<16>(g2);
#pragma unroll
    for (int i = 0; i < 16; ++i) g0[i] = g0[i] > g2[15 - i] ? g0[i] : g2[15 - i];
    bitonic_merge_desc<16>(g0);
    unsigned top[16];
#pragma unroll
    for (int i = 0; i < 16; ++i) {
      const unsigned o = (unsigned)__shfl_xor((int)g0[15 - i], 32, 64);
      top[i] = g0[i] > o ? g0[i] : o;
    }
    bitonic_merge_desc<16>(top);
    if (hh == 0) {
      const int t = m0 + w * 32 + (lane & 31);
      u32x4* dst = (u32x4*)(TOPK + ((size_t)t * 16 + hc) * 16);
      dst[0] = mk_u4(top[0], top[1], top[2], top[3]);
      dst[1] = mk_u4(top[4], top[5], top[6], top[7]);
      dst[2] = mk_u4(top[8], top[9], top[10], top[11]);
      dst[3] = mk_u4(top[12], top[13], top[14], top[15]);
    }
  }
}

DEVI void phase7b(const ParamsG& p, unsigned char* smem) {
  unsigned* ka = (unsigned*)smem;
  unsigned* kb = ka + 16 * 512;
  const unsigned* TOPK = (const unsigned*)(gp(p.ws) + OFF_TOPK);
  int* IDX = (int*)(gp(p.ws) + OFF_IDX);
  float* GATE = (float*)(gp(p.ws) + OFF_GATE);
  const int tid = threadIdx.x;
  for (int grp = blockIdx.x; grp < (T_TOK * 8) / NTHREADS; grp += gridDim.x) {
    const int item = grp * NTHREADS + tid;
    const u32x4* src = (const u32x4*)(TOPK + (size_t)item * 32);
#pragma unroll
    for (int i = 0; i < 4; ++i) {
      const u32x4 va = src[i], vb = src[4 + i];
      ka[(4 * i + 0) * 512 + tid] = va.x; ka[(4 * i + 1) * 512 + tid] = va.y;
      ka[(4 * i + 2) * 512 + tid] = va.z; ka[(4 * i + 3) * 512 + tid] = va.w;
      kb[(4 * i + 0) * 512 + tid] = vb.x; kb[(4 * i + 1) * 512 + tid] = vb.y;
      kb[(4 * i + 2) * 512 + tid] = vb.z; kb[(4 * i + 3) * 512 + tid] = vb.w;
    }
    unsigned long long jp = 0ull;
    float sc[16];
    int ex[16];
#pragma unroll
    for (int r = 0; r < 16; ++r) {
      float best = -3.0e38f;
      int bi = 0, bj = 0;
      for (int i = 0; i <= r; ++i) {
        const int ji = (int)((jp >> (4 * i)) & 15ull);
        const float cand = key_score(ka[i * 512 + tid]) + key_score(kb[ji * 512 + tid]);
        if (cand > best) { best = cand; bi = i; bj = ji; }
      }
      sc[r] = best;
      ex[r] = (int)(ka[bi * 512 + tid] & 127u) * 128 + (int)(kb[bj * 512 + tid] & 127u);
      jp += 1ull << (4 * bi);
    }
    float den = 0.f;
    const float smax = sc[0];
#pragma unroll
    for (int r = 0; r < 16; ++r) { sc[r] = __expf(sc[r] - smax); den += sc[r]; }
    const float inv = 1.f / den;
    i32x4* di = (i32x4*)(IDX + (size_t)item * 16);
    f32x4* dg = (f32x4*)(GATE + (size_t)item * 16);
#pragma unroll
    for (int i = 0; i < 4; ++i) {
      di[i] = mk_i4(ex[4 * i], ex[4 * i + 1], ex[4 * i + 2], ex[4 * i + 3]);
      dg[i] = mk_f4(sc[4 * i] * inv, sc[4 * i + 1] * inv, sc[4 * i + 2] * inv, sc[4 * i + 3] * inv);
    }
  }
}

struct PeerBuf { u32x4 uq[2]; u32x4 vq[2]; float ius; float gt; };
template <class T> DEVI const T* scalar_base(const T* q) {
  const unsigned long long v = (unsigned long long)q;
  const unsigned lo = (unsigned)__builtin_amdgcn_readfirstlane((int)(unsigned)v), hi = (unsigned)__builtin_amdgcn_readfirstlane((int)(unsigned)(v >> 32));
  return (const T*)(const GLB T*)(((unsigned long long)hi << 32) | lo);
}
DEVI float gelu_as(float d) {
  const float ax = fabsf(d);
  const float x = ax * 0.70710678f;
  const float t = __builtin_amdgcn_rcpf(fmaf(0.3275911f, x, 1.f));
  float pl = fmaf(t, 1.061405429f, -1.453152027f);
  pl = fmaf(pl, t, 1.421413741f); pl = fmaf(pl, t, -0.284496736f); pl = fmaf(pl, t, 0.254829592f);
  pl *= t;
  const float ex = __builtin_amdgcn_exp2f(x * x * -1.44269504f);
  const float erfa = fmaf(-pl, ex, 1.f);
  return 0.5f * fmaf(ax, erfa, d);
}
DEVI void peer_issue(PeerBuf& b, int it, int idxr, float iusr, float givr, const unsigned char* __restrict__ U8, const unsigned char* __restrict__ V8,
                     int g, int j, int lane) {
  const int srcl = (it * 4 + g) & 63;
  const int e = __shfl(idxr, srcl, 64);
  b.ius = __shfl(iusr, srcl, 64);
  b.gt = __shfl(givr, srcl, 64);
  const unsigned uo = (unsigned)(e * 512 + j * 16);
  b.uq[0] = *(const u32x4*)(U8 + uo);
  b.uq[1] = *(const u32x4*)(U8 + uo + 256u);
  const int hf = lane >> 5;
#pragma unroll
  for (int q = 0; q < 2; ++q) {
    const int ev = __shfl(idxr, (it * 4 + 2 * q + hf) & 63, 64);
    b.vq[q] = *(const u32x4*)(V8 + (unsigned)(ev * 512 + (lane & 31) * 16));
  }
}
#define FP4_BF16(W, S) __builtin_bit_cast(unsigned, __builtin_amdgcn_cvt_scalef32_pk_bf16_fp4((W), 1.0f, (S)))
DEVI void peer_compute(const PeerBuf& b, const unsigned (&hq)[32], float (&acc)[32], int lane) {
  float d0 = 0.f, d1 = 0.f, d2 = 0.f, d3 = 0.f;
#pragma unroll
  for (int i = 0; i < 2; ++i)
#pragma unroll
    for (int wi = 0; wi < 4; ++wi) {
      const unsigned w = b.uq[i][wi];
      d0 = dot2bf(hq[i * 16 + wi * 4 + 0], FP4_BF16(w, 0), d0);
      d1 = dot2bf(hq[i * 16 + wi * 4 + 1], FP4_BF16(w, 1), d1);
      d2 = dot2bf(hq[i * 16 + wi * 4 + 2], FP4_BF16(w, 2), d2);
      d3 = dot2bf(hq[i * 16 + wi * 4 + 3], FP4_BF16(w, 3), d3);
    }
  float d = (d0 + d1) + (d2 + d3);
  d = row16_allsum(d) * b.ius;
  const float act = gelu_as(d);
  const float cf = b.gt * act;
  const int hf = lane >> 5;
#pragma unroll
  for (int q = 0; q < 2; ++q) {
    const float cc = __shfl(cf, (2 * q + hf) * 16, 64);
#pragma unroll
    for (int wi = 0; wi < 4; ++wi) {
      const unsigned w = b.vq[q][wi];
      const f32x2 f0 = __builtin_amdgcn_cvt_scalef32_pk_f32_fp4(w, 1.0f, 0);
      const f32x2 f1 = __builtin_amdgcn_cvt_scalef32_pk_f32_fp4(w, 1.0f, 1);
      const f32x2 f2 = __builtin_amdgcn_cvt_scalef32_pk_f32_fp4(w, 1.0f, 2);
      const f32x2 f3 = __builtin_amdgcn_cvt_scalef32_pk_f32_fp4(w, 1.0f, 3);
      acc[wi * 8 + 0] += cc * f0.x; acc[wi * 8 + 1] += cc * f0.y;
      acc[wi * 8 + 2] += cc * f1.x; acc[wi * 8 + 3] += cc * f1.y;
      acc[wi * 8 + 4] += cc * f2.x; acc[wi * 8 + 5] += cc * f2.y;
      acc[wi * 8 + 6] += cc * f3.x; acc[wi * 8 + 7] += cc * f3.y;
    }
  }
}
struct PeerUBuf { u32x4 uq[2]; };
DEVI void peer_uissue(PeerUBuf& b, int it, int idxr, const unsigned char* __restrict__ U8, int g, int j) {
  const int e = __shfl(idxr, (it * 4 + g) & 63, 64);
  const unsigned uo = (unsigned)(e * 512 + j * 16);
  b.uq[0] = *(const u32x4*)(U8 + uo);
  b.uq[1] = *(const u32x4*)(U8 + uo + 256u);
}
DEVI float peer_udot(const PeerUBuf& b, const unsigned (&hq)[32]) {
  float d0 = 0.f, d1 = 0.f, d2 = 0.f, d3 = 0.f;
#pragma unroll
  for (int i = 0; i < 2; ++i)
#pragma unroll
    for (int wi = 0; wi < 4; ++wi) {
      const unsigned w = b.uq[i][wi];
      d0 = dot2bf(hq[i * 16 + wi * 4 + 0], FP4_BF16(w, 0), d0);
      d1 = dot2bf(hq[i * 16 + wi * 4 + 1], FP4_BF16(w, 1), d1);
      d2 = dot2bf(hq[i * 16 + wi * 4 + 2], FP4_BF16(w, 2), d2);
      d3 = dot2bf(hq[i * 16 + wi * 4 + 3], FP4_BF16(w, 3), d3);
    }
  return row16_allsum((d0 + d1) + (d2 + d3));
}
DEVI void phase8a(const ParamsG& p) {
  int tid_ = threadIdx.x; asm volatile("" : "+v"(tid_));
  const int lane = tid_ & 63;
  const int gw = blockIdx.x * NWAVES + (tid_ >> 6), nw = gridDim.x * NWAVES;
  const bf16* H2 = (const bf16*)(gp(p.ws) + OFF_XB);
  const unsigned char* U8 = scalar_base((const unsigned char*)(gp(p.ws) + OFF_U8));
  const float* IUS = (const float*)(gp(p.ws) + OFF_IUS);
  const int* IDX = (const int*)(gp(p.ws) + OFF_IDX);
  float* DD = (float*)(gp(p.ws) + OFF_DD);
  const int g = lane >> 4, j = lane & 15;
  const int srcg = (lane & 3) * 16;
  for (int t = gw; t < T_TOK; t += nw) {
    unsigned hq[32];
#pragma unroll
    for (int i = 0; i < 2; ++i) {
      const bf16* hp = H2 + (size_t)t * DM + i * 512 + j * 32;
#pragma unroll
      for (int c = 0; c < 4; ++c) {
        const u32x4 a = *(const u32x4*)(hp + c * 8);
        hq[i * 16 + c * 4 + 0] = a.x; hq[i * 16 + c * 4 + 1] = a.y; hq[i * 16 + c * 4 + 2] = a.z; hq[i * 16 + c * 4 + 3] = a.w;
      }
    }
    float rstd;
    {
      float q0 = 0.f, q1 = 0.f;
#pragma unroll
      for (int i = 0; i < 32; i += 2) { q0 = dot2bf(hq[i], hq[i], q0); q1 = dot2bf(hq[i + 1], hq[i + 1], q1); }
      rstd = rsqrtf(row16_allsum(q0 + q1) * (1.f / DM) + 1e-6f);
    }
    const int idx0 = IDX[(size_t)t * 128 + lane], idx1 = IDX[(size_t)t * 128 + 64 + lane];
    const float iu0 = IUS[idx0] * rstd, iu1 = IUS[idx1] * rstd;
    float dv0 = 0.f, dv1 = 0.f;
    PeerUBuf ba, bb, bc;
#define UISSUE(B, IT) peer_uissue(B, (IT), ((IT) < 16) ? idx0 : idx1, U8, g, j)
#define UTAKE(B, IT) { const float d_ = __shfl(peer_udot(B, hq), srcg, 64); const bool me_ = (lane >> 2) == ((IT) & 15); \
      if ((IT) < 16) dv0 = me_ ? d_ : dv0; else dv1 = me_ ? d_ : dv1; }
    UISSUE(ba, 0);
    UISSUE(bb, 1);
#pragma unroll 1
    for (int it = 0; it < 30; it += 3) {
      UISSUE(bc, it + 2);
      UTAKE(ba, it)
      UISSUE(ba, it + 3);
      UTAKE(bb, it + 1)
      UISSUE(bb, it + 4);
      UTAKE(bc, it + 2)
    }
    UTAKE(ba, 30)
    UTAKE(bb, 31)
#undef UISSUE
#undef UTAKE
    DD[(size_t)t * 128 + lane] = dv0 * iu0;
    DD[(size_t)t * 128 + 64 + lane] = dv1 * iu1;
  }
}
struct PeerVBuf { u32x4 vq[2]; float cc[2]; };
DEVI void peer_vissue(PeerVBuf& b, int it, int idxr, float cfr, const unsigned char* __restrict__ V8, int lane) {
  const int hf = lane >> 5;
#pragma unroll
  for (int q = 0; q < 2; ++q) {
    const int src = (it * 4 + 2 * q + hf) & 63;
    const int ev = __shfl(idxr, src, 64);
    b.cc[q] = __shfl(cfr, src, 64);
    b.vq[q] = *(const u32x4*)(V8 + (unsigned)(ev * 512 + (lane & 31) * 16));
  }
}
DEVI void peer_vcompute(const PeerVBuf& b, float (&acc)[32]) {
#pragma unroll
  for (int q = 0; q < 2; ++q) {
    const float cc = b.cc[q];
#pragma unroll
    for (int wi = 0; wi < 4; ++wi) {
      const unsigned w = b.vq[q][wi];
      const f32x2 f0 = __builtin_amdgcn_cvt_scalef32_pk_f32_fp4(w, 1.0f, 0);
      const f32x2 f1 = __builtin_amdgcn_cvt_scalef32_pk_f32_fp4(w, 1.0f, 1);
      const f32x2 f2 = __builtin_amdgcn_cvt_scalef32_pk_f32_fp4(w, 1.0f, 2);
      const f32x2 f3 = __builtin_amdgcn_cvt_scalef32_pk_f32_fp4(w, 1.0f, 3);
      acc[wi * 8 + 0] += cc * f0.x; acc[wi * 8 + 1] += cc * f0.y;
      acc[wi * 8 + 2] += cc * f1.x; acc[wi * 8 + 3] += cc * f1.y;
      acc[wi * 8 + 4] += cc * f2.x; acc[wi * 8 + 5] += cc * f2.y;
      acc[wi * 8 + 6] += cc * f3.x; acc[wi * 8 + 7] += cc * f3.y;
    }
  }
}
template <bool DRY> DEVI void phase8(const ParamsG& p) {
  int tid_ = threadIdx.x; asm volatile("" : "+v"(tid_));
  const int lane = tid_ & 63;
  const int gw = blockIdx.x * NWAVES + (tid_ >> 6), nw = gridDim.x * NWAVES;
  const unsigned char* V8 = scalar_base((const unsigned char*)(gp(p.ws) + OFF_V8));
  const float* IVS = (const float*)(gp(p.ws) + OFF_IVS);
  const int* IDX = (const int*)(gp(p.ws) + OFF_IDX);
  const float* GATE = (const float*)(gp(p.ws) + OFF_GATE);
  const float* DD = (const float*)(gp(p.ws) + OFF_DD);
  bf16* H3 = (bf16*)(gp(p.ws) + OFF_H3);
  const int ocol = (lane & 31) * 32 + (lane >> 5) * 16;
  f32x4 gpl[4];
#pragma unroll
  for (int i = 0; i < 4; ++i) gpl[i] = *(const f32x4*)(gp(p.norm_ple) + ocol + i * 4);
  for (int t = gw; t < T_TOK; t += nw) {
    const int idx0 = IDX[(size_t)t * 128 + lane], idx1 = IDX[(size_t)t * 128 + 64 + lane];
    const float cf0 = GATE[(size_t)t * 128 + lane] * IVS[idx0] * gelu_as(DD[(size_t)t * 128 + lane]);
    const float cf1 = GATE[(size_t)t * 128 + 64 + lane] * IVS[idx1] * gelu_as(DD[(size_t)t * 128 + 64 + lane]);
    float acc[32];
#pragma unroll
    for (int i = 0; i < 32; ++i) acc[i] = 0.f;
    PeerVBuf ba, bb, bc;
#define PISSUE(B, IT) peer_vissue(B, (IT), ((IT) < 16) ? idx0 : idx1, ((IT) < 16) ? cf0 : cf1, V8, lane)
    PISSUE(ba, 0);
    PISSUE(bb, 1);
#pragma unroll 1
    for (int it = 0; it < 30; it += 3) {
      PISSUE(bc, it + 2);
      peer_vcompute(ba, acc);
      PISSUE(ba, it + 3);
      peer_vcompute(bb, acc);
      PISSUE(bb, it + 4);
      peer_vcompute(bc, acc);
    }
    peer_vcompute(ba, acc);
    peer_vcompute(bb, acc);
#undef PISSUE
    float keep[16];
    const bool hi = (lane >> 5) != 0;
#pragma unroll
    for (int i = 0; i < 16; ++i) {
      const float mine = hi ? acc[16 + i] : acc[i];
      const float give = hi ? acc[i] : acc[16 + i];
      keep[i] = mine + __shfl_xor(give, 32, 64);
    }
    bf16* xo = (bf16*)(gp(p.ws) + OFF_XB) + (size_t)t * DM + ocol;
    f32x4 xv[4];
    float ss = 0.f;
    {
      const bf16x8 xa = *(const bf16x8*)xo, xc = *(const bf16x8*)(xo + 8);
      bf16x8 ya, yc;
#pragma unroll
      for (int i = 0; i < 2; ++i) {
        xv[i].x = (float)xa[i * 4 + 0] + keep[i * 4 + 0]; xv[i].y = (float)xa[i * 4 + 1] + keep[i * 4 + 1];
        xv[i].z = (float)xa[i * 4 + 2] + keep[i * 4 + 2]; xv[i].w = (float)xa[i * 4 + 3] + keep[i * 4 + 3];
        xv[2 + i].x = (float)xc[i * 4 + 0] + keep[8 + i * 4 + 0]; xv[2 + i].y = (float)xc[i * 4 + 1] + keep[8 + i * 4 + 1];
        xv[2 + i].z = (float)xc[i * 4 + 2] + keep[8 + i * 4 + 2]; xv[2 + i].w = (float)xc[i * 4 + 3] + keep[8 + i * 4 + 3];
        ya[i * 4 + 0] = (bf16)xv[i].x; ya[i * 4 + 1] = (bf16)xv[i].y; ya[i * 4 + 2] = (bf16)xv[i].z; ya[i * 4 + 3] = (bf16)xv[i].w;
        yc[i * 4 + 0] = (bf16)xv[2 + i].x; yc[i * 4 + 1] = (bf16)xv[2 + i].y; yc[i * 4 + 2] = (bf16)xv[2 + i].z; yc[i * 4 + 3] = (bf16)xv[2 + i].w;
      }
#pragma unroll
      for (int i = 0; i < 4; ++i) ss += xv[i].x * xv[i].x + xv[i].y * xv[i].y + xv[i].z * xv[i].z + xv[i].w * xv[i].w;
      if (!DRY) { *(bf16x8*)xo = ya; *(bf16x8*)(xo + 8) = yc; }
    }
    ss = wave_sum(ss);
    const float rs = rsqrtf(ss * (1.f / DM) + 1e-6f);
    bf16x8 o0, o1;
    o0[0] = (bf16)(xv[0].x * rs * gpl[0].x); o0[1] = (bf16)(xv[0].y * rs * gpl[0].y); o0[2] = (bf16)(xv[0].z * rs * gpl[0].z); o0[3] = (bf16)(xv[0].w * rs * gpl[0].w);
    o0[4] = (bf16)(xv[1].x * rs * gpl[1].x); o0[5] = (bf16)(xv[1].y * rs * gpl[1].y); o0[6] = (bf16)(xv[1].z * rs * gpl[1].z); o0[7] = (bf16)(xv[1].w * rs * gpl[1].w);
    o1[0] = (bf16)(xv[2].x * rs * gpl[2].x); o1[1] = (bf16)(xv[2].y * rs * gpl[2].y); o1[2] = (bf16)(xv[2].z * rs * gpl[2].z); o1[3] = (bf16)(xv[2].w * rs * gpl[2].w);
    o1[4] = (bf16)(xv[3].x * rs * gpl[3].x); o1[5] = (bf16)(xv[3].y * rs * gpl[3].y); o1[6] = (bf16)(xv[3].z * rs * gpl[3].z); o1[7] = (bf16)(xv[3].w * rs * gpl[3].w);
    *(bf16x8*)(H3 + (size_t)t * DM + ocol) = o0;
    *(bf16x8*)(H3 + (size_t)t * DM + ocol + 8) = o1;
  }
}

struct EpiX3 {
  static constexpr bool PERM = true, AFTER_DRAIN = false;
  const bf16* pps; bf16* xb;
  DEVI void operator()(PgAcc acc, const pg8::Unit& u, int wr, int wc, int fr, int fq) const {
    bf16x4 lp[2][4]; bf16x4 lx[2][4];
    PG_EPI_PIPELINED(
      lp[slot][c] = *(const bf16x4*)(pps + off); lx[slot][c] = *(const bf16x4*)(xb + off); ,
      const bf16x4 pp = lp[slot][c];
      const bf16x4 xi = lx[slot][c];
      bf16x4 xo;
      xo[0] = (bf16)((float)xi[0] + sigmoid_f(v.x) * (float)pp[0]); xo[1] = (bf16)((float)xi[1] + sigmoid_f(v.y) * (float)pp[1]);
      xo[2] = (bf16)((float)xi[2] + sigmoid_f(v.z) * (float)pp[2]); xo[3] = (bf16)((float)xi[3] + sigmoid_f(v.w) * (float)pp[3]);
      *(bf16x4*)(xb + off) = xo;
    )
  }
};
DEVI void phase10(const ParamsG& p, unsigned char* smem) {
  bf16* PPS = (bf16*)(gp(p.ws) + OFF_H2);
  { EpiMix<0> e; e.D = PPS; e.S = nullptr; run_gemm(smem, (const bf16*)(gp(p.ws) + OFF_PBF), (const bf16*)(gp(p.ws) + OFF_PP_T), T_TOK, DM, 256, e); }
  { EpiX3 e; e.pps = PPS; e.xb = (bf16*)(gp(p.ws) + OFF_XB); run_gemm(smem, (const bf16*)(gp(p.ws) + OFF_H3), (const bf16*)(gp(p.ws) + OFF_PG_T), T_TOK, DM, DM, e); }
}

DEVI void phase11(const ParamsG& p) {
  int tid_ = threadIdx.x; asm volatile("" : "+v"(tid_));
  const int lane = tid_ & 63;
  const int gw = blockIdx.x * NWAVES + (tid_ >> 6), nw = gridDim.x * NWAVES;
  f32x4 gn[4];
#pragma unroll
  for (int i = 0; i < 4; ++i) gn[i] = *(const f32x4*)(gp(p.norm_final) + i * 256 + lane * 4);
  for (int t = gw; t < T_TOK; t += nw) {
    float* xr = gp(p.out) + (size_t)t * DM;
    const bf16* xs = (const bf16*)(gp(p.ws) + OFF_XB) + (size_t)t * DM;
    f32x4 v[4];
    float ss = 0.f;
#pragma unroll
    for (int i = 0; i < 4; ++i) {
      const bf16x4 b4 = *(const bf16x4*)(xs + i * 256 + lane * 4);
      v[i].x = (float)b4[0]; v[i].y = (float)b4[1]; v[i].z = (float)b4[2]; v[i].w = (float)b4[3];
      ss += v[i].x * v[i].x + v[i].y * v[i].y + v[i].z * v[i].z + v[i].w * v[i].w;
    }
    ss = wave_sum(ss);
    const float rs = rsqrtf(ss * (1.f / DM) + 1e-6f);
#pragma unroll
    for (int i = 0; i < 4; ++i) {
      f32x4 o;
      o.x = v[i].x * rs * gn[i].x; o.y = v[i].y * rs * gn[i].y; o.z = v[i].z * rs * gn[i].z; o.w = v[i].w * rs * gn[i].w;
      *(f32x4*)(xr + i * 256 + lane * 4) = o;
    }
  }
}

constexpr int N_PHASES = 16;
__global__ void __launch_bounds__(NTHREADS, 2) hybrid_block_kernel(Params p_arg, int ph0, int ph1) {
  extern __shared__ __attribute__((aligned(1024))) unsigned char smem[];
  cg::grid_group grid = cg::this_grid();
  Params* ptab = (Params*)(p_arg.ws + OFF_PTAB) + blockIdx.x;
  if (threadIdx.x == 0) *ptab = p_arg;
  __syncthreads();
  const ParamsG& p = *(const ParamsG*)ptab;
#ifndef DUP_PHASE
#define DUP_PHASE -1
#endif
  volatile LAS unsigned* xst = (volatile LAS unsigned*)(smem + LDS_BYTES - 256);
  if (threadIdx.x == 0) { xst[0] = 0u; xst[1] = 0u; }
  __syncthreads();
#define GSYNC(K) { if ((K) == 0) { grid.sync(); (void)xcd_barrier_post((unsigned*)(gp(p.ws) + OFF_BAR), xst); } else { XcdBarrier xb_; xb_.bar = (unsigned*)(gp(p.ws) + OFF_BAR); xb_.x = xb_xcc_id(); xb_.st = xst; xcd_barrier(xb_); } }
#define RUN_PHASE(K, CALL) if (ph0 <= (K) && (K) < ph1) { \
    if (DUP_PHASE == (K)) { CALL; GSYNC(1) } \
    CALL; if ((K) + 1 < ph1) GSYNC(K) }
  RUN_PHASE(0, phase0(p, smem))
  RUN_PHASE(1, phase1(p, smem))
  RUN_PHASE(2, phase2a(p))
  RUN_PHASE(3, phase2b(p, smem))
#ifdef SEQ_SCAN
  RUN_PHASE(4, { phase3a(p, smem); __syncthreads(); phase3b(p, smem); })
  RUN_PHASE(5, { })
  RUN_PHASE(6, { })
#else
  RUN_PHASE(4, phase3b(p, smem))
  RUN_PHASE(5, phase3A(p, smem))
  RUN_PHASE(6, phase3B(p, smem))
#endif
  RUN_PHASE(7, phase3c(p))
  RUN_PHASE(8, phase4(p, smem))
  RUN_PHASE(9, phase5(p, smem))
  RUN_PHASE(10, phase7(p, smem))
  RUN_PHASE(11, phase7b(p, smem))
  RUN_PHASE(12, phase8a(p))
  RUN_PHASE(13, phase8<false>(p))
  RUN_PHASE(14, phase10(p, smem))
  RUN_PHASE(15, phase11(p))
#undef RUN_PHASE
}

extern "C" void kernel_launch(void* const* d_in, const int* in_sizes, int n_in, void* d_out, int out_size, void* d_ws,
                              size_t ws_size, hipStream_t stream) {
  static int grid_blocks = 0;
  if (!grid_blocks) {
    int dev = 0, cus = 0, per_cu = 0;
    hipGetDevice(&dev);
    hipDeviceGetAttribute(&cus, hipDeviceAttributeMultiprocessorCount, dev);
    hipFuncSetAttribute((const void*)hybrid_block_kernel, hipFuncAttributeMaxDynamicSharedMemorySize, LDS_BYTES);
    hipOccupancyMaxActiveBlocksPerMultiprocessor(&per_cu, hybrid_block_kernel, NTHREADS, LDS_BYTES);
    if (per_cu > 1) per_cu = 1;
    if (per_cu < 1) per_cu = 1;
    grid_blocks = cus * per_cu;
  }
  Params p{};
  const float** fp = (const float**)&p;
  for (int i = 0; i < 32; ++i) fp[i] = (const float*)d_in[i];
  p.pos = (const int*)d_in[2];
  p.out = (float*)d_out;
  p.ws = (unsigned char*)d_ws;
#ifndef MULTI_LAUNCH
  int ph0 = 0, ph1 = N_PHASES;
  void* args[] = {&p, &ph0, &ph1};
  hipError_t e = hipLaunchCooperativeKernel((void*)hybrid_block_kernel, dim3(grid_blocks), dim3(NTHREADS), args, LDS_BYTES, stream);
  if (e != hipSuccess) fprintf(stderr, "cooperative launch failed: %s (grid %d)\n", hipGetErrorString(e), grid_blocks);
#else
  for (int ph = 0; ph < N_PHASES; ++ph)
    hipLaunchKernelGGL(hybrid_block_kernel, dim3(grid_blocks), dim3(NTHREADS), LDS_BYTES, stream, p, ph, ph + 1);
#endif
}
```

```cpp
#include <hip/hip_runtime.h>
#include <hip/hip_cooperative_groups.h>
#include <stdint.h>
#include <stdio.h>
namespace cg = cooperative_groups;

typedef __bf16 bf16;
typedef __attribute__((ext_vector_type(8))) __bf16 bf16x8;
typedef __attribute__((ext_vector_type(4))) __bf16 bf16x4;
typedef __attribute__((ext_vector_type(2))) __bf16 bf16x2;
typedef __attribute__((ext_vector_type(16))) float f32x16;
typedef __attribute__((ext_vector_type(4))) float f32x4;
typedef __attribute__((ext_vector_type(2))) float f32x2;
typedef __attribute__((ext_vector_type(4))) unsigned u32x4;
typedef __attribute__((ext_vector_type(2))) unsigned u32x2;
typedef __attribute__((ext_vector_type(4))) int i32x4;

#define DEVI __device__ __forceinline__
#ifndef ABL
#define ABL 0
#endif

constexpr int T_TOK = 32768;
constexpr int SEQ = 4096;
constexpr int DM = 1024;
constexpr int IN_COLS = 4512;
constexpr int RWC = 1792;
constexpr int MLC = 672;
constexpr int NTHREADS = 512;
constexpr int NWAVES = 8;
constexpr int LDS_BYTES = 148480;

constexpr size_t MiB = 1ull << 20;
constexpr size_t OFF_WIN_T = 0;
constexpr size_t OFF_WG_T = 5 * MiB;
constexpr size_t OFF_WLORA_T = 9 * MiB;
constexpr size_t OFF_RWO_T = 10 * MiB;
constexpr size_t OFF_MLO_T = 11 * MiB;
constexpr size_t OFF_WUQ_T = 12 * MiB;
constexpr size_t OFF_WUKV_T = 13 * MiB;
constexpr size_t OFF_PP_T = 13 * MiB + 524288;
constexpr size_t OFF_WOUT_T = 14 * MiB;
constexpr size_t OFF_PG_T = 16 * MiB;
constexpr size_t OFF_WQ_T = 18 * MiB;
constexpr size_t OFF_SK = 22 * MiB;
constexpr size_t OFF_CNT = 22 * MiB + 524288;
constexpr size_t OFF_BAR = 22 * MiB + 524288 + 65536;
constexpr size_t OFF_PTAB = 22 * MiB + 524288 + 131072;
constexpr size_t OFF_CS = 23 * MiB;
constexpr size_t OFF_SN = 25 * MiB;
constexpr size_t OFF_RK = 27 * MiB;
constexpr size_t OFF_PBF = 28 * MiB;
constexpr size_t OFF_U8 = 44 * MiB;
constexpr size_t OFF_V8 = 60 * MiB;
constexpr size_t OFF_IUS = 76 * MiB;
constexpr size_t OFF_IVS = 76 * MiB + 65536;
constexpr size_t OFF_H1 = 108 * MiB;
constexpr size_t OFF_ZRW = 172 * MiB;
constexpr size_t OFF_ZMLA = 284 * MiB;
constexpr size_t OFF_LORA = 326 * MiB;
constexpr size_t OFF_CQ = 342 * MiB;
constexpr size_t OFF_CKV = 366 * MiB;
constexpr size_t OFF_E = 382 * MiB;
constexpr size_t OFF_ICLR = 446 * MiB;
constexpr size_t OFF_G = 478 * MiB;
constexpr size_t OFF_O = 284 * MiB;
constexpr size_t OFF_YRAW = 326 * MiB;
constexpr size_t OFF_YAPRE = 358 * MiB;
constexpr size_t OFF_M = 172 * MiB;
constexpr size_t OFF_M2 = 390 * MiB;
constexpr size_t OFF_H2 = 382 * MiB;
constexpr size_t OFF_TOPK = 236 * MiB;
constexpr size_t OFF_IDX = 446 * MiB;
constexpr size_t OFF_GATE = 462 * MiB;
constexpr size_t OFF_H3 = 172 * MiB;
constexpr size_t OFF_DD = 326 * MiB;
constexpr size_t OFF_XB = 108 * MiB;
constexpr size_t OFF_Q = 0;
constexpr size_t OFF_K = 48 * MiB;
constexpr size_t OFF_VT = 96 * MiB;

struct Params {
  const float* x; const float* p; const int* pos; const float* norm_mix; const float* w_in; const float* rw_mu;
  const float* rw_w0; const float* rw_w2; const float* rw_a0; const float* rw_a2; const float* rw_g2; const float* rw_k_k;
  const float* rw_k_a; const float* rw_r_k; const float* rw_gn_w; const float* rw_gn_b; const float* rw_w_o;
  const float* mla_q_norm; const float* mla_w_uq; const float* mla_kv_norm; const float* mla_w_ukv; const float* mla_w_o;
  const float* w_out; const float* norm_ffn; const float* peer_w_q; const float* peer_sub_keys; const float* peer_u;
  const float* peer_v; const float* norm_ple; const float* ple_w_gate; const float* ple_w_proj; const float* norm_final;
  float* out; unsigned char* ws;
};
#define GLB __attribute__((address_space(1)))
struct ParamsG {
  const GLB float* x; const GLB float* p; const GLB int* pos; const GLB float* norm_mix; const GLB float* w_in; const GLB float* rw_mu;
  const GLB float* rw_w0; const GLB float* rw_w2; const GLB float* rw_a0; const GLB float* rw_a2; const GLB float* rw_g2; const GLB float* rw_k_k;
  const GLB float* rw_k_a; const GLB float* rw_r_k; const GLB float* rw_gn_w; const GLB float* rw_gn_b; const GLB float* rw_w_o;
  const GLB float* mla_q_norm; const GLB float* mla_w_uq; const GLB float* mla_kv_norm; const GLB float* mla_w_ukv; const GLB float* mla_w_o;
  const GLB float* w_out; const GLB float* norm_ffn; const GLB float* peer_w_q; const GLB float* peer_sub_keys; const GLB float* peer_u;
  const GLB float* peer_v; const GLB float* norm_ple; const GLB float* ple_w_gate; const GLB float* ple_w_proj; const GLB float* norm_final;
  GLB float* out; GLB unsigned char* ws;
};
template <class T> DEVI T* gp(GLB T* q) { return (T*)q; }

DEVI u32x4 mk_u4(unsigned a, unsigned b, unsigned c, unsigned d) { u32x4 v; v.x = a; v.y = b; v.z = c; v.w = d; return v; }
DEVI u32x2 mk_u2(unsigned a, unsigned b) { u32x2 v; v.x = a; v.y = b; return v; }
DEVI f32x4 mk_f4(float a, float b, float c, float d) { f32x4 v; v.x = a; v.y = b; v.z = c; v.w = d; return v; }
DEVI i32x4 mk_i4(int a, int b, int c, int d) { i32x4 v; v.x = a; v.y = b; v.z = c; v.w = d; return v; }
DEVI float wave_sum(float v) {
#pragma unroll
  for (int o = 32; o > 0; o >>= 1) v += __shfl_xor(v, o, 64);
  return v;
}
template <int CTRL> DEVI float dpp_f(float v) {
  return __int_as_float(__builtin_amdgcn_update_dpp(0, __float_as_int(v), CTRL, 0xf, 0xf, true));
}
DEVI float row16_allsum(float v) {
  v += dpp_f<0xB1>(v);
  v += dpp_f<0x4E>(v);
  v += dpp_f<0x141>(v);
  v += dpp_f<0x140>(v);
  return v;
}
DEVI float row8_allsum(float v) {
  v += dpp_f<0xB1>(v);
  v += dpp_f<0x4E>(v);
  v += dpp_f<0x141>(v);
  return v;
}
DEVI float sigmoid_f(float x) { return 1.f / (1.f + __expf(-x)); }
DEVI float bflo(unsigned u) { return __uint_as_float(u << 16); }
DEVI float bfhi(unsigned u) { return __uint_as_float(u & 0xffff0000u); }
DEVI unsigned pack2(float a, float b) {
  bf16x2 v; v[0] = (bf16)a; v[1] = (bf16)b;
  return __builtin_bit_cast(unsigned, v);
}
DEVI float dot2bf(unsigned a, unsigned b, float c) {
  return __builtin_amdgcn_fdot2_f32_bf16(__builtin_bit_cast(bf16x2, a), __builtin_bit_cast(bf16x2, b), c, false);
}


#define XB_TMO      128
#define XB_XCNT(j)  (256  + 64 * (j))
#define XB_XSUB(j)  (1280 + 64 * (j))
#define XB_XGEN(j)  (2304 + 64 * (j))
#define XB_TOP      3328
#define XB_TOPGEN   3392
#define XCD_BAR_WORDS 3456
#define XB_SPIN_CAP (1u << 22)
#define LAS __attribute__((address_space(3)))
DEVI unsigned xb_ld(unsigned* p) { return __hip_atomic_load(p, __ATOMIC_RELAXED, __HIP_MEMORY_SCOPE_AGENT); }
DEVI unsigned xb_add(unsigned* p, unsigned v) { return __hip_atomic_fetch_add(p, v, __ATOMIC_RELAXED, __HIP_MEMORY_SCOPE_AGENT); }
DEVI unsigned xb_xcc_id() { return (unsigned)__builtin_amdgcn_s_getreg((3 << 11) | 20) & 0xFu; }
#define XB_SPIN(cond, bar) do { unsigned _sp = 0; while (cond) { __builtin_amdgcn_s_sleep(1); \
    if ((++_sp & 255u) == 0u) { if (xb_ld(&(bar)[XB_TMO])) break; if (_sp > XB_SPIN_CAP) { atomicAdd(&(bar)[XB_TMO], 1u); break; } } } } while (0)
struct XcdBarrier { unsigned* bar; unsigned x; volatile LAS unsigned* st; };
DEVI XcdBarrier xcd_barrier_post(unsigned* bar, volatile LAS unsigned* st) {
  XcdBarrier b; b.bar = bar; b.x = xb_xcc_id(); b.st = st;
  if (threadIdx.x == 0) (void)xb_add(&bar[XB_XCNT(b.x)], 1u);
  return b;
}
DEVI void xcd_barrier_complete(unsigned* bar, unsigned x, unsigned& nloc, unsigned& nx) {
  const unsigned G = gridDim.x * gridDim.y * gridDim.z;
  unsigned sum, cnt, mine, sp = 0u;
  for (;;) {
    sum = 0u; cnt = 0u; mine = 0u;
#pragma unroll
    for (unsigned j = 0; j < 16; ++j) { const unsigned c = xb_ld(&bar[XB_XCNT(j)]); sum += c; cnt += (c > 0u) ? 1u : 0u; mine = (j == x) ? c : mine; }
    if (sum == G) break;
    __builtin_amdgcn_s_sleep(1);
    if ((++sp & 255u) == 0u) { if (xb_ld(&bar[XB_TMO])) break; if (sp > XB_SPIN_CAP) { atomicAdd(&bar[XB_TMO], 1u); break; } }
  }
  nloc = mine > 0u ? mine : 1u; nx = cnt > 0u ? cnt : 1u;
}
DEVI void xcd_barrier(const XcdBarrier& b) {
  asm volatile("s_waitcnt vmcnt(0)" ::: "memory");
  __syncthreads();
  if (threadIdx.x == 0) {
    unsigned* bar = b.bar;
    __builtin_amdgcn_s_waitcnt(0);
    unsigned nloc = b.st[0], nx = b.st[1];
    if (nloc == 0u) { xcd_barrier_complete(bar, b.x, nloc, nx); b.st[0] = nloc; b.st[1] = nx; }
    const unsigned old = xb_add(&bar[XB_XSUB(b.x)], 1u);
    const unsigned gen = old / nloc;
    if (old + 1u == (gen + 1u) * nloc) {
      __builtin_amdgcn_fence(__ATOMIC_RELEASE, "agent");
      asm volatile("s_waitcnt vmcnt(0)" ::: "memory");
      const unsigned og = xb_add(&bar[XB_TOP], 1u);
      const unsigned tg = og / nx;
      if (og + 1u == (tg + 1u) * nx) xb_add(&bar[XB_TOPGEN], 1u);
      else XB_SPIN(xb_ld(&bar[XB_TOPGEN]) == tg, bar);
      __builtin_amdgcn_fence(__ATOMIC_ACQUIRE, "agent");
      xb_add(&bar[XB_XGEN(b.x)], 1u);
      asm volatile("s_waitcnt vmcnt(0)" ::: "memory");
    } else {
      XB_SPIN(xb_ld(&bar[XB_XGEN(b.x)]) == gen, bar);
      __builtin_amdgcn_fence(__ATOMIC_ACQUIRE, "agent");
      asm volatile("s_waitcnt vmcnt(0)" ::: "memory");
    }
  }
  __syncthreads();
}

namespace pg8 {
#define PG8_LAS __attribute__((address_space(3)))
typedef unsigned short bf16_t;
typedef short bf16x8 __attribute__((ext_vector_type(8)));
typedef float f32x4 __attribute__((ext_vector_type(4)));
typedef unsigned u32x4 __attribute__((ext_vector_type(4)));
constexpr int BM = 256, BK = 64, HALF = 128, HTB = HALF * BK * 2  , STAGE_BYTES = 8 * HTB, NXCD = 8, WGM = 8;

__host__ __device__ __forceinline__ int lds_byte(int r, int c) { const int st = (r >> 4) * 2 + (c >> 5), rr = r & 15, cc = c & 31, ob = rr * 64 + cc * 2; return st * 1024 + (ob ^ (((ob >> 9) & 1) << 5)); }
__host__ __device__ __forceinline__ void stage_rc(int b, int& R, int& C) { const int st = b / 1024, sb = b % 1024, swz = sb ^ (((sb >> 9) & 1) << 5); R = (st >> 1) * 16 + swz / 64; C = (st & 1) * 32 + (swz % 64) / 2; }
__host__ __device__ __forceinline__ int perm32(int rho) { const int n = rho >> 4, i = rho & 15; return 8 * (i >> 2) + 4 * n + (i & 3); }

struct Unit { int pm, pn; };
struct Gemm { const bf16_t* A; const bf16_t* Bt; int M, N, K; };

struct StaticOrder {
    int nM, nN, nwg, G, c;
    __host__ __device__ void init(int M, int N, int G_, int c_) { nM = M / BM; nN = N / BM; nwg = nM * nN; G = G_; c = c_; }
    __host__ __device__ bool next(int i, Unit& u) const {
        const long L = (long)i * G + c; if (L >= nwg) return false;
        int wgid = (int)L; { const int q = nwg / NXCD, r = nwg % NXCD, xcd = wgid % NXCD, off = wgid / NXCD; wgid = (xcd < r ? xcd * (q + 1) : r * (q + 1) + (xcd - r) * q) + off; }
        const int nig = WGM * nN, gid = wgid / nig, fm = gid * WGM, gsz = (nM - fm) < WGM ? (nM - fm) : WGM;
        u.pm = fm + ((wgid % nig) % gsz); u.pn = (wgid % nig) / gsz; return true;
    }
    __device__ __forceinline__ void a_ready(const Unit&) const {}
    __device__ __forceinline__ void done(const Unit&) const {}
};

template <class Epi, class Sched, bool STAMP = false>
__device__ __forceinline__ void gemm_phase(PG8_LAS unsigned char* lds, const Gemm g, const Sched& S, const Epi& E, unsigned long long* stamps) {
    int tid_ = threadIdx.x; asm volatile("" : "+v"(tid_));
    const int tid = tid_, wid = __builtin_amdgcn_readfirstlane(tid >> 6), lane = tid & 63, wr = wid >> 2, wc = wid & 3, fr = lane & 15, fq = lane >> 4;
    const int K = g.K, nt = K / BK;
    int ts_lo = 0, ts_hi = 0, nts = 0; const unsigned long long rt_entry = STAMP ? (unsigned long long)wall_clock64() : 0ull;
#define PG8_STAMP() do { if (STAMP && wid == 0 && nts < 64) { const unsigned long long _c = (unsigned long long)clock64(); \
        ts_lo = (lane == nts) ? (int)(unsigned)_c : ts_lo; ts_hi = (lane == nts) ? (int)(unsigned)(_c >> 32) : ts_hi; ++nts; } } while (0)
    PG8_STAMP();
    unsigned voffA[2], voffB[2];
#pragma unroll
    for (int i = 0; i < 2; ++i) { int R, C; stage_rc(tid * 16 + i * 8192, R, C); const int Rb = Epi::PERM ? ((R & ~31) + perm32(R & 31)) : R;
        voffA[i] = (unsigned)(R * K + C) * 2u; voffB[i] = (unsigned)(Rb * K + C) * 2u; }
    const size_t kstep = (size_t)(BK * 2);
    const size_t hstep = (size_t)HALF * K * 2;
    const size_t tstep = 2 * hstep;
    const unsigned ldsw = (unsigned)wid * 1024u;
    const int aoff = lds_byte(wr * 64 + fr, fq * 8), boff = lds_byte(wc * 32 + fr, fq * 8);
#define PG8_SA(b, h) (((b) * 2 + (h)) * HTB)
#define PG8_SB(b, h) ((4 + (b) * 2 + (h)) * HTB)
#define PG8_STAGE(bufoff, gbase, voff) do { _Pragma("unroll") for (int _i = 0; _i < 2; ++_i) \
        __builtin_amdgcn_global_load_lds((const unsigned*)((const char*)(gbase) + (voff)[_i]), (PG8_LAS unsigned*)(lds + (bufoff) + ldsw + _i * 8192), 16, 0, 0); } while (0)
#define PG8_LDA(dst, b, h) do { _Pragma("unroll") for (int m = 0; m < 4; ++m) _Pragma("unroll") for (int k = 0; k < 2; ++k) dst[m][k] = *(const PG8_LAS bf16x8*)(lds + PG8_SA(b, h) + aoff + m * 2048 + k * 1024); } while (0)
#define PG8_LDB(dst, b, h) do { _Pragma("unroll") for (int n = 0; n < 2; ++n) _Pragma("unroll") for (int k = 0; k < 2; ++k) dst[n][k] = *(const PG8_LAS bf16x8*)(lds + PG8_SB(b, h) + boff + n * 2048 + k * 1024); } while (0)
#define PG8_MMA(ai, bj, At, Bt) do { __builtin_amdgcn_s_setprio(1); _Pragma("unroll") for (int m = 0; m < 4; ++m) _Pragma("unroll") for (int n = 0; n < 2; ++n) _Pragma("unroll") for (int k = 0; k < 2; ++k) \
        acc[ai][bj][m][n] = __builtin_amdgcn_mfma_f32_16x16x32_bf16(Bt[n][k], At[m][k], acc[ai][bj][m][n], 0, 0, 0); __builtin_amdgcn_s_setprio(0); } while (0)
#define PG8_WAIT_V(n) asm volatile("s_waitcnt vmcnt(" #n ")" ::: "memory")
#define PG8_WAIT_L(n) asm volatile("s_waitcnt lgkmcnt(" #n ")" ::: "memory")
#define PG8_BAR __builtin_amdgcn_s_barrier()
#define PG8_SCHED __builtin_amdgcn_sched_barrier(0)
    Unit cur, nxt; int ui = 0;
    if (!S.next(0, cur)) return;
    f32x4 acc[2][2][4][2];
#pragma unroll
    for (int a = 0; a < 2; ++a)
#pragma unroll
        for (int b = 0; b < 2; ++b)
#pragma unroll
            for (int m = 0; m < 4; ++m)
#pragma unroll
                for (int n = 0; n < 2; ++n) acc[a][b][m][n] = (f32x4){0.f, 0.f, 0.f, 0.f};
    bf16x8 At[4][2], B0[2][2], B1[2][2];
    const char* cA = (const char*)g.A + (size_t)cur.pm * tstep; const char* cB = (const char*)g.Bt + (size_t)cur.pn * tstep;
    S.a_ready(cur);
    PG8_STAGE(PG8_SB(0, 0), cB, voffB); PG8_STAGE(PG8_SA(0, 0), cA, voffA); PG8_STAGE(PG8_SB(0, 1), cB + hstep, voffB); PG8_STAGE(PG8_SA(0, 1), cA + hstep, voffA);
    if (wr == 1) PG8_BAR;
    PG8_WAIT_V(4); PG8_BAR;
    PG8_STAGE(PG8_SB(1, 0), cB + kstep, voffB); PG8_STAGE(PG8_SA(1, 0), cA + kstep, voffA); PG8_STAGE(PG8_SB(1, 1), cB + hstep + kstep, voffB);
    PG8_WAIT_V(6); PG8_BAR;
    PG8_STAMP();
    for (;;) {
        const bool has_next = S.next(ui + 1, nxt);
        const char* nA = has_next ? (const char*)g.A + (size_t)nxt.pm * tstep : cA; const char* nB = has_next ? (const char*)g.Bt + (size_t)nxt.pn * tstep : cB;
        for (int t = 0; t < nt; t += 2) {
            const bool last = (t == nt - 2);
            const char* a1 = cA + (size_t)(t + 1) * kstep;
            const char* a2 = last ? nA : cA + (size_t)(t + 2) * kstep; const char* b2 = last ? nB : cB + (size_t)(t + 2) * kstep;
            const char* a3 = a2 + kstep; const char* b3 = b2 + kstep;
            if (last && has_next) S.a_ready(nxt);
            PG8_LDB(B0, 0, 0); PG8_SCHED; PG8_LDA(At, 0, 0); PG8_STAGE(PG8_SA(1, 1), a1 + hstep, voffA);
            PG8_WAIT_L(8); PG8_BAR; PG8_WAIT_L(0); PG8_MMA(0, 0, At, B0); PG8_BAR; PG8_SCHED;
            PG8_LDB(B1, 0, 1); PG8_STAGE(PG8_SB(0, 0), b2, voffB);
            PG8_BAR; PG8_WAIT_L(0); PG8_MMA(0, 1, At, B1); PG8_BAR;
            PG8_LDA(At, 0, 1); PG8_STAGE(PG8_SA(0, 0), a2, voffA);
            PG8_BAR; PG8_WAIT_L(0); PG8_MMA(1, 0, At, B0); PG8_BAR; PG8_SCHED;
            PG8_STAGE(PG8_SB(0, 1), b2 + hstep, voffB);
            PG8_WAIT_V(6); PG8_BAR; PG8_MMA(1, 1, At, B1); PG8_BAR;
            PG8_LDB(B0, 1, 0); PG8_SCHED; PG8_LDA(At, 1, 0); PG8_STAGE(PG8_SA(0, 1), a2 + hstep, voffA);
            PG8_WAIT_L(8); PG8_BAR; PG8_WAIT_L(0); PG8_MMA(0, 0, At, B0); PG8_BAR; PG8_SCHED;
            PG8_LDB(B1, 1, 1); PG8_STAGE(PG8_SB(1, 0), b3, voffB);
            PG8_BAR; PG8_WAIT_L(0); PG8_MMA(0, 1, At, B1); PG8_BAR;
            PG8_LDA(At, 1, 1); PG8_STAGE(PG8_SA(1, 0), a3, voffA);
            PG8_BAR; PG8_WAIT_L(0); PG8_MMA(1, 0, At, B0); PG8_BAR; PG8_SCHED;
            PG8_STAGE(PG8_SB(1, 1), b3 + hstep, voffB);
            PG8_WAIT_V(6); PG8_BAR; PG8_MMA(1, 1, At, B1); PG8_BAR;
        }
        PG8_STAMP();
        if constexpr (!Epi::AFTER_DRAIN) { E(acc, cur, wr, wc, fr, fq); S.done(cur); }
        PG8_STAMP();
        if (!has_next) break;
#pragma unroll
        for (int a = 0; a < 2; ++a)
#pragma unroll
            for (int b = 0; b < 2; ++b)
#pragma unroll
                for (int m = 0; m < 4; ++m)
#pragma unroll
                    for (int n = 0; n < 2; ++n) acc[a][b][m][n] = (f32x4){0.f, 0.f, 0.f, 0.f};
        cur = nxt; cA = nA; cB = nB; ++ui;
    }
    PG8_WAIT_V(0);
    if (wr == 0) PG8_BAR;
    PG8_BAR;
    if constexpr (Epi::AFTER_DRAIN) { E.fused(acc, cur, wr, wc, fr, fq, lds, wid, lane); S.done(cur); }
    PG8_STAMP();
    if (STAMP && wid == 0) { stamps[lane] = lane < nts ? (((unsigned long long)(unsigned)ts_hi << 32) | (unsigned)ts_lo) : 0ull;
        if (lane == 62) stamps[62] = rt_entry; if (lane == 63) stamps[63] = (unsigned long long)wall_clock64(); }
#undef PG8_STAMP
#undef PG8_SA
#undef PG8_SB
#undef PG8_STAGE
#undef PG8_LDA
#undef PG8_LDB
#undef PG8_MMA
#undef PG8_WAIT_V
#undef PG8_WAIT_L
#undef PG8_BAR
#undef PG8_SCHED
}
}


#define PG_EPI_ROWS(ROWBODY)                                                                     \
  _Pragma("unroll") for (int ai = 0; ai < 2; ++ai) _Pragma("unroll") for (int m = 0; m < 4; ++m) { \
    int row = u.pm * 256 + ai * 128 + wr * 64 + m * 16 + fr;                                      \
    asm volatile("" : "+v"(row));                                                                 \
    ROWBODY                                                                                       \
    asm volatile("" ::: "memory"); }
#define PG_EPI_COLS(COLBODY)                                                                      \
  _Pragma("unroll") for (int bj = 0; bj < 2; ++bj) _Pragma("unroll") for (int n = 0; n < 2; ++n) { \
    const int col = u.pn * 256 + bj * 128 + wc * 32 + 8 * fq + 4 * n;                             \
    const f32x4 v = acc[ai][bj][m][n];                                                            \
    COLBODY }
typedef const f32x4 (&PgAcc)[2][2][4][2];
#define PG_ROW_OF(r) (u.pm * 256 + ((r) >> 2) * 128 + wr * 64 + ((r) & 3) * 16 + fr)
#define PG_EPI_PIPELINED(LOADS, USE)                                                            \
  {                                                                                             \
    const int colb = u.pn * 256 + wc * 32 + 8 * fq;                                             \
    int row = PG_ROW_OF(0);                                                                     \
    asm volatile("" : "+v"(row));                                                               \
    { const int lrow = row; _Pragma("unroll") for (int c = 0; c < 4; ++c) { const int slot = 0; const unsigned off = (unsigned)(lrow * DM + colb + (c >> 1) * 128 + (c & 1) * 4); LOADS } } \
    _Pragma("unroll") for (int r = 0; r < 8; ++r) {                                             \
      int rown = PG_ROW_OF((r + 1) & 7);                                                        \
      asm volatile("" : "+v"(rown));                                                            \
      if (r < 7) { const int lrow = rown; _Pragma("unroll") for (int c = 0; c < 4; ++c) { const int slot = (r + 1) & 1; const unsigned off = (unsigned)(lrow * DM + colb + (c >> 1) * 128 + (c & 1) * 4); LOADS } } \
      _Pragma("unroll") for (int c = 0; c < 4; ++c) {                                           \
        const int slot = r & 1;                                                                 \
        const unsigned off = (unsigned)(row * DM + colb + (c >> 1) * 128 + (c & 1) * 4);       \
        const f32x4 v = acc[r >> 2][c >> 1][r & 3][c & 1];                                      \
        USE }                                                                                   \
      asm volatile("" ::: "memory");                                                            \
      row = rown;                                                                               \
    }                                                                                           \
  }
DEVI bf16x4 to_bf4(f32x4 v) { bf16x4 o; o[0] = (bf16)v.x; o[1] = (bf16)v.y; o[2] = (bf16)v.z; o[3] = (bf16)v.w; return o; }
template <class Epi> DEVI void run_gemm(unsigned char* smem, const bf16* A, const bf16* Bt, int M, int N, int K, const Epi& E) {
  pg8::Gemm g; g.A = (const pg8::bf16_t*)A; g.Bt = (const pg8::bf16_t*)Bt; g.M = M; g.N = N; g.K = K;
  pg8::StaticOrder S; S.init(M, N, (int)gridDim.x, (int)blockIdx.x);
  pg8::gemm_phase<Epi, pg8::StaticOrder, false>((PG8_LAS unsigned char*)smem, g, S, E, nullptr);
}

template <int MTILES, int NTILES, int R>
DEVI bool tile_map(int it, int& mt, int& nt) {
  const int xcd = blockIdx.x & 7, slot = blockIdx.x >> 3, nslots = gridDim.x >> 3;
  const int L = it * nslots + slot;
  if (L >= (MTILES / 8) * NTILES) return false;
  const int group = L / (R * NTILES), rem = L % (R * NTILES);
  nt = rem / R;
  mt = (group * R + (rem % R)) * 8 + xcd;
  return true;
}

DEVI void transpose_job(const float* __restrict__ src, int ld, int n0, int nvalid, int npad, int K, bf16* __restrict__ dst, float* smf, const float* __restrict__ kscale = nullptr) {
  const int vb = threadIdx.x >> 8, tid = threadIdx.x & 255;
  float* sm = smf + vb * (64 * 65);
  const int ktiles = K >> 6, ntiles = (npad >> 6) * ktiles;
  const int ty = tid >> 4, tx = tid & 15;
  for (int base = blockIdx.x * 2; base < ntiles; base += gridDim.x * 2) {
    const int tile = base + vb;
    const bool ok = tile < ntiles;
    const int nb = (tile / ktiles) << 6, kb = (tile % ktiles) << 6;
    if (ok) {
#pragma unroll
      for (int i = 0; i < 4; ++i) {
        const int k = kb + ty + 16 * i, n = nb + tx * 4;
        f32x4 v = mk_f4(0.f, 0.f, 0.f, 0.f);
        if (n < nvalid) v = *(const f32x4*)(src + (size_t)k * ld + n0 + n);
        if (kscale) v = v * kscale[k];
        float* q = sm + (ty + 16 * i) * 65 + tx * 4;
        q[0] = v.x; q[1] = v.y; q[2] = v.z; q[3] = v.w;
      }
    }
    __syncthreads();
    if (ok) {
      const int n = tid >> 2, kq = tid & 3;
      bf16x8 o0, o1;
#pragma unroll
      for (int j = 0; j < 8; ++j) {
        o0[j] = (bf16)sm[(kq * 16 + j) * 65 + n];
        o1[j] = (bf16)sm[(kq * 16 + 8 + j) * 65 + n];
      }
      bf16* d = dst + (size_t)(nb + n) * K + kb + kq * 16;
      *(bf16x8*)d = o0;
      *(bf16x8*)(d + 8) = o1;
    }
    __syncthreads();
  }
}

DEVI void convert_job(const float* __restrict__ src, bf16* __restrict__ dst, size_t n) {
  const size_t n4 = n >> 2;
  for (size_t i = (size_t)blockIdx.x * NTHREADS + threadIdx.x; i < n4; i += (size_t)gridDim.x * NTHREADS) {
    const f32x4 v = ((const f32x4*)src)[i];
    bf16x4 o; o[0] = (bf16)v.x; o[1] = (bf16)v.y; o[2] = (bf16)v.z; o[3] = (bf16)v.w;
    ((bf16x4*)dst)[i] = o;
  }
}


DEVI void fp4_rows_job(const float* __restrict__ src, unsigned char* __restrict__ dst, float* __restrict__ inv, const float* __restrict__ cscale = nullptr) {
  const int lane = threadIdx.x & 63;
  const int gw = blockIdx.x * NWAVES + (threadIdx.x >> 6), nw = gridDim.x * NWAVES;
  for (int r = gw; r < 16384; r += nw) {
    const float* sp = src + (size_t)r * 1024 + lane * 16;
    f32x4 v[4];
    float mx = 0.f;
#pragma unroll
    for (int i = 0; i < 4; ++i) {
      v[i] = *(const f32x4*)(sp + i * 4);
      if (cscale) v[i] = v[i] * *(const f32x4*)(cscale + lane * 16 + i * 4);
      mx = fmaxf(mx, fmaxf(fmaxf(fabsf(v[i].x), fabsf(v[i].y)), fmaxf(fabsf(v[i].z), fabsf(v[i].w))));
    }
#pragma unroll
    for (int o = 32; o > 0; o >>= 1) mx = fmaxf(mx, __shfl_xor(mx, o, 64));
    const float sc = (mx > 0.f) ? 6.f / mx : 1.f;
    u32x2 o2;
#pragma unroll
    for (int d = 0; d < 2; ++d) {
      unsigned w = 0u;
      w = __builtin_amdgcn_cvt_scalef32_pk_fp4_f32(w, v[2 * d].x * sc, v[2 * d].y * sc, 1.0f, 0);
      w = __builtin_amdgcn_cvt_scalef32_pk_fp4_f32(w, v[2 * d].z * sc, v[2 * d].w * sc, 1.0f, 1);
      w = __builtin_amdgcn_cvt_scalef32_pk_fp4_f32(w, v[2 * d + 1].x * sc, v[2 * d + 1].y * sc, 1.0f, 2);
      w = __builtin_amdgcn_cvt_scalef32_pk_fp4_f32(w, v[2 * d + 1].z * sc, v[2 * d + 1].w * sc, 1.0f, 3);
      o2[d] = w;
    }
    *(u32x2*)(dst + (size_t)r * 512 + lane * 8) = o2;
    if (lane == 0) inv[r] = 1.f / sc;
  }
}

DEVI void rmsnorm_rows_bf16(const float* src, const float* __restrict__ gain, bf16* __restrict__ dst) {
  const int lane = threadIdx.x & 63;
  const int gw = blockIdx.x * NWAVES + (threadIdx.x >> 6), nw = gridDim.x * NWAVES;
  f32x4 gn[4];
#pragma unroll
  for (int i = 0; i < 4; ++i) gn[i] = *(const f32x4*)(gain + i * 256 + lane * 4);
  for (int t = gw; t < T_TOK; t += nw) {
    const float* xr = src + (size_t)t * DM;
    f32x4 v[4];
    float ss = 0.f;
#pragma unroll
    for (int i = 0; i < 4; ++i) {
      v[i] = *(const f32x4*)(xr + i * 256 + lane * 4);
      ss += v[i].x * v[i].x + v[i].y * v[i].y + v[i].z * v[i].z + v[i].w * v[i].w;
    }
    ss = wave_sum(ss);
    const float rs = rsqrtf(ss * (1.f / DM) + 1e-6f);
#pragma unroll
    for (int i = 0; i < 4; ++i) {
      bf16x4 o;
      o[0] = (bf16)(v[i].x * rs * gn[i].x); o[1] = (bf16)(v[i].y * rs * gn[i].y);
      o[2] = (bf16)(v[i].z * rs * gn[i].z); o[3] = (bf16)(v[i].w * rs * gn[i].w);
      *(bf16x4*)(dst + (size_t)t * DM + i * 256 + lane * 4) = o;
    }
  }
}

DEVI void rmsnorm_rows_bf16_from_bf16(const bf16* __restrict__ src, const float* __restrict__ gain, bf16* __restrict__ dst) {
  const int lane = threadIdx.x & 63;
  const int gw = blockIdx.x * NWAVES + (threadIdx.x >> 6), nw = gridDim.x * NWAVES;
  f32x4 gn[4];
#pragma unroll
  for (int i = 0; i < 4; ++i) gn[i] = *(const f32x4*)(gain + i * 256 + lane * 4);
  for (int t = gw; t < T_TOK; t += nw) {
    const bf16* xr = src + (size_t)t * DM;
    bf16x4 v[4];
    float ss = 0.f;
#pragma unroll
    for (int i = 0; i < 4; ++i) {
      v[i] = *(const bf16x4*)(xr + i * 256 + lane * 4);
#pragma unroll
      for (int j = 0; j < 4; ++j) ss += (float)v[i][j] * (float)v[i][j];
    }
    ss = wave_sum(ss);
    const float rs = rsqrtf(ss * (1.f / DM) + 1e-6f);
#pragma unroll
    for (int i = 0; i < 4; ++i) {
      bf16x4 o;
      o[0] = (bf16)((float)v[i][0] * rs * gn[i].x); o[1] = (bf16)((float)v[i][1] * rs * gn[i].y);
      o[2] = (bf16)((float)v[i][2] * rs * gn[i].z); o[3] = (bf16)((float)v[i][3] * rs * gn[i].w);
      *(bf16x4*)(dst + (size_t)t * DM + i * 256 + lane * 4) = o;
    }
  }
}

DEVI void phase0(const ParamsG& p, unsigned char* smem) {
  unsigned char* ws = gp(p.ws);
  float* smf = (float*)smem;
#define TJOB(SRC, LD, N0, NVALID, NPAD, KK, OFF) transpose_job((SRC), (LD), (N0), (NVALID), (NPAD), (KK), (bf16*)(ws + (OFF)), smf);
  TJOB(gp(p.w_in), IN_COLS, 0, 2464, 2560, 1024, OFF_WIN_T)
  TJOB(gp(p.w_in), IN_COLS, 2464, 2048, 2048, 1024, OFF_WG_T)
  TJOB(gp(p.rw_w_o), 1024, 0, 1024, 1024, 512, OFF_RWO_T)
  TJOB(gp(p.mla_w_o), 1024, 0, 1024, 1024, 512, OFF_MLO_T)
  TJOB(gp(p.mla_w_uq), 768, 0, 768, 768, 384, OFF_WUQ_T)
  TJOB(gp(p.mla_w_ukv), 1024, 0, 1024, 1024, 256, OFF_WUKV_T)
  TJOB(gp(p.w_out), 1024, 0, 1024, 1024, 1024, OFF_WOUT_T)
  transpose_job(gp(p.peer_w_q), 2048, 0, 2048, 2048, 1024, (bf16*)(ws + OFF_WQ_T), smf, gp(p.norm_ffn));
  TJOB(gp(p.ple_w_gate), 1024, 0, 1024, 1024, 1024, OFF_PG_T)
  TJOB(gp(p.ple_w_proj), 1024, 0, 1024, 1024, 256, OFF_PP_T)
#undef TJOB
  {
    bf16* wl = (bf16*)(ws + OFF_WLORA_T);
    for (int i = blockIdx.x * NTHREADS + threadIdx.x; i < 1536 * 256; i += gridDim.x * NTHREADS) {
      const int n = i >> 8, k = i & 255;
      float v = 0.f;
      if (n < 512) { if (k < 64) v = gp(p.rw_w2)[k * 512 + n]; }
      else if (n < 1024) { if (k >= 64 && k < 128) v = gp(p.rw_a2)[(k - 64) * 512 + (n - 512)]; }
      else { if (k >= 128) v = gp(p.rw_g2)[(k - 128) * 512 + (n - 1024)]; }
      wl[i] = (bf16)v;
    }
  }
  convert_job(gp(p.peer_sub_keys), (bf16*)(ws + OFF_SK), (size_t)8 * 2 * 128 * 128);
  fp4_rows_job(gp(p.peer_u), ws + OFF_U8, (float*)(ws + OFF_IUS), gp(p.norm_ffn));
  fp4_rows_job(gp(p.peer_v), ws + OFF_V8, (float*)(ws + OFF_IVS));
  convert_job(gp(p.p), (bf16*)(ws + OFF_PBF), (size_t)T_TOK * 256);
  rmsnorm_rows_bf16(gp(p.x), gp(p.norm_mix), (bf16*)(ws + OFF_H1));
  {
    float* cs = (float*)(ws + OFF_CS);
    float* sn = (float*)(ws + OFF_SN);
    for (int i = blockIdx.x * NTHREADS + threadIdx.x; i < T_TOK * 16; i += gridDim.x * NTHREADS) {
      const int t = i >> 4, f = i & 15;
      const float inv = powf(10000.f, -(float)(2 * f) / 32.f);
      const float ang = (float)gp(p.pos)[t] * inv;
      double s, c;
      sincos((double)ang, &s, &c);
      cs[i] = (float)c; sn[i] = (float)s;
    }
  }
  if (blockIdx.x == 0 && threadIdx.x < 64) ((unsigned*)(ws + OFF_CNT))[threadIdx.x] = 0u;
  if (blockIdx.x == 0) for (int i = threadIdx.x; i < XCD_BAR_WORDS; i += NTHREADS) ((unsigned*)(ws + OFF_BAR))[i] = 0u;
}

struct EpiZ {
  static constexpr bool PERM = true, AFTER_DRAIN = false;
  bf16* zrw; bf16* zmla;
  DEVI void operator()(PgAcc acc, const pg8::Unit& u, int wr, int wc, int fr, int fq) const {
    PG_EPI_ROWS(PG_EPI_COLS(
      if (col < RWC) *(bf16x4*)(zrw + (unsigned)(row * RWC + col)) = to_bf4(v);
      else if (col < RWC + MLC) *(bf16x4*)(zmla + (unsigned)(row * MLC + (col - RWC))) = to_bf4(v);
    ))
  }
};
DEVI void phase1(const ParamsG& p, unsigned char* smem) {
  EpiZ e; e.zrw = (bf16*)(gp(p.ws) + OFF_ZRW); e.zmla = (bf16*)(gp(p.ws) + OFF_ZMLA);
  run_gemm(smem, (const bf16*)(gp(p.ws) + OFF_H1), (const bf16*)(gp(p.ws) + OFF_WIN_T), T_TOK, 2560, DM, e);
}

DEVI void phase2a(const ParamsG& p) {
  const int lane = threadIdx.x & 63;
  const int gw = blockIdx.x * NWAVES + (threadIdx.x >> 6), nw = gridDim.x * NWAVES;
  const bf16* zrw = (const bf16*)(gp(p.ws) + OFF_ZRW);
  const bf16* zmla = (const bf16*)(gp(p.ws) + OFF_ZMLA);
  bf16* lora = (bf16*)(gp(p.ws) + OFF_LORA);
  bf16* cq = (bf16*)(gp(p.ws) + OFF_CQ);
  bf16* ckv = (bf16*)(gp(p.ws) + OFF_CKV);
  bf16* Kd = (bf16*)((unsigned char*)gp(p.out) + OFF_K);
  const float* cs = (const float*)(gp(p.ws) + OFF_CS);
  const float* sn = (const float*)(gp(p.ws) + OFF_SN);
  const f32x4 mu = *(const f32x4*)(gp(p.rw_mu) + 1536 + lane * 4);
  const f32x4 qg0 = *(const f32x4*)(gp(p.mla_q_norm) + lane * 4);
  const f32x2 qg1 = *(const f32x2*)(gp(p.mla_q_norm) + 256 + lane * 2);
  const f32x4 kg = *(const f32x4*)(gp(p.mla_kv_norm) + lane * 4);
  const float mua[4] = {mu.x, mu.y, mu.z, mu.w};
  for (int t = gw; t < T_TOK; t += nw) {
    const int s = t & (SEQ - 1), b = t >> 12;
    {
      const bf16* zp = zrw + (size_t)t * RWC + 1536 + lane * 4;
      const bf16x4 zc = *(const bf16x4*)zp;
      bf16x4 zv;
      if (s > 0) zv = *(const bf16x4*)(zp - RWC);
      else { zv[0] = (bf16)0.f; zv[1] = (bf16)0.f; zv[2] = (bf16)0.f; zv[3] = (bf16)0.f; }
      bf16x4 o;
#pragma unroll
      for (int j = 0; j < 4; ++j) {
        const float c = (float)zc[j], pv = (float)zv[j];
        const float zs = c + mua[j] * (pv - c);
        float val;
        if (lane < 16) val = tanhf(zs);
        else if (lane < 32) val = zs;
        else val = sigmoid_f(zs);
        o[j] = (bf16)val;
      }
      *(bf16x4*)(lora + (size_t)t * 256 + lane * 4) = o;
    }
    {
      const bf16* zq = zmla + (size_t)t * MLC;
      const bf16x4 q0 = *(const bf16x4*)(zq + lane * 4);
      const bf16x2 q1 = *(const bf16x2*)(zq + 256 + lane * 2);
      float f[6] = {(float)q0[0], (float)q0[1], (float)q0[2], (float)q0[3], (float)q1[0], (float)q1[1]};
      float ss = 0.f;
#pragma unroll
      for (int j = 0; j < 6; ++j) ss += f[j] * f[j];
      ss = wave_sum(ss);
      const float rs = rsqrtf(ss * (1.f / 384.f) + 1e-6f);
      bf16x4 o0; bf16x2 o1;
      o0[0] = (bf16)(f[0] * rs * qg0.x); o0[1] = (bf16)(f[1] * rs * qg0.y);
      o0[2] = (bf16)(f[2] * rs * qg0.z); o0[3] = (bf16)(f[3] * rs * qg0.w);
      o1[0] = (bf16)(f[4] * rs * qg1.x); o1[1] = (bf16)(f[5] * rs * qg1.y);
      *(bf16x4*)(cq + (size_t)t * 384 + lane * 4) = o0;
      *(bf16x2*)(cq + (size_t)t * 384 + 256 + lane * 2) = o1;
    }
    {
      const bf16x4 k0 = *(const bf16x4*)(zmla + (size_t)t * MLC + 384 + lane * 4);
      float f[4] = {(float)k0[0], (float)k0[1], (float)k0[2], (float)k0[3]};
      float ss = f[0] * f[0] + f[1] * f[1] + f[2] * f[2] + f[3] * f[3];
      ss = wave_sum(ss);
      const float rs = rsqrtf(ss * (1.f / 256.f) + 1e-6f);
      bf16x4 o;
      o[0] = (bf16)(f[0] * rs * kg.x); o[1] = (bf16)(f[1] * rs * kg.y);
      o[2] = (bf16)(f[2] * rs * kg.z); o[3] = (bf16)(f[3] * rs * kg.w);
      *(bf16x4*)(ckv + (size_t)t * 256 + lane * 4) = o;
    }
    {
      const float xr = (float)zmla[(size_t)t * MLC + 640 + (lane & 31)];
      const float xp = __shfl_xor(xr, 16, 64);
      const int f = lane & 15;
      const float c = cs[t * 16 + f], sv = sn[t * 16 + f];
      const float o = (lane & 16) ? (xr * c + xp * sv) : (xr * c - xp * sv);
      if (lane < 32) {
        const bf16 ob = (bf16)o;
#pragma unroll
        for (int h = 0; h < 8; ++h) Kd[((size_t)(b * 8 + h) * SEQ + s) * 96 + 64 + lane] = ob;
      }
    }
  }
}

constexpr float QSCALE = 0.14724444f;
template <bool SSQ = false>
DEVI void route_mainloop(f32x16 (&acc)[4], const bf16* __restrict__ A, int lda, const bf16* __restrict__ B, int ldb, int nk, unsigned char* base,
                         const bf16* __restrict__ sk = nullptr, float* ssq = nullptr) {
  const int tid = threadIdx.x, lane = tid & 63, w = tid >> 6;
  unsigned ao[2], bo[4];
#pragma unroll
  for (int i = 0; i < 2; ++i) { const int r = (w + 8 * i) * 8 + (lane >> 3); ao[i] = (unsigned)(r * lda + (((lane & 7) ^ ((r >> 1) & 7)) * 8)) * 2u; }
#pragma unroll
  for (int i = 0; i < 4; ++i) { const int r = (w + 8 * i) * 8 + (lane >> 3); bo[i] = (unsigned)(r * ldb + (((lane & 7) ^ ((r >> 1) & 7)) * 8)) * 2u; }
  const int sw = (lane >> 1) & 7, hh = lane >> 5;
  const int arow = (lane & 31) * 128, brow = (w * 32 + (lane & 31)) * 128;
  auto issue = [&](int kt, int slot) {
    unsigned char* nb = base + slot * 49152;
#pragma unroll
    for (int i = 0; i < 2; ++i)
      __builtin_amdgcn_global_load_lds((const unsigned*)((const char*)A + (ao[i] + (unsigned)kt * 128u)), (__attribute__((address_space(3))) unsigned*)(nb + (w + 8 * i) * 1024), 16, 0, 0);
#pragma unroll
    for (int i = 0; i < 4; ++i)
      __builtin_amdgcn_global_load_lds((const unsigned*)((const char*)B + (bo[i] + (unsigned)kt * 128u)), (__attribute__((address_space(3))) unsigned*)(nb + 16384 + (w + 8 * i) * 1024), 16, 0, 0);
  };
  float ss0 = 0.f, ss1 = 0.f;
  __syncthreads();
  issue(0, 0);
  issue(1, 1);
  int cur = 0;
  for (int kt = 0; kt < nk; ++kt) {
    if (kt + 1 < nk) asm volatile("s_waitcnt vmcnt(6)" ::: "memory");
    else if (sk) asm volatile("s_waitcnt vmcnt(4)" ::: "memory");
    else asm volatile("s_waitcnt vmcnt(0)" ::: "memory");
    __syncthreads();
    int nx2 = cur + 2; if (nx2 >= 3) nx2 -= 3;
    if (kt + 2 < nk) issue(kt + 2, nx2);
    else if (kt + 2 == nk && sk) {
#pragma unroll
      for (int i = 0; i < 4; ++i) {
        const int r = (w * 4 + i) * 4 + (lane >> 4);
        const int ch = (lane & 15) ^ (r & 15);
        __builtin_amdgcn_global_load_lds((const unsigned*)((const char*)sk + (unsigned)(r * 128 + ch * 8) * 2u), (__attribute__((address_space(3))) unsigned*)(base + nx2 * 49152 + (w * 4 + i) * 1024), 16, 0, 0);
      }
    }
    const unsigned char* cb = base + cur * 49152;
    cur = (cur == 2) ? 0 : cur + 1;
#pragma unroll
    for (int ks = 0; ks < 4; ++ks) {
      const int co = ((ks * 2 + hh) ^ sw) * 16;
      const bf16x8 bfr = *(const bf16x8*)(cb + 16384 + brow + co);
      if (SSQ) {
        const u32x4 bu = __builtin_bit_cast(u32x4, bfr);
        ss0 = dot2bf(bu.x, bu.x, ss0); ss1 = dot2bf(bu.y, bu.y, ss1);
        ss0 = dot2bf(bu.z, bu.z, ss0); ss1 = dot2bf(bu.w, bu.w, ss1);
      }
#pragma unroll
      for (int mt = 0; mt < 4; ++mt) {
        const bf16x8 af = *(const bf16x8*)(cb + arow + mt * 4096 + co);
        acc[mt] = __builtin_amdgcn_mfma_f32_32x32x16_bf16(af, bfr, acc[mt], 0, 0, 0);
      }
    }
  }
  if (SSQ) *ssq = ss0 + ss1;
  if (sk) { asm volatile("s_waitcnt vmcnt(0)" ::: "memory"); __syncthreads(); }
}
DEVI void phase2b(const ParamsG& p, unsigned char* smem) {
  unsigned char* ws = gp(p.ws);
  const bf16* LORA = (const bf16*)(ws + OFF_LORA);
  const bf16* CQ = (const bf16*)(ws + OFF_CQ);
  const bf16* CKV = (const bf16*)(ws + OFF_CKV);
  bf16* E = (bf16*)(ws + OFF_E);
  bf16* ICLR = (bf16*)(ws + OFF_ICLR);
  bf16* G = (bf16*)(ws + OFF_G);
  bf16* Qd = (bf16*)((unsigned char*)gp(p.out) + OFF_Q);
  bf16* Kd = (bf16*)((unsigned char*)gp(p.out) + OFF_K);
  bf16* Vd = (bf16*)((unsigned char*)gp(p.out) + OFF_VT);
  const int lane = threadIdx.x & 63, w = threadIdx.x >> 6, hh = lane >> 5;
  for (int it = 0;; ++it) {
    int tm, j;
    if (!tile_map<128, 26, 2>(it, tm, j)) break;
    const int m0 = tm * 256;
    const bf16* A; const bf16* Bm; int K, kind, n0;
    if (j < 12) { kind = 0; n0 = j * 128; K = 256; A = (const bf16*)(ws + OFF_WLORA_T) + (size_t)n0 * 256; Bm = LORA + (size_t)m0 * 256; }
    else if (j < 18) { kind = 1; n0 = (j - 12) * 128; K = 384; A = (const bf16*)(ws + OFF_WUQ_T) + (size_t)n0 * 384; Bm = CQ + (size_t)m0 * 384; }
    else { kind = 2; n0 = (j - 18) * 128; K = 256; A = (const bf16*)(ws + OFF_WUKV_T) + (size_t)n0 * 256; Bm = CKV + (size_t)m0 * 256; }
    f32x16 acc[4];
#pragma unroll
    for (int mt = 0; mt < 4; ++mt)
#pragma unroll
      for (int r = 0; r < 16; ++r) acc[mt][r] = 0.f;
    route_mainloop(acc, A, K, Bm, K, K >> 6, smem);
    {
      bf16* wb = (bf16*)(smem + w * 8704);
      __syncthreads();
#pragma unroll
      for (int mt = 0; mt < 4; ++mt)
#pragma unroll
        for (int rg = 0; rg < 4; ++rg) {
          f32x4 v; v.x = acc[mt][4 * rg + 0]; v.y = acc[mt][4 * rg + 1]; v.z = acc[mt][4 * rg + 2]; v.w = acc[mt][4 * rg + 3];
          if (kind == 1) v = v * QSCALE;
          *(bf16x4*)(wb + (lane & 31) * 136 + mt * 32 + 8 * rg + 4 * hh) = to_bf4(v);
        }
      __builtin_amdgcn_fence(__ATOMIC_RELEASE, "wavefront");
#pragma unroll
      for (int ps = 0; ps < 8; ++ps) {
        const int tl = ps * 4 + (lane >> 4), f0 = (lane & 15) * 8;
        const u32x4 v = *(const u32x4*)(wb + tl * 136 + f0);
        const size_t tok = (size_t)m0 + w * 32 + tl;
        const size_t bb = tok >> 12, ss = tok & (SEQ - 1);
        if (kind == 0) {
          bf16* D = (n0 < 512) ? E : ((n0 < 1024) ? ICLR : G);
          *(u32x4*)(D + tok * 512 + (n0 & 511) + f0) = v;
        } else if (kind == 1) {
          const int f = n0 + f0, head = f / 96, d = f - head * 96;
          *(u32x4*)(Qd + ((bb * 8 + head) * SEQ + ss) * 96 + d) = v;
        } else {
          const int head = n0 >> 7;
          if (f0 < 64) *(u32x4*)(Kd + ((bb * 8 + head) * SEQ + ss) * 96 + f0) = v;
          else *(u32x4*)(Vd + ((bb * 8 + head) * SEQ + ss) * 64 + (f0 - 64)) = v;
        }
      }
    }
  }
}

struct ScanBuf { float A[16][64], B[16][64], W[16][64], K2[16][64], R[16][64]; float V[16][16]; };
DEVI void phase3a(const ParamsG& p, unsigned char* smem) {
  ScanBuf* sb = (ScanBuf*)smem;
  const bf16* zrw = (const bf16*)(gp(p.ws) + OFF_ZRW);
  const bf16* E = (const bf16*)(gp(p.ws) + OFF_E);
  const bf16* ICLR = (const bf16*)(gp(p.ws) + OFF_ICLR);
  bf16* YRAW = (bf16*)(gp(p.ws) + OFF_YRAW);
  float* RK = (float*)(gp(p.ws) + OFF_RK);
  const int role = threadIdx.x >> 8;
  const int tid = threadIdx.x & 255, lane = tid & 63, w = tid >> 6;
  const int pi = tid >> 4, kq = tid & 15;
  const int rloc = 4 * w + (lane >> 4), kg = lane & 15;
  if (role == 0) __builtin_amdgcn_s_setprio(3);
  for (int item = blockIdx.x; item < 256; item += gridDim.x) {
    const int bh = item >> 2, quarter = item & 3, b = bh >> 3, h = bh & 7;
    const int c0 = h * 64 + 4 * kq;
    if (role == 1) {
      const f32x4 mur = *(const f32x4*)(gp(p.rw_mu) + c0);
      const f32x4 muk = *(const f32x4*)(gp(p.rw_mu) + 512 + c0);
      const f32x4 muv = *(const f32x4*)(gp(p.rw_mu) + 1024 + c0);
      const f32x4 kkw = *(const f32x4*)(gp(p.rw_k_k) + c0);
      const f32x4 kaw = *(const f32x4*)(gp(p.rw_k_a) + c0);
      const f32x4 rkw = *(const f32x4*)(gp(p.rw_r_k) + c0);
      const f32x4 w0v = *(const f32x4*)(gp(p.rw_w0) + c0);
      const f32x4 a0v = *(const f32x4*)(gp(p.rw_a0) + c0);
      const float w0_[4] = {w0v.x, w0v.y, w0v.z, w0v.w}, a0_[4] = {a0v.x, a0v.y, a0v.z, a0v.w};
      const float mur_[4] = {mur.x, mur.y, mur.z, mur.w}, muk_[4] = {muk.x, muk.y, muk.z, muk.w},
                  muv_[4] = {muv.x, muv.y, muv.z, muv.w}, kkw_[4] = {kkw.x, kkw.y, kkw.z, kkw.w},
                  kaw_[4] = {kaw.x, kaw.y, kaw.z, kaw.w}, rkw_[4] = {rkw.x, rkw.y, rkw.z, rkw.w};
      bf16x4 zr, zk, zv, pr, pk, pv, ic;
      f32x4 ee;
      auto load_raw = [&](int c) {
        const int s = c * 16 + pi;
        const size_t t = (size_t)b * SEQ + s;
        const bf16* zp = zrw + t * RWC + c0;
        zr = *(const bf16x4*)zp; zk = *(const bf16x4*)(zp + 512); zv = *(const bf16x4*)(zp + 1024);
        if (s > 0) {
          pr = *(const bf16x4*)(zp - RWC); pk = *(const bf16x4*)(zp - RWC + 512); pv = *(const bf16x4*)(zp - RWC + 1024);
        } else {
#pragma unroll
          for (int j = 0; j < 4; ++j) { pr[j] = (bf16)0.f; pk[j] = (bf16)0.f; pv[j] = (bf16)0.f; }
        }
        { const bf16x4 e4 = *(const bf16x4*)(E + t * 512 + c0); ee = mk_f4((float)e4[0], (float)e4[1], (float)e4[2], (float)e4[3]); }
        ic = *(const bf16x4*)(ICLR + t * 512 + c0);
      };
      auto prep = [&](int c) {
        ScanBuf& bf = sb[c & 1];
        const float ee_[4] = {ee.x, ee.y, ee.z, ee.w};
        float r[4], k[4], v[4], kx[4], icl[4];
        float n2 = 0.f;
#pragma unroll
        for (int j = 0; j < 4; ++j) {
          const float zrj = (float)zr[j], zkj = (float)zk[j], zvj = (float)zv[j];
          r[j] = zrj + mur_[j] * ((float)pr[j] - zrj);
          k[j] = zkj + muk_[j] * ((float)pk[j] - zkj);
          v[j] = zvj + muv_[j] * ((float)pv[j] - zvj);
          kx[j] = k[j] * kkw_[j];
          n2 += kx[j] * kx[j];
          icl[j] = sigmoid_f(a0_[j] + (float)ic[j]);
        }
        n2 = row16_allsum(n2);
        const float inv = 1.f / fmaxf(sqrtf(n2), 1e-12f);
        float av[4], bv[4], wv[4], k2[4];
        float rkp = 0.f;
#pragma unroll
        for (int j = 0; j < 4; ++j) {
          const float kkn = kx[j] * inv;
          k2[j] = k[j] * (1.f + (icl[j] - 1.f) * kaw_[j]);
          av[j] = -kkn;
          bv[j] = kkn * icl[j];
          wv[j] = __expf(-0.60653066f * sigmoid_f(w0_[j] + ee_[j]));
          rkp += r[j] * k2[j] * rkw_[j];
        }
        rkp = row16_allsum(rkp);
        *(f32x4*)&bf.A[pi][4 * kq] = mk_f4(av[0], av[1], av[2], av[3]);
        *(f32x4*)&bf.B[pi][4 * kq] = mk_f4(bv[0], bv[1], bv[2], bv[3]);
        *(f32x4*)&bf.W[pi][4 * kq] = mk_f4(wv[0], wv[1], wv[2], wv[3]);
        *(f32x4*)&bf.K2[pi][4 * kq] = mk_f4(k2[0], k2[1], k2[2], k2[3]);
        *(f32x4*)&bf.R[pi][4 * kq] = mk_f4(r[0], r[1], r[2], r[3]);
        if ((kq >> 2) == quarter) *(f32x4*)&bf.V[pi][(kq & 3) * 4] = mk_f4(v[0], v[1], v[2], v[3]);
        if (quarter == 0 && kq == 0) RK[((size_t)b * SEQ + c * 16 + pi) * 8 + h] = rkp;
      };
      load_raw(0);
      prep(0);
      load_raw(1);
      __syncthreads();
      for (int c = 0; c < 256; ++c) {
        if (c + 1 < 256) prep(c + 1);
        if (c + 2 < 256) load_raw(c + 2);
        __syncthreads();
      }
    } else {
      float s0 = 0.f, s1 = 0.f, s2 = 0.f, s3 = 0.f;
      __syncthreads();
      for (int c = 0; c < 256; ++c) {
        const ScanBuf& bf = sb[c & 1];
        float yv = 0.f;
#pragma unroll
        for (int i = 0; i < 16; ++i) {
          const f32x4 A4 = *(const f32x4*)&bf.A[i][4 * kg];
          const f32x4 B4 = *(const f32x4*)&bf.B[i][4 * kg];
          const f32x4 W4 = *(const f32x4*)&bf.W[i][4 * kg];
          const f32x4 K4 = *(const f32x4*)&bf.K2[i][4 * kg];
          const f32x4 R4 = *(const f32x4*)&bf.R[i][4 * kg];
          const float vv = bf.V[i][rloc];
          float pd = s0 * A4.x + s1 * A4.y + s2 * A4.z + s3 * A4.w;
          const float sa = row16_allsum(pd);
          s0 = s0 * W4.x + vv * K4.x + sa * B4.x;
          s1 = s1 * W4.y + vv * K4.y + sa * B4.y;
          s2 = s2 * W4.z + vv * K4.z + sa * B4.z;
          s3 = s3 * W4.w + vv * K4.w + sa * B4.w;
          float yp = s0 * R4.x + s1 * R4.y + s2 * R4.z + s3 * R4.w;
          const float y = row16_allsum(yp);
          yv = (kg == i) ? y : yv;
        }
        YRAW[((size_t)b * SEQ + c * 16 + kg) * 512 + h * 64 + quarter * 16 + rloc] = (bf16)yv;
        __syncthreads();
      }
    }
    __syncthreads();
  }
  __builtin_amdgcn_s_setprio(0);
}

struct AttnSmem { bf16 k[2][64][104]; bf16 v[2][64][68]; int tile; };
DEVI void phase3b(const ParamsG& p, unsigned char* smem) {
  AttnSmem& sm = *(AttnSmem*)smem;
  const bf16* Qd = (const bf16*)((const unsigned char*)gp(p.out) + OFF_Q);
  const bf16* Kd = (const bf16*)((const unsigned char*)gp(p.out) + OFF_K);
  const bf16* Vd = (const bf16*)((const unsigned char*)gp(p.out) + OFF_VT);
  bf16* O = (bf16*)(gp(p.ws) + OFF_O);
  unsigned* cnt = (unsigned*)(gp(p.ws) + OFF_CNT);
  const int tid = threadIdx.x, lane = tid & 63, w = tid >> 6;
  const int q = lane & 31, hh = lane >> 5;
  for (;;) {
    __syncthreads();
    if (tid == 0) sm.tile = (int)atomicAdd(cnt, 1u);
    __syncthreads();
    const int tile = sm.tile;
    if (tile >= 1024) break;
    const int qt = 15 - (tile >> 6), bh = tile & 63;
    const int s0 = qt * 256;
    const int nkt = 4 * qt + 4;
    const int my_nkt = 4 * qt + 1 + (w >> 1);
    bf16x8 qf[6];
    {
      const bf16* qp = Qd + ((size_t)bh * SEQ + s0 + w * 32 + q) * 96 + hh * 8;
#pragma unroll
      for (int ks = 0; ks < 6; ++ks) qf[ks] = *(const bf16x8*)(qp + ks * 16);
      const size_t trow = (size_t)(bh >> 3) * SEQ + s0 + w * 32 + q;
      const float* cp = (const float*)(gp(p.ws) + OFF_CS) + trow * 16 + hh * 8;
      const float* sp = (const float*)(gp(p.ws) + OFF_SN) + trow * 16 + hh * 8;
#pragma unroll
      for (int j = 0; j < 8; ++j) {
        const float c = cp[j], sv = sp[j];
        const float x1 = (float)qf[4][j], x2 = (float)qf[5][j];
        qf[4][j] = (bf16)(x1 * c - x2 * sv);
        qf[5][j] = (bf16)(x2 * c + x1 * sv);
      }
    }
    f32x16 ot[2];
#pragma unroll
    for (int vb = 0; vb < 2; ++vb)
#pragma unroll
      for (int r = 0; r < 16; ++r) ot[vb][r] = 0.f;
    float mref = 0.f, lsum = 0.f;
    u32x4 kr0, kr1, vr;
    kr1 = mk_u4(0u, 0u, 0u, 0u);
    auto gload = [&](int kt) {
      const bf16* kb = Kd + ((size_t)bh * SEQ + kt * 64) * 96;
      kr0 = *(const u32x4*)(kb + (size_t)tid * 8);
      if (tid < 256) kr1 = *(const u32x4*)(kb + (size_t)(tid + 512) * 8);
      const bf16* vb = Vd + ((size_t)bh * SEQ + kt * 64) * 64;
      vr = *(const u32x4*)(vb + (size_t)tid * 8);
    };
    auto lwrite = [&](int buf) {
      const int row = tid / 12, cc = tid % 12;
      *(u32x4*)&sm.k[buf][row][cc * 8] = kr0;
      if (tid < 256) { const int id = tid + 512; *(u32x4*)&sm.k[buf][id / 12][(id % 12) * 8] = kr1; }
      const int key = tid >> 3, vd0 = (tid & 7) * 8;
      unsigned short* vs = (unsigned short*)&sm.v[buf][0][0];
#pragma unroll
      for (int j = 0; j < 4; ++j) {
        vs[(vd0 + 2 * j) * 68 + key] = (unsigned short)(vr[j] & 0xffffu);
        vs[(vd0 + 2 * j + 1) * 68 + key] = (unsigned short)(vr[j] >> 16);
      }
    };
    gload(0);
    lwrite(0);
    if (nkt > 1) gload(1);
    __syncthreads();
    for (int kt = 0; kt < nkt; ++kt) {
      const int cb_ = kt & 1;
      if (kt + 1 < nkt) lwrite(cb_ ^ 1);
      if (kt + 2 < nkt) gload(kt + 2);
      if (kt < my_nkt) {
        f32x16 st[2];
        const float nmref = -mref;
#pragma unroll
        for (int kb2 = 0; kb2 < 2; ++kb2) {
#pragma unroll
          for (int r = 0; r < 16; ++r) st[kb2][r] = nmref;
#pragma unroll
          for (int ks = 0; ks < 6; ++ks) {
            const bf16x8 a = *(const bf16x8*)&sm.k[cb_][kb2 * 32 + q][ks * 16 + hh * 8];
            st[kb2] = __builtin_amdgcn_mfma_f32_32x32x16_bf16(a, qf[ks], st[kb2], 0, 0, 0);
          }
        }
        float mx = st[0][0];
#pragma unroll
        for (int kb2 = 0; kb2 < 2; ++kb2)
#pragma unroll
          for (int r = 0; r < 16; ++r) mx = fmaxf(mx, st[kb2][r]);
        mx = fmaxf(mx, __shfl_xor(mx, 32, 64));
        if (kt == 0) {
          mref = mx;
#pragma unroll
          for (int kb2 = 0; kb2 < 2; ++kb2)
#pragma unroll
            for (int r = 0; r < 16; ++r) st[kb2][r] -= mx;
        } else if (__builtin_amdgcn_ballot_w64(mx > 8.f) != 0ull) {
          const float delta = fmaxf(mx, 0.f);
          const float alpha = __builtin_amdgcn_exp2f(-delta);
          mref += delta;
          lsum *= alpha;
#pragma unroll
          for (int kb2 = 0; kb2 < 2; ++kb2)
#pragma unroll
            for (int r = 0; r < 16; ++r) st[kb2][r] -= delta;
#pragma unroll
          for (int vb = 0; vb < 2; ++vb)
#pragma unroll
            for (int r = 0; r < 16; ++r) ot[vb][r] *= alpha;
        }
        float ps = 0.f;
#pragma unroll
        for (int kb2 = 0; kb2 < 2; ++kb2)
#pragma unroll
          for (int r = 0; r < 16; ++r) {
            const float pv = __builtin_amdgcn_exp2f(st[kb2][r]);
            st[kb2][r] = pv;
            ps += pv;
          }
        lsum += ps;
#pragma unroll
        for (int kb2 = 0; kb2 < 2; ++kb2)
#pragma unroll
          for (int s2 = 0; s2 < 2; ++s2) {
            bf16x8 pf;
#pragma unroll
            for (int j = 0; j < 8; ++j) pf[j] = (bf16)st[kb2][8 * s2 + j];
#pragma unroll
            for (int vb = 0; vb < 2; ++vb) {
              const bf16x4 lo = *(const bf16x4*)&sm.v[cb_][vb * 32 + q][kb2 * 32 + 16 * s2 + 4 * hh];
              const bf16x4 hi = *(const bf16x4*)&sm.v[cb_][vb * 32 + q][kb2 * 32 + 16 * s2 + 8 + 4 * hh];
              bf16x8 a;
              a[0] = lo[0]; a[1] = lo[1]; a[2] = lo[2]; a[3] = lo[3];
              a[4] = hi[0]; a[5] = hi[1]; a[6] = hi[2]; a[7] = hi[3];
              ot[vb] = __builtin_amdgcn_mfma_f32_32x32x16_bf16(a, pf, ot[vb], 0, 0, 0);
            }
          }
      }
      __syncthreads();
    }
    const float ltot = lsum + __shfl_xor(lsum, 32, 64);
    const float inv = 1.f / ltot;
    const int b = bh >> 3, h = bh & 7;
    bf16* op = O + ((size_t)b * SEQ + s0 + w * 32 + q) * 512 + h * 64;
#pragma unroll
    for (int vb = 0; vb < 2; ++vb)
#pragma unroll
      for (int rg = 0; rg < 4; ++rg) {
        bf16x4 o;
        o[0] = (bf16)(ot[vb][4 * rg + 0] * inv); o[1] = (bf16)(ot[vb][4 * rg + 1] * inv);
        o[2] = (bf16)(ot[vb][4 * rg + 2] * inv); o[3] = (bf16)(ot[vb][4 * rg + 3] * inv);
        *(bf16x4*)(op + vb * 32 + 8 * rg + 4 * hh) = o;
      }
  }
}

constexpr int CS_LD = 72;
constexpr int CS_SLOT = 64 * CS_LD * 2;
constexpr size_t CS_ITEM = 64 * 64;
constexpr size_t OFF_CS_PH = 0;
constexpr size_t OFF_CS_PL = 32 * MiB;
constexpr size_t OFF_CS_QA = 64 * MiB;
constexpr size_t OFF_CS_SL = 96 * MiB;
constexpr size_t OFF_CS_YL1 = 358 * MiB;
constexpr size_t OFF_CS_YL2 = 316 * MiB;
DEVI size_t cs_yl_off(int item) { return (item < 3072) ? OFF_CS_YL1 + (size_t)item * CS_ITEM * 2 : OFF_CS_YL2 + (size_t)(item - 3072) * CS_ITEM * 2; }

DEVI f32x4 mfma16(bf16x8 a, bf16x8 b, f32x4 c) { return __builtin_amdgcn_mfma_f32_16x16x32_bf16(a, b, c, 0, 0, 0); }
DEVI f32x4 cs_block(const bf16* X, const bf16* Y, int rb, int cb, int lane, f32x4 acc) {
  const int r = lane & 15, g = lane >> 4;
#pragma unroll
  for (int ks = 0; ks < 2; ++ks) {
    const bf16x8 a = *(const bf16x8*)(X + (rb * 16 + r) * CS_LD + ks * 32 + g * 8);
    const bf16x8 b = *(const bf16x8*)(Y + (cb * 16 + r) * CS_LD + ks * 32 + g * 8);
    acc = mfma16(a, b, acc);
  }
  return acc;
}
DEVI void cs_store_rowmajor(bf16* D, int rb, int cb, int lane, f32x4 v) {
  const int row0 = rb * 16 + 4 * (lane >> 4), col = cb * 16 + (lane & 15);
  D[(row0 + 0) * CS_LD + col] = (bf16)v.x; D[(row0 + 1) * CS_LD + col] = (bf16)v.y;
  D[(row0 + 2) * CS_LD + col] = (bf16)v.z; D[(row0 + 3) * CS_LD + col] = (bf16)v.w;
}
DEVI void cs_store_transposed(bf16* DT, int rb, int cb, int lane, f32x4 v) {
  const int row0 = rb * 16 + 4 * (lane >> 4), col = cb * 16 + (lane & 15);
  *(bf16x4*)(DT + col * CS_LD + row0) = to_bf4(v);
}

DEVI void phase3A(const ParamsG& p, unsigned char* smem) {
  const bf16* zrw = (const bf16*)(gp(p.ws) + OFF_ZRW);
  const bf16* E = (const bf16*)(gp(p.ws) + OFF_E);
  const bf16* ICLR = (const bf16*)(gp(p.ws) + OFF_ICLR);
  float* RK = (float*)(gp(p.ws) + OFF_RK);
  bf16* gPH = (bf16*)((unsigned char*)gp(p.out) + OFF_CS_PH);
  bf16* gPL = (bf16*)((unsigned char*)gp(p.out) + OFF_CS_PL);
  bf16* gQA = (bf16*)((unsigned char*)gp(p.out) + OFF_CS_QA);
  bf16* gSL = (bf16*)((unsigned char*)gp(p.out) + OFF_CS_SL);
  bf16* SLOT[14];
#pragma unroll
  for (int i = 0; i < 14; ++i) SLOT[i] = (bf16*)(smem + i * CS_SLOT);
  float* GL = (float*)smem;
  bf16* RAWA = SLOT[2]; bf16* RAWB = SLOT[3]; bf16* RAWK = SLOT[4]; bf16* RAWV = SLOT[5];
  bf16* At = SLOT[6]; bf16* Rt = SLOT[7]; bf16* Bt = SLOT[8]; bf16* Kt = SLOT[9];
  bf16* AT = SLOT[10]; bf16* BH = SLOT[11]; bf16* KH = SLOT[12]; bf16* VT = SLOT[13];
  float* BTOT = (float*)(smem + 14 * CS_SLOT);
  float* G63 = BTOT + 8 * 64;
  bf16* Lm = SLOT[0]; bf16* LmT = SLOT[1]; bf16* Lak = SLOT[2]; bf16* Mrb = SLOT[3]; bf16* Mrk = SLOT[4];
  const int tid = threadIdx.x, lane = tid & 63, w = tid >> 6;
  const int rb = w >> 1, cb0 = 2 * (w & 1);
  bf16x8 zr, zk, zv, pr, pk, pv, ic, e8;
  auto fetch = [&](int item) {
    const int bh = item >> 6, ch = item & 63, b = bh >> 3, h = bh & 7;
    const int tt = tid >> 3, kc = (tid & 7) * 8;
    const int s = ch * 64 + tt;
    const size_t t = (size_t)b * SEQ + s;
    const int c0 = h * 64 + kc;
    const bf16* zp = zrw + t * RWC + c0;
    zr = *(const bf16x8*)zp; zk = *(const bf16x8*)(zp + 512); zv = *(const bf16x8*)(zp + 1024);
    if (s > 0) { pr = *(const bf16x8*)(zp - RWC); pk = *(const bf16x8*)(zp - RWC + 512); pv = *(const bf16x8*)(zp - RWC + 1024); }
    else {
#pragma unroll
      for (int j = 0; j < 8; ++j) { pr[j] = (bf16)0.f; pk[j] = (bf16)0.f; pv[j] = (bf16)0.f; }
    }
    e8 = *(const bf16x8*)(E + t * 512 + c0);
    ic = *(const bf16x8*)(ICLR + t * 512 + c0);
  };
  if ((int)blockIdx.x < 4096) fetch(blockIdx.x);
  for (int item = blockIdx.x; item < 4096; item += gridDim.x) {
    const int bh = item >> 6, ch = item & 63, b = bh >> 3, h = bh & 7;
    const int tbase = ch * 64;
    float a_[8], b_[8], k2_[8], r_[8];
    {
      const int tt = tid >> 3, kc = (tid & 7) * 8;
      const int s = tbase + tt;
      const size_t t = (size_t)b * SEQ + s;
      const int c0 = h * 64 + kc;
      const float ee[8] = {(float)e8[0], (float)e8[1], (float)e8[2], (float)e8[3], (float)e8[4], (float)e8[5], (float)e8[6], (float)e8[7]};
      float k_[8], v_[8], kx[8], icl[8], lw[8];
      float n2 = 0.f;
#pragma unroll
      for (int j = 0; j < 8; ++j) {
        const float zrj = (float)zr[j], zkj = (float)zk[j], zvj = (float)zv[j];
        r_[j] = zrj + gp(p.rw_mu)[c0 + j] * ((float)pr[j] - zrj);
        k_[j] = zkj + gp(p.rw_mu)[512 + c0 + j] * ((float)pk[j] - zkj);
        v_[j] = zvj + gp(p.rw_mu)[1024 + c0 + j] * ((float)pv[j] - zvj);
        kx[j] = k_[j] * gp(p.rw_k_k)[c0 + j];
        n2 += kx[j] * kx[j];
        icl[j] = sigmoid_f(gp(p.rw_a0)[c0 + j] + (float)ic[j]);
        lw[j] = -0.60653066f * sigmoid_f(gp(p.rw_w0)[c0 + j] + ee[j]);
      }
      n2 = row8_allsum(n2);
      const float inv = 1.f / fmaxf(sqrtf(n2), 1e-12f);
      float rkp = 0.f;
#pragma unroll
      for (int j = 0; j < 8; ++j) {
        const float kkn = kx[j] * inv;
        k2_[j] = k_[j] * (1.f + (icl[j] - 1.f) * gp(p.rw_k_a)[c0 + j]);
        a_[j] = -kkn;
        b_[j] = kkn * icl[j];
        rkp += r_[j] * k2_[j] * gp(p.rw_r_k)[c0 + j];
      }
      rkp = row8_allsum(rkp);
      if ((tid & 7) == 0) RK[t * 8 + h] = rkp;
      *(f32x4*)&GL[tt * 64 + kc] = mk_f4(lw[0], lw[1], lw[2], lw[3]);
      *(f32x4*)&GL[tt * 64 + kc + 4] = mk_f4(lw[4], lw[5], lw[6], lw[7]);
      bf16x8 oa, ob, ok, ov;
#pragma unroll
      for (int j = 0; j < 8; ++j) { oa[j] = (bf16)a_[j]; ob[j] = (bf16)b_[j]; ok[j] = (bf16)k2_[j]; ov[j] = (bf16)v_[j]; }
      *(bf16x8*)(RAWA + tt * CS_LD + kc) = oa; *(bf16x8*)(RAWB + tt * CS_LD + kc) = ob;
      *(bf16x8*)(RAWK + tt * CS_LD + kc) = ok; *(bf16x8*)(RAWV + tt * CS_LD + kc) = ov;
    }
    if (item + (int)gridDim.x < 4096) fetch(item + gridDim.x);
    __syncthreads();
    {
      const int kch = tid & 63, tb = tid >> 6;
      float run = 0.f;
#pragma unroll
      for (int i = 0; i < 8; ++i) { run += GL[(tb * 8 + i) * 64 + kch]; GL[(tb * 8 + i) * 64 + kch] = run; }
      BTOT[tb * 64 + kch] = run;
    }
    __syncthreads();
    {
      const int kch = tid & 63, tb = tid >> 6;
      float off = 0.f;
      for (int i = 0; i < tb; ++i) off += BTOT[i * 64 + kch];
#pragma unroll
      for (int i = 0; i < 8; ++i) GL[(tb * 8 + i) * 64 + kch] += off;
    }
    __syncthreads();
    {
      const int tt = tid >> 3, kc = (tid & 7) * 8;
      bf16x8 oA, oR, oB, oK;
#pragma unroll
      for (int j = 0; j < 8; ++j) {
        const float g = GL[tt * 64 + kc + j];
        const float gm = (tt > 0) ? GL[(tt - 1) * 64 + kc + j] : 0.f;
        const float ig = __expf(-g);
        oA[j] = (bf16)(a_[j] * __expf(gm));
        oR[j] = (bf16)(r_[j] * __expf(g));
        oB[j] = (bf16)(b_[j] * ig);
        oK[j] = (bf16)(k2_[j] * ig);
      }
      *(bf16x8*)(At + tt * CS_LD + kc) = oA; *(bf16x8*)(Rt + tt * CS_LD + kc) = oR;
      *(bf16x8*)(Bt + tt * CS_LD + kc) = oB; *(bf16x8*)(Kt + tt * CS_LD + kc) = oK;
    }
    {
      const int kch = tid & 63, tb = tid >> 6;
      const float g63 = GL[63 * 64 + kch];
      bf16x8 oAT, oBH, oKH, oVT;
#pragma unroll
      for (int i = 0; i < 8; ++i) {
        const int t = tb * 8 + i;
        const float g = GL[t * 64 + kch];
        const float gm = (t > 0) ? GL[(t - 1) * 64 + kch] : 0.f;
        const float sc = __expf(g63 - g);
        oAT[i] = (bf16)((float)RAWA[t * CS_LD + kch] * __expf(gm));
        oBH[i] = (bf16)((float)RAWB[t * CS_LD + kch] * sc);
        oKH[i] = (bf16)((float)RAWK[t * CS_LD + kch] * sc);
        oVT[i] = RAWV[t * CS_LD + kch];
      }
      *(bf16x8*)(AT + kch * CS_LD + tb * 8) = oAT; *(bf16x8*)(BH + kch * CS_LD + tb * 8) = oBH;
      *(bf16x8*)(KH + kch * CS_LD + tb * 8) = oKH; *(bf16x8*)(VT + kch * CS_LD + tb * 8) = oVT;
      if (tb == 0) G63[kch] = __expf(g63);
    }
    __syncthreads();
    f32x4 tacc[2];
#pragma unroll
    for (int q = 0; q < 2; ++q) {
      const int cb = cb0 + q;
      const f32x4 z4 = mk_f4(0.f, 0.f, 0.f, 0.f);
      f32x4 dab = cs_block(At, Bt, rb, cb, lane, z4);
      f32x4 dak = cs_block(At, Kt, rb, cb, lane, z4);
      f32x4 drb = cs_block(Rt, Bt, rb, cb, lane, z4);
      f32x4 drk = cs_block(Rt, Kt, rb, cb, lane, z4);
      const int row0 = rb * 16 + 4 * (lane >> 4), col = cb * 16 + (lane & 15);
#pragma unroll
      for (int i = 0; i < 4; ++i) {
        const int row = row0 + i;
        if (col >= row) { dab[i] = 0.f; dak[i] = 0.f; }
        if (col > row) { drb[i] = 0.f; drk[i] = 0.f; }
      }
      tacc[q] = dab;
#pragma unroll
      for (int i = 0; i < 4; ++i) if (col == row0 + i) tacc[q][i] += 1.f;
      asm volatile("" ::: "memory");
      cs_store_rowmajor(Lm, rb, cb, lane, dab);
      cs_store_transposed(LmT, rb, cb, lane, dab);
      cs_store_rowmajor(Lak, rb, cb, lane, dak);
      cs_store_rowmajor(Mrb, rb, cb, lane, drb);
      cs_store_rowmajor(Mrk, rb, cb, lane, drk);
      cs_store_transposed(SLOT[5], rb, cb, lane, tacc[q]);
    }
    __syncthreads();
    {
      bf16* Pc = Lm; bf16* PcT = LmT; bf16* Pn = At; bf16* PnT = Bt;
      bf16* TTc = SLOT[5]; bf16* TTn = Kt;
#pragma unroll 1
      for (int it = 0; it < 5; ++it) {
        f32x4 pp[2];
#pragma unroll
        for (int q = 0; q < 2; ++q) pp[q] = cs_block(Pc, PcT, rb, cb0 + q, lane, mk_f4(0.f, 0.f, 0.f, 0.f));
#pragma unroll
        for (int q = 0; q < 2; ++q) { cs_store_rowmajor(Pn, rb, cb0 + q, lane, pp[q]); cs_store_transposed(PnT, rb, cb0 + q, lane, pp[q]); }
        __syncthreads();
#pragma unroll
        for (int q = 0; q < 2; ++q) tacc[q] = cs_block(Pn, TTc, rb, cb0 + q, lane, tacc[q]);
#pragma unroll
        for (int q = 0; q < 2; ++q) cs_store_transposed(TTn, rb, cb0 + q, lane, tacc[q]);
        __syncthreads();
        bf16* t1 = Pc; Pc = Pn; Pn = t1; t1 = PcT; PcT = PnT; PnT = t1; t1 = TTc; TTc = TTn; TTn = t1;
      }
    }
    bf16* Tm = SLOT[0]; bf16* WT = SLOT[1]; bf16* TAT = SLOT[5]; bf16* ULT = SLOT[6];
#pragma unroll
    for (int q = 0; q < 2; ++q) cs_store_rowmajor(Tm, rb, cb0 + q, lane, tacc[q]);
#pragma unroll
    for (int q = 0; q < 2; ++q) cs_store_transposed(WT, rb, cb0 + q, lane, cs_block(Lak, VT, rb, cb0 + q, lane, mk_f4(0.f, 0.f, 0.f, 0.f)));
    __syncthreads();
#pragma unroll
    for (int q = 0; q < 2; ++q) {
      cs_store_transposed(TAT, rb, cb0 + q, lane, cs_block(Tm, AT, rb, cb0 + q, lane, mk_f4(0.f, 0.f, 0.f, 0.f)));
      cs_store_transposed(ULT, rb, cb0 + q, lane, cs_block(Tm, WT, rb, cb0 + q, lane, mk_f4(0.f, 0.f, 0.f, 0.f)));
    }
    __syncthreads();
    {
      bf16* oQA = SLOT[2]; bf16* oYL = SLOT[8]; bf16* oPH = SLOT[9];
      f32x4 pm_[2], sl_[2];
#pragma unroll
      for (int q = 0; q < 2; ++q) {
        const int cb = cb0 + q;
        const int row0 = rb * 16 + 4 * (lane >> 4), col = cb * 16 + (lane & 15);
        f32x4 qa;
#pragma unroll
        for (int i = 0; i < 4; ++i) qa[i] = (float)Rt[(row0 + i) * CS_LD + col];
        qa = cs_block(Mrb, TAT, rb, cb, lane, qa);
        f32x4 yl = cs_block(Mrb, ULT, rb, cb, lane, mk_f4(0.f, 0.f, 0.f, 0.f));
        yl = cs_block(Mrk, VT, rb, cb, lane, yl);
        f32x4 pm = cs_block(BH, TAT, rb, cb, lane, mk_f4(0.f, 0.f, 0.f, 0.f));
#pragma unroll
        for (int i = 0; i < 4; ++i) if (col == row0 + i) pm[i] += G63[col];
        f32x4 sl = cs_block(BH, ULT, rb, cb, lane, mk_f4(0.f, 0.f, 0.f, 0.f));
        sl = cs_block(KH, VT, rb, cb, lane, sl);
        cs_store_rowmajor(oQA, rb, cb, lane, qa);
        cs_store_rowmajor(oYL, rb, cb, lane, yl);
        cs_store_rowmajor(oPH, rb, cb, lane, pm);
        pm_[q] = pm; sl_[q] = sl;
      }
      __syncthreads();
      bf16* oPL = SLOT[0]; bf16* oSL = SLOT[1];
#pragma unroll
      for (int q = 0; q < 2; ++q) {
        const int cb = cb0 + q;
        const int row0 = rb * 16 + 4 * (lane >> 4), col = cb * 16 + (lane & 15);
        f32x4 lo;
#pragma unroll
        for (int i = 0; i < 4; ++i) lo[i] = pm_[q][i] - (float)oPH[(row0 + i) * CS_LD + col];
        cs_store_rowmajor(oPL, rb, cb, lane, lo);
        cs_store_rowmajor(oSL, rb, cb, lane, sl_[q]);
      }
      __syncthreads();
      const size_t ib = (size_t)item * CS_ITEM + (size_t)tid * 8;
      const int row = tid >> 3, cc = (tid & 7) * 8;
      *(u32x4*)(gQA + ib) = *(const u32x4*)(oQA + row * CS_LD + cc);
      *(u32x4*)((bf16*)(gp(p.ws) + cs_yl_off(item)) + (size_t)tid * 8) = *(const u32x4*)(oYL + row * CS_LD + cc);
      *(u32x4*)(gPH + ib) = *(const u32x4*)(oPH + row * CS_LD + cc);
      *(u32x4*)(gPL + ib) = *(const u32x4*)(oPL + row * CS_LD + cc);
      *(u32x4*)(gSL + ib) = *(const u32x4*)(oSL + row * CS_LD + cc);
    }
    __syncthreads();
  }
}

struct CsStage { bf16 ph[64 * CS_LD]; bf16 pl[64 * CS_LD]; bf16 qa[64 * CS_LD]; bf16 sl[64 * 16]; bf16 yl[64 * 16]; bf16 zh[16 * CS_LD]; bf16 zl[16 * CS_LD]; };
DEVI void phase3B(const ParamsG& p, unsigned char* smem) {
  const bf16* gPH = (const bf16*)((const unsigned char*)gp(p.out) + OFF_CS_PH);
  const bf16* gPL = (const bf16*)((const unsigned char*)gp(p.out) + OFF_CS_PL);
  const bf16* gQA = (const bf16*)((const unsigned char*)gp(p.out) + OFF_CS_QA);
  const bf16* gSL = (const bf16*)((const unsigned char*)gp(p.out) + OFF_CS_SL);
  bf16* YRAW = (bf16*)(gp(p.ws) + OFF_YRAW);
  CsStage* st = (CsStage*)smem;
  const int tid = threadIdx.x, lane = tid & 63, w = tid >> 6;
  const int r = lane & 15, g = lane >> 4;
  for (int item = blockIdx.x; item < 256; item += gridDim.x) {
    const int bh = item >> 2, vb = item & 3, b = bh >> 3, h = bh & 7;
    u32x4 rPH[2], rPL[2], rQA[2]; unsigned rSL[2], rYL[2];
    auto gload = [&](int ch, int sl) {
      const int it2 = bh * 64 + ch;
      const size_t ib = (size_t)it2 * CS_ITEM;
      rPH[sl] = *(const u32x4*)(gPH + ib + (size_t)tid * 8);
      rPL[sl] = *(const u32x4*)(gPL + ib + (size_t)tid * 8);
      rQA[sl] = *(const u32x4*)(gQA + ib + (size_t)tid * 8);
      const size_t o = (size_t)(tid >> 3) * 64 + vb * 16 + (tid & 7) * 2;
      rSL[sl] = *(const unsigned*)(gSL + ib + o);
      rYL[sl] = *(const unsigned*)((const bf16*)(gp(p.ws) + cs_yl_off(it2)) + o);
    };
    auto stage_write = [&](int ch, int sl) {
      CsStage& s2 = st[ch & 1];
      const int row = tid >> 3, cc = (tid & 7) * 8;
      *(u32x4*)(s2.ph + row * CS_LD + cc) = rPH[sl];
      *(u32x4*)(s2.pl + row * CS_LD + cc) = rPL[sl];
      *(u32x4*)(s2.qa + row * CS_LD + cc) = rQA[sl];
      *(unsigned*)(s2.sl + row * 16 + (tid & 7) * 2) = rSL[sl];
      *(unsigned*)(s2.yl + row * 16 + (tid & 7) * 2) = rYL[sl];
    };
    gload(0, 0);
    gload(1, 1);
    __syncthreads();
    for (int i = tid; i < 16 * CS_LD; i += NTHREADS) { st[0].zh[i] = (bf16)0.f; st[0].zl[i] = (bf16)0.f; }
    stage_write(0, 0);
    gload(2, 0);
    __syncthreads();
#pragma unroll 2
    for (int ch = 0; ch < 64; ++ch) {
      if (ch + 1 < 64) stage_write(ch + 1, (ch + 1) & 1);
      if (ch + 3 < 64) gload(ch + 3, (ch + 1) & 1);
      const CsStage& c = st[ch & 1];
      CsStage& n = st[(ch + 1) & 1];
      if (w < 4) {
        f32x4 acc;
#pragma unroll
        for (int i = 0; i < 4; ++i) acc[i] = (float)c.sl[(w * 16 + 4 * g + i) * 16 + r];
#pragma unroll
        for (int ks = 0; ks < 2; ++ks) {
          const bf16x8 ah = *(const bf16x8*)(c.ph + (w * 16 + r) * CS_LD + ks * 32 + g * 8);
          const bf16x8 al = *(const bf16x8*)(c.pl + (w * 16 + r) * CS_LD + ks * 32 + g * 8);
          const bf16x8 bh8 = *(const bf16x8*)(c.zh + r * CS_LD + ks * 32 + g * 8);
          const bf16x8 bl8 = *(const bf16x8*)(c.zl + r * CS_LD + ks * 32 + g * 8);
          acc = mfma16(ah, bh8, acc);
          acc = mfma16(ah, bl8, acc);
          acc = mfma16(al, bh8, acc);
        }
        const bf16x4 hi4 = to_bf4(acc);
        f32x4 res;
#pragma unroll
        for (int i = 0; i < 4; ++i) res[i] = acc[i] - (float)hi4[i];
        *(bf16x4*)(n.zh + r * CS_LD + w * 16 + 4 * g) = hi4;
        *(bf16x4*)(n.zl + r * CS_LD + w * 16 + 4 * g) = to_bf4(res);
      } else {
        const int tb = w - 4;
        f32x4 acc;
#pragma unroll
        for (int i = 0; i < 4; ++i) acc[i] = (float)c.yl[(tb * 16 + 4 * g + i) * 16 + r];
#pragma unroll
        for (int ks = 0; ks < 2; ++ks) {
          const bf16x8 a = *(const bf16x8*)(c.qa + (tb * 16 + r) * CS_LD + ks * 32 + g * 8);
          const bf16x8 bh8 = *(const bf16x8*)(c.zh + r * CS_LD + ks * 32 + g * 8);
          const bf16x8 bl8 = *(const bf16x8*)(c.zl + r * CS_LD + ks * 32 + g * 8);
          acc = mfma16(a, bh8, acc);
          acc = mfma16(a, bl8, acc);
        }
#pragma unroll
        for (int i = 0; i < 4; ++i) {
          const size_t t = (size_t)b * SEQ + ch * 64 + tb * 16 + 4 * g + i;
          YRAW[t * 512 + h * 64 + vb * 16 + r] = (bf16)acc[i];
        }
      }
      __syncthreads();
    }
  }
}

DEVI void phase3c(const ParamsG& p) {
  const int lane = threadIdx.x & 63;
  const int gw = blockIdx.x * NWAVES + (threadIdx.x >> 6), nw = gridDim.x * NWAVES;
  const bf16* zrw = (const bf16*)(gp(p.ws) + OFF_ZRW);
  const bf16* YRAW = (const bf16*)(gp(p.ws) + OFF_YRAW);
  const bf16* G = (const bf16*)(gp(p.ws) + OFF_G);
  const float* RK = (const float*)(gp(p.ws) + OFF_RK);
  bf16* YA = (bf16*)(gp(p.ws) + OFF_YAPRE);
  const int c0 = lane * 8, head = lane >> 3;
  float gw_[8], gb_[8], mu_[8];
#pragma unroll
  for (int j = 0; j < 8; ++j) { gw_[j] = gp(p.rw_gn_w)[c0 + j]; gb_[j] = gp(p.rw_gn_b)[c0 + j]; mu_[j] = gp(p.rw_mu)[1024 + c0 + j]; }
  for (int t = gw; t < T_TOK; t += nw) {
    const int s = t & (SEQ - 1);
    const bf16x8 y8 = *(const bf16x8*)(YRAW + (size_t)t * 512 + c0);
    float y[8];
    float sm = 0.f;
#pragma unroll
    for (int j = 0; j < 8; ++j) { y[j] = (float)y8[j]; sm += y[j]; }
    const float mean = row8_allsum(sm) * (1.f / 64.f);
    float sq = 0.f;
#pragma unroll
    for (int j = 0; j < 8; ++j) { y[j] -= mean; sq += y[j] * y[j]; }
    const float var = row8_allsum(sq) * (1.f / 64.f);
    const float rstd = rsqrtf(var + 64e-5f);
    const bf16* vp = zrw + (size_t)t * RWC + 1024 + c0;
    const bf16x8 vc = *(const bf16x8*)vp;
    bf16x8 vq;
    if (s > 0) vq = *(const bf16x8*)(vp - RWC);
    else {
#pragma unroll
      for (int j = 0; j < 8; ++j) vq[j] = (bf16)0.f;
    }
    const bf16x8 g8 = *(const bf16x8*)(G + (size_t)t * 512 + c0);
    const float rk = RK[(size_t)t * 8 + head];
    bf16x8 o;
#pragma unroll
    for (int j = 0; j < 8; ++j) {
      const float vcur = (float)vc[j];
      const float vs = vcur + mu_[j] * ((float)vq[j] - vcur);
      const float yn = y[j] * rstd * gw_[j] + gb_[j];
      o[j] = (bf16)((yn + rk * vs) * (float)g8[j]);
    }
    *(bf16x8*)(YA + (size_t)t * 512 + c0) = o;
  }
}

template <int MODE> struct EpiMix {
  static constexpr bool PERM = true, AFTER_DRAIN = false;
  bf16* D; const bf16* S;
  DEVI void operator()(PgAcc acc, const pg8::Unit& u, int wr, int wc, int fr, int fq) const {
    if constexpr (MODE == 1) {
      bf16x4 ly[2][4];
      PG_EPI_PIPELINED(
        ly[slot][c] = *(const bf16x4*)(D + off); ,
        const bf16x4 y = ly[slot][c];
        f32x4 o; o.x = (float)y[0] * sigmoid_f(v.x); o.y = (float)y[1] * sigmoid_f(v.y); o.z = (float)y[2] * sigmoid_f(v.z); o.w = (float)y[3] * sigmoid_f(v.w);
        *(bf16x4*)(D + off) = to_bf4(o);
      )
      return;
    }
    if constexpr (MODE == 3) {
      bf16x4 ly[2][4]; bf16x4 ls[2][4];
      PG_EPI_PIPELINED(
        ly[slot][c] = *(const bf16x4*)(D + off); ls[slot][c] = *(const bf16x4*)(S + off); ,
        const bf16x4 y = ly[slot][c]; const bf16x4 y2 = ls[slot][c];
        f32x4 o; o.x = (float)y[0] + (float)y2[0] * sigmoid_f(v.x); o.y = (float)y[1] + (float)y2[1] * sigmoid_f(v.y);
        o.z = (float)y[2] + (float)y2[2] * sigmoid_f(v.z); o.w = (float)y[3] + (float)y2[3] * sigmoid_f(v.w);
        *(bf16x4*)(D + off) = to_bf4(o);
      )
      return;
    }
    PG_EPI_ROWS(PG_EPI_COLS(
      bf16* q = D + (unsigned)(row * DM + col);
      if (MODE == 0) *(bf16x4*)q = to_bf4(v);
      else if (MODE == 1) {
        const bf16x4 y = *(const bf16x4*)q;
        f32x4 o; o.x = (float)y[0] * sigmoid_f(v.x); o.y = (float)y[1] * sigmoid_f(v.y); o.z = (float)y[2] * sigmoid_f(v.z); o.w = (float)y[3] * sigmoid_f(v.w);
        *(bf16x4*)q = to_bf4(o);
      } else {
        const bf16x4 y = *(const bf16x4*)q; const bf16x4 y2 = *(const bf16x4*)(S + (unsigned)(row * DM + col));
        f32x4 o; o.x = (float)y[0] + (float)y2[0] * sigmoid_f(v.x); o.y = (float)y[1] + (float)y2[1] * sigmoid_f(v.y);
        o.z = (float)y[2] + (float)y2[2] * sigmoid_f(v.z); o.w = (float)y[3] + (float)y2[3] * sigmoid_f(v.w);
        *(bf16x4*)q = to_bf4(o);
      }
    ))
  }
};
DEVI void phase4(const ParamsG& p, unsigned char* smem) {
  unsigned char* ws = gp(p.ws);
  const bf16* H1 = (const bf16*)(ws + OFF_H1);
  const bf16* WG = (const bf16*)(ws + OFF_WG_T);
  bf16* M = (bf16*)(ws + OFF_M);
  bf16* M2 = (bf16*)(ws + OFF_M2);
  { EpiMix<0> e; e.D = M; e.S = nullptr; run_gemm(smem, (const bf16*)(ws + OFF_YAPRE), (const bf16*)(ws + OFF_RWO_T), T_TOK, DM, 512, e); }
  { EpiMix<1> e; e.D = M; e.S = nullptr; run_gemm(smem, H1, WG, T_TOK, DM, DM, e); }
  { EpiMix<0> e; e.D = M2; e.S = nullptr; run_gemm(smem, (const bf16*)(ws + OFF_O), (const bf16*)(ws + OFF_MLO_T), T_TOK, DM, 512, e); }
  { EpiMix<3> e; e.D = M; e.S = M2; run_gemm(smem, H1, WG + (size_t)1024 * DM, T_TOK, DM, DM, e); }
}

struct EpiX1 {
  static constexpr bool PERM = true, AFTER_DRAIN = false;
  const float* x; bf16* xb;
  DEVI void operator()(PgAcc acc, const pg8::Unit& u, int wr, int wc, int fr, int fq) const {
    f32x4 lx[2][4];
    PG_EPI_PIPELINED(
      lx[slot][c] = *(const f32x4*)(x + off); ,
      const f32x4 s4 = lx[slot][c] + v;
      bf16x4 o; o[0] = (bf16)s4.x; o[1] = (bf16)s4.y; o[2] = (bf16)s4.z; o[3] = (bf16)s4.w;
      *(bf16x4*)(xb + off) = o;
    )
  }
};
DEVI void phase5(const ParamsG& p, unsigned char* smem) {
  EpiX1 e; e.x = gp(p.x); e.xb = (bf16*)(gp(p.ws) + OFF_XB);
  run_gemm(smem, (const bf16*)(gp(p.ws) + OFF_M), (const bf16*)(gp(p.ws) + OFF_WOUT_T), T_TOK, DM, DM, e);
}

DEVI unsigned pack_key(float s, int n) {
  unsigned u = __float_as_uint(s);
  u = (u & 0x80000000u) ? ~u : (u | 0x80000000u);
  return (u & 0xFFFFFF80u) | (unsigned)n;
}
DEVI float key_score(unsigned k) {
  unsigned u = k & 0xFFFFFF80u;
  u = (u & 0x80000000u) ? (u & 0x7FFFFFFFu) : ~u;
  return __uint_as_float(u);
}
template <int N> DEVI void bitonic_sort_desc(unsigned (&v)[N]) {
#pragma unroll
  for (int k = 2; k <= N; k <<= 1) {
#pragma unroll
    for (int j = k >> 1; j > 0; j >>= 1) {
#pragma unroll
      for (int i = 0; i < N; ++i) {
        const int l = i ^ j;
        if (l > i) {
          const bool desc = ((i & k) == 0);
          const unsigned a = v[i], b = v[l];
          const unsigned mx = a > b ? a : b, mn = a > b ? b : a;
          v[i] = desc ? mx : mn;
          v[l] = desc ? mn : mx;
        }
      }
    }
  }
}
template <int N> DEVI void bitonic_merge_desc(unsigned (&v)[N]) {
#pragma unroll
  for (int j = N >> 1; j > 0; j >>= 1) {
#pragma unroll
    for (int i = 0; i < N; ++i) {
      const int l = i ^ j;
      if (l > i) {
        const unsigned a = v[i], b = v[l];
        v[i] = a > b ? a : b;
        v[l] = a > b ? b : a;
      }
    }
  }
}

DEVI void phase7(const ParamsG& p, unsigned char* smem) {
  const bf16* H2 = (const bf16*)(gp(p.ws) + OFF_XB);
  const bf16* WQ = (const bf16*)(gp(p.ws) + OFF_WQ_T);
  const bf16* SK = (const bf16*)(gp(p.ws) + OFF_SK);
  unsigned* TOPK = (unsigned*)(gp(p.ws) + OFF_TOPK);
  const int lane = threadIdx.x & 63, w = threadIdx.x >> 6;
  const int hh = lane >> 5;
  for (int it = 0;; ++it) {
    int tm, hc;
    if (!tile_map<128, 16, 2>(it, tm, hc)) break;
    const int m0 = tm * 256;
    f32x16 acc[4];
#pragma unroll
    for (int mt = 0; mt < 4; ++mt)
#pragma unroll
      for (int r = 0; r < 16; ++r) acc[mt][r] = 0.f;
    float ssq;
    route_mainloop<true>(acc, WQ + (size_t)(hc * 128) * DM, DM, H2 + (size_t)m0 * DM, DM, 16, smem, SK + (size_t)hc * 128 * 128, &ssq);
    ssq += __shfl_xor(ssq, 32, 64);
    const float rstd = rsqrtf(ssq * (1.f / DM) + 1e-6f);
    bf16x8 qf[4][2];
#pragma unroll
    for (int db = 0; db < 4; ++db)
#pragma unroll
      for (int s2 = 0; s2 < 2; ++s2)
#pragma unroll
        for (int j = 0; j < 8; ++j) qf[db][s2][j] = (bf16)(acc[db][8 * s2 + j] * rstd);
    unsigned key[64];
    int hh4 = 4 * hh; asm volatile("" : "+v"(hh4));
    const unsigned char* skl = smem + (16 % 3) * 49152;
#pragma unroll
    for (int nb = 0; nb < 4; ++nb) {
      f32x16 sc;
#pragma unroll
      for (int r = 0; r < 16; ++r) sc[r] = 0.f;
      const int n = nb * 32 + (lane & 31);
      const unsigned char* rowp = skl + n * 256 + 8 * hh;
#pragma unroll
      for (int db = 0; db < 4; ++db)
#pragma unroll
        for (int s2 = 0; s2 < 2; ++s2) {
          const int c = db * 4 + 2 * s2;
          const bf16x4 lo = *(const bf16x4*)(rowp + ((c ^ (n & 15)) * 16));
          const bf16x4 hi = *(const bf16x4*)(rowp + (((c + 1) ^ (n & 15)) * 16));
          bf16x8 a;
          a[0] = lo[0]; a[1] = lo[1]; a[2] = lo[2]; a[3] = lo[3];
          a[4] = hi[0]; a[5] = hi[1]; a[6] = hi[2]; a[7] = hi[3];
          sc = __builtin_amdgcn_mfma_f32_32x32x16_bf16(a, qf[db][s2], sc, 0, 0, 0);
        }
#pragma unroll
      for (int r = 0; r < 16; ++r) key[nb * 16 + r] = pack_key(sc[r], nb * 32 + (r & 3) + 8 * (r >> 2) + hh4);
    }
    unsigned g0[16], g1[16], g2[16], g3[16];
#pragma unroll
    for (int i = 0; i < 16; ++i) { g0[i] = key[i]; g1[i] = key[16 + i]; g2[i] = key[32 + i]; g3[i] = key[48 + i]; }
    bitonic_sort_desc<16>(g0); bitonic_sort_desc<16>(g1); bitonic_sort_desc<16>(g2); bitonic_sort_desc<16>(g3);
#pragma unroll
    for (int i = 0; i < 16; ++i) { g0[i] = g0[i] > g1[15 - i] ? g0[i] : g1[15 - i]; g2[i] = g2[i] > g3[15 - i] ? g2[i] : g3[15 - i]; }
    bitonic_merge_desc<16>(g0); bitonic_merge_desc<16>(g2);
#pragma unroll
    for (int i = 0; i < 16; ++i) g0[i] = g0[i] > g2[15 - i] ? g0[i] : g2[15 - i];
    bitonic_merge_desc<16>(g0);
    unsigned top[16];
#pragma unroll
    for (int i = 0; i < 16; ++i) {
      const unsigned o = (unsigned)__shfl_xor((int)g0[15 - i], 32, 64);
      top[i] = g0[i] > o ? g0[i] : o;
    }
    bitonic_merge_desc<16>(top);
    if (hh == 0) {
      const int t = m0 + w * 32 + (lane & 31);
      u32x4* dst = (u32x4*)(TOPK + ((size_t)t * 16 + hc) * 16);
      dst[0] = mk_u4(top[0], top[1], top[2], top[3]);
      dst[1] = mk_u4(top[4], top[5], top[6], top[7]);
      dst[2] = mk_u4(top[8], top[9], top[10], top[11]);
      dst[3] = mk_u4(top[12], top[13], top[14], top[15]);
    }
  }
}

DEVI void phase7b(const ParamsG& p, unsigned char* smem) {
  unsigned* ka = (unsigned*)smem;
  unsigned* kb = ka + 16 * 512;
  const unsigned* TOPK = (const unsigned*)(gp(p.ws) + OFF_TOPK);
  int* IDX = (int*)(gp(p.ws) + OFF_IDX);
  float* GATE = (float*)(gp(p.ws) + OFF_GATE);
  const int tid = threadIdx.x;
  for (int grp = blockIdx.x; grp < (T_TOK * 8) / NTHREADS; grp += gridDim.x) {
    const int item = grp * NTHREADS + tid;
    const u32x4* src = (const u32x4*)(TOPK + (size_t)item * 32);
#pragma unroll
    for (int i = 0; i < 4; ++i) {
      const u32x4 va = src[i], vb = src[4 + i];
      ka[(4 * i + 0) * 512 + tid] = va.x; ka[(4 * i + 1) * 512 + tid] = va.y;
      ka[(4 * i + 2) * 512 + tid] = va.z; ka[(4 * i + 3) * 512 + tid] = va.w;
      kb[(4 * i + 0) * 512 + tid] = vb.x; kb[(4 * i + 1) * 512 + tid] = vb.y;
      kb[(4 * i + 2) * 512 + tid] = vb.z; kb[(4 * i + 3) * 512 + tid] = vb.w;
    }
    unsigned long long jp = 0ull;
    float sc[16];
    int ex[16];
#pragma unroll
    for (int r = 0; r < 16; ++r) {
      float best = -3.0e38f;
      int bi = 0, bj = 0;
      for (int i = 0; i <= r; ++i) {
        const int ji = (int)((jp >> (4 * i)) & 15ull);
        const float cand = key_score(ka[i * 512 + tid]) + key_score(kb[ji * 512 + tid]);
        if (cand > best) { best = cand; bi = i; bj = ji; }
      }
      sc[r] = best;
      ex[r] = (int)(ka[bi * 512 + tid] & 127u) * 128 + (int)(kb[bj * 512 + tid] & 127u);
      jp += 1ull << (4 * bi);
    }
    float den = 0.f;
    const float smax = sc[0];
#pragma unroll
    for (int r = 0; r < 16; ++r) { sc[r] = __expf(sc[r] - smax); den += sc[r]; }
    const float inv = 1.f / den;
    i32x4* di = (i32x4*)(IDX + (size_t)item * 16);
    f32x4* dg = (f32x4*)(GATE + (size_t)item * 16);
#pragma unroll
    for (int i = 0; i < 4; ++i) {
      di[i] = mk_i4(ex[4 * i], ex[4 * i + 1], ex[4 * i + 2], ex[4 * i + 3]);
      dg[i] = mk_f4(sc[4 * i] * inv, sc[4 * i + 1] * inv, sc[4 * i + 2] * inv, sc[4 * i + 3] * inv);
    }
  }
}

struct PeerBuf { u32x4 uq[2]; u32x4 vq[2]; float ius; float gt; };
template <class T> DEVI const T* scalar_base(const T* q) {
  const unsigned long long v = (unsigned long long)q;
  const unsigned lo = (unsigned)__builtin_amdgcn_readfirstlane((int)(unsigned)v), hi = (unsigned)__builtin_amdgcn_readfirstlane((int)(unsigned)(v >> 32));
  return (const T*)(const GLB T*)(((unsigned long long)hi << 32) | lo);
}
DEVI float gelu_as(float d) {
  const float ax = fabsf(d);
  const float x = ax * 0.70710678f;
  const float t = __builtin_amdgcn_rcpf(fmaf(0.3275911f, x, 1.f));
  float pl = fmaf(t, 1.061405429f, -1.453152027f);
  pl = fmaf(pl, t, 1.421413741f); pl = fmaf(pl, t, -0.284496736f); pl = fmaf(pl, t, 0.254829592f);
  pl *= t;
  const float ex = __builtin_amdgcn_exp2f(x * x * -1.44269504f);
  const float erfa = fmaf(-pl, ex, 1.f);
  return 0.5f * fmaf(ax, erfa, d);
}
DEVI void peer_issue(PeerBuf& b, int it, int idxr, float iusr, float givr, const unsigned char* __restrict__ U8, const unsigned char* __restrict__ V8,
                     int g, int j, int lane) {
  const int srcl = (it * 4 + g) & 63;
  const int e = __shfl(idxr, srcl, 64);
  b.ius = __shfl(iusr, srcl, 64);
  b.gt = __shfl(givr, srcl, 64);
  const unsigned uo = (unsigned)(e * 512 + j * 16);
  b.uq[0] = *(const u32x4*)(U8 + uo);
  b.uq[1] = *(const u32x4*)(U8 + uo + 256u);
  const int hf = lane >> 5;
#pragma unroll
  for (int q = 0; q < 2; ++q) {
    const int ev = __shfl(idxr, (it * 4 + 2 * q + hf) & 63, 64);
    b.vq[q] = *(const u32x4*)(V8 + (unsigned)(ev * 512 + (lane & 31) * 16));
  }
}
#define FP4_BF16(W, S) __builtin_bit_cast(unsigned, __builtin_amdgcn_cvt_scalef32_pk_bf16_fp4((W), 1.0f, (S)))
DEVI void peer_compute(const PeerBuf& b, const unsigned (&hq)[32], float (&acc)[32], int lane) {
  float d0 = 0.f, d1 = 0.f, d2 = 0.f, d3 = 0.f;
#pragma unroll
  for (int i = 0; i < 2; ++i)
#pragma unroll
    for (int wi = 0; wi < 4; ++wi) {
      const unsigned w = b.uq[i][wi];
      d0 = dot2bf(hq[i * 16 + wi * 4 + 0], FP4_BF16(w, 0), d0);
      d1 = dot2bf(hq[i * 16 + wi * 4 + 1], FP4_BF16(w, 1), d1);
      d2 = dot2bf(hq[i * 16 + wi * 4 + 2], FP4_BF16(w, 2), d2);
      d3 = dot2bf(hq[i * 16 + wi * 4 + 3], FP4_BF16(w, 3), d3);
    }
  float d = (d0 + d1) + (d2 + d3);
  d = row16_allsum(d) * b.ius;
  const float act = gelu_as(d);
  const float cf = b.gt * act;
  const int hf = lane >> 5;
#pragma unroll
  for (int q = 0; q < 2; ++q) {
    const float cc = __shfl(cf, (2 * q + hf) * 16, 64);
#pragma unroll
    for (int wi = 0; wi < 4; ++wi) {
      const unsigned w = b.vq[q][wi];
      const f32x2 f0 = __builtin_amdgcn_cvt_scalef32_pk_f32_fp4(w, 1.0f, 0);
      const f32x2 f1 = __builtin_amdgcn_cvt_scalef32_pk_f32_fp4(w, 1.0f, 1);
      const f32x2 f2 = __builtin_amdgcn_cvt_scalef32_pk_f32_fp4(w, 1.0f, 2);
      const f32x2 f3 = __builtin_amdgcn_cvt_scalef32_pk_f32_fp4(w, 1.0f, 3);
      acc[wi * 8 + 0] += cc * f0.x; acc[wi * 8 + 1] += cc * f0.y;
      acc[wi * 8 + 2] += cc * f1.x; acc[wi * 8 + 3] += cc * f1.y;
      acc[wi * 8 + 4] += cc * f2.x; acc[wi * 8 + 5] += cc * f2.y;
      acc[wi * 8 + 6] += cc * f3.x; acc[wi * 8 + 7] += cc * f3.y;
    }
  }
}
struct PeerUBuf { u32x4 uq[2]; };
DEVI void peer_uissue(PeerUBuf& b, int it, int idxr, const unsigned char* __restrict__ U8, int g, int j) {
  const int e = __shfl(idxr, (it * 4 + g) & 63, 64);
  const unsigned uo = (unsigned)(e * 512 + j * 16);
  b.uq[0] = *(const u32x4*)(U8 + uo);
  b.uq[1] = *(const u32x4*)(U8 + uo + 256u);
}
DEVI float peer_udot(const PeerUBuf& b, const unsigned (&hq)[32]) {
  float d0 = 0.f, d1 = 0.f, d2 = 0.f, d3 = 0.f;
#pragma unroll
  for (int i = 0; i < 2; ++i)
#pragma unroll
    for (int wi = 0; wi < 4; ++wi) {
      const unsigned w = b.uq[i][wi];
      d0 = dot2bf(hq[i * 16 + wi * 4 + 0], FP4_BF16(w, 0), d0);
      d1 = dot2bf(hq[i * 16 + wi * 4 + 1], FP4_BF16(w, 1), d1);
      d2 = dot2bf(hq[i * 16 + wi * 4 + 2], FP4_BF16(w, 2), d2);
      d3 = dot2bf(hq[i * 16 + wi * 4 + 3], FP4_BF16(w, 3), d3);
    }
  return row16_allsum((d0 + d1) + (d2 + d3));
}
DEVI void phase8a(const ParamsG& p) {
  int tid_ = threadIdx.x; asm volatile("" : "+v"(tid_));
  const int lane = tid_ & 63;
  const int gw = blockIdx.x * NWAVES + (tid_ >> 6), nw = gridDim.x * NWAVES;
  const bf16* H2 = (const bf16*)(gp(p.ws) + OFF_XB);
  const unsigned char* U8 = scalar_base((const unsigned char*)(gp(p.ws) + OFF_U8));
  const float* IUS = (const float*)(gp(p.ws) + OFF_IUS);
  const int* IDX = (const int*)(gp(p.ws) + OFF_IDX);
  float* DD = (float*)(gp(p.ws) + OFF_DD);
  const int g = lane >> 4, j = lane & 15;
  const int srcg = (lane & 3) * 16;
#define U_LOADROW(DST, TT) _Pragma("unroll") for (int i = 0; i < 2; ++i) { const bf16* hp_ = H2 + (size_t)(TT) * DM + i * 512 + j * 32; \
    _Pragma("unroll") for (int c = 0; c < 4; ++c) { const u32x4 a_ = *(const u32x4*)(hp_ + c * 8); \
      DST[i * 16 + c * 4 + 0] = a_.x; DST[i * 16 + c * 4 + 1] = a_.y; DST[i * 16 + c * 4 + 2] = a_.z; DST[i * 16 + c * 4 + 3] = a_.w; } }
#define U_RSTD(SRC) ({ float q0_ = 0.f, q1_ = 0.f; _Pragma("unroll") for (int i = 0; i < 32; i += 2) { q0_ = dot2bf(SRC[i], SRC[i], q0_); q1_ = dot2bf(SRC[i + 1], SRC[i + 1], q1_); } \
    rsqrtf(row16_allsum(q0_ + q1_) * (1.f / DM) + 1e-6f); })
#define UISSUE(B, IT) peer_uissue(B, (IT), ((IT) < 16) ? idx0 : idx1, U8, g, j)
#define UTAKE(B, IT) { const float d_ = __shfl(peer_udot(B, hq), srcg, 64); const bool me_ = (lane >> 2) == ((IT) & 15); \
      if ((IT) < 16) dv0 = me_ ? d_ : dv0; else dv1 = me_ ? d_ : dv1; }
  unsigned hq[32];
  int idx0 = 0, idx1 = 0;
  float iu0 = 0.f, iu1 = 0.f;
  PeerUBuf ba, bb, bc;
#pragma unroll
  for (int i = 0; i < 32; ++i) hq[i] = 0u;
  if (gw < T_TOK) {
    U_LOADROW(hq, gw)
    idx0 = IDX[(size_t)gw * 128 + lane]; idx1 = IDX[(size_t)gw * 128 + 64 + lane];
    const float rstd = U_RSTD(hq);
    iu0 = IUS[idx0] * rstd; iu1 = IUS[idx1] * rstd;
    UISSUE(ba, 0);
    UISSUE(bb, 1);
  }
  for (int t = gw; t < T_TOK; t += nw) {
    const int tn = (t + nw < T_TOK) ? t + nw : t;
    unsigned hqn[32];
    U_LOADROW(hqn, tn)
    const int idxn0 = IDX[(size_t)tn * 128 + lane], idxn1 = IDX[(size_t)tn * 128 + 64 + lane];
    float iun0 = 0.f, iun1 = 0.f;
    float dv0 = 0.f, dv1 = 0.f;
#pragma unroll 1
    for (int it = 0; it < 30; it += 3) {
      UISSUE(bc, it + 2);
      UTAKE(ba, it)
      UISSUE(ba, it + 3);
      UTAKE(bb, it + 1)
      UISSUE(bb, it + 4);
      UTAKE(bc, it + 2)
      if (it == 15) { iun0 = IUS[idxn0]; iun1 = IUS[idxn1]; }
    }
    UTAKE(ba, 30)
    UTAKE(bb, 31)
    const float d0 = dv0 * iu0, d1 = dv1 * iu1;
    const float rstdn = U_RSTD(hqn);
#pragma unroll
    for (int i = 0; i < 32; ++i) hq[i] = hqn[i];
    idx0 = idxn0; idx1 = idxn1; iu0 = iun0 * rstdn; iu1 = iun1 * rstdn;
    if (t + nw < T_TOK) { UISSUE(ba, 0); UISSUE(bb, 1); }
    DD[(size_t)t * 128 + lane] = d0;
    DD[(size_t)t * 128 + 64 + lane] = d1;
  }
#undef UISSUE
#undef UTAKE
#undef U_LOADROW
#undef U_RSTD
}
struct PeerVBuf { u32x4 vq[2]; float cc[2]; };
DEVI void peer_vissue(PeerVBuf& b, int it, int idxr, float cfr, const unsigned char* __restrict__ V8, int lane) {
  const int hf = lane >> 5;
#pragma unroll
  for (int q = 0; q < 2; ++q) {
    const int src = (it * 4 + 2 * q + hf) & 63;
    const int ev = __shfl(idxr, src, 64);
    b.cc[q] = __shfl(cfr, src, 64);
    b.vq[q] = *(const u32x4*)(V8 + (unsigned)(ev * 512 + (lane & 31) * 16));
  }
}
DEVI void peer_vcompute(const PeerVBuf& b, float (&acc)[32]) {
#pragma unroll
  for (int q = 0; q < 2; ++q) {
    const float cc = b.cc[q];
#pragma unroll
    for (int wi = 0; wi < 4; ++wi) {
      const unsigned w = b.vq[q][wi];
      const f32x2 f0 = __builtin_amdgcn_cvt_scalef32_pk_f32_fp4(w, 1.0f, 0);
      const f32x2 f1 = __builtin_amdgcn_cvt_scalef32_pk_f32_fp4(w, 1.0f, 1);
      const f32x2 f2 = __builtin_amdgcn_cvt_scalef32_pk_f32_fp4(w, 1.0f, 2);
      const f32x2 f3 = __builtin_amdgcn_cvt_scalef32_pk_f32_fp4(w, 1.0f, 3);
      acc[wi * 8 + 0] += cc * f0.x; acc[wi * 8 + 1] += cc * f0.y;
      acc[wi * 8 + 2] += cc * f1.x; acc[wi * 8 + 3] += cc * f1.y;
      acc[wi * 8 + 4] += cc * f2.x; acc[wi * 8 + 5] += cc * f2.y;
      acc[wi * 8 + 6] += cc * f3.x; acc[wi * 8 + 7] += cc * f3.y;
    }
  }
}
template <bool DRY> DEVI void phase8(const ParamsG& p) {
  int tid_ = threadIdx.x; asm volatile("" : "+v"(tid_));
  const int lane = tid_ & 63;
  const int gw = blockIdx.x * NWAVES + (tid_ >> 6), nw = gridDim.x * NWAVES;
  const unsigned char* V8 = scalar_base((const unsigned char*)(gp(p.ws) + OFF_V8));
  const float* IVS = (const float*)(gp(p.ws) + OFF_IVS);
  const int* IDX = (const int*)(gp(p.ws) + OFF_IDX);
  const float* GATE = (const float*)(gp(p.ws) + OFF_GATE);
  const float* DD = (const float*)(gp(p.ws) + OFF_DD);
  bf16* H3 = (bf16*)(gp(p.ws) + OFF_H3);
  const int ocol = (lane & 31) * 32 + (lane >> 5) * 16;
  f32x4 gpl[4];
#pragma unroll
  for (int i = 0; i < 4; ++i) gpl[i] = *(const f32x4*)(gp(p.norm_ple) + ocol + i * 4);
  const bf16* XBr = (const bf16*)(gp(p.ws) + OFF_XB);
  int idx0 = 0, idx1 = 0; float gt0 = 0.f, gt1 = 0.f, dd0 = 0.f, dd1 = 0.f, iv0 = 0.f, iv1 = 0.f;
  bf16x8 xa, xc;
#pragma unroll
  for (int i = 0; i < 8; ++i) { xa[i] = (bf16)0.f; xc[i] = (bf16)0.f; }
  if (gw < T_TOK) {
    idx0 = IDX[(size_t)gw * 128 + lane]; idx1 = IDX[(size_t)gw * 128 + 64 + lane];
    gt0 = GATE[(size_t)gw * 128 + lane]; gt1 = GATE[(size_t)gw * 128 + 64 + lane];
    dd0 = DD[(size_t)gw * 128 + lane]; dd1 = DD[(size_t)gw * 128 + 64 + lane];
    xa = *(const bf16x8*)(XBr + (size_t)gw * DM + ocol); xc = *(const bf16x8*)(XBr + (size_t)gw * DM + ocol + 8);
    iv0 = IVS[idx0]; iv1 = IVS[idx1];
  }
  float cf0 = gt0 * iv0 * gelu_as(dd0), cf1 = gt1 * iv1 * gelu_as(dd1);
  PeerVBuf ba, bb, bc;
#define PISSUE(B, IT) peer_vissue(B, (IT), ((IT) < 16) ? idx0 : idx1, ((IT) < 16) ? cf0 : cf1, V8, lane)
  if (gw < T_TOK) { PISSUE(ba, 0); PISSUE(bb, 1); }
  for (int t = gw; t < T_TOK; t += nw) {
    const int tn = (t + nw < T_TOK) ? t + nw : t;
    const int idxn0 = IDX[(size_t)tn * 128 + lane], idxn1 = IDX[(size_t)tn * 128 + 64 + lane];
    const float gtn0 = GATE[(size_t)tn * 128 + lane], gtn1 = GATE[(size_t)tn * 128 + 64 + lane];
    const float ddn0 = DD[(size_t)tn * 128 + lane], ddn1 = DD[(size_t)tn * 128 + 64 + lane];
    const bf16x8 xan = *(const bf16x8*)(XBr + (size_t)tn * DM + ocol), xcn = *(const bf16x8*)(XBr + (size_t)tn * DM + ocol + 8);
    float acc[32];
#pragma unroll
    for (int i = 0; i < 32; ++i) acc[i] = 0.f;
    float ivn0 = 0.f, ivn1 = 0.f;
#pragma unroll 1
    for (int it = 0; it < 30; it += 3) {
      PISSUE(bc, it + 2);
      peer_vcompute(ba, acc);
      PISSUE(ba, it + 3);
      peer_vcompute(bb, acc);
      PISSUE(bb, it + 4);
      peer_vcompute(bc, acc);
      if (it == 15) { ivn0 = IVS[idxn0]; ivn1 = IVS[idxn1]; }
    }
    peer_vcompute(ba, acc);
    peer_vcompute(bb, acc);
    idx0 = idxn0; idx1 = idxn1;
    cf0 = gtn0 * ivn0 * gelu_as(ddn0); cf1 = gtn1 * ivn1 * gelu_as(ddn1);
    if (t + nw < T_TOK) { PISSUE(ba, 0); PISSUE(bb, 1); }
    float keep[16];
    const bool hi = (lane >> 5) != 0;
#pragma unroll
    for (int i = 0; i < 16; ++i) {
      const float mine = hi ? acc[16 + i] : acc[i];
      const float give = hi ? acc[i] : acc[16 + i];
      keep[i] = mine + __shfl_xor(give, 32, 64);
    }
    bf16* xo = (bf16*)(gp(p.ws) + OFF_XB) + (size_t)t * DM + ocol;
    f32x4 xv[4];
    float ss = 0.f;
    {
      bf16x8 ya, yc;
#pragma unroll
      for (int i = 0; i < 2; ++i) {
        xv[i].x = (float)xa[i * 4 + 0] + keep[i * 4 + 0]; xv[i].y = (float)xa[i * 4 + 1] + keep[i * 4 + 1];
        xv[i].z = (float)xa[i * 4 + 2] + keep[i * 4 + 2]; xv[i].w = (float)xa[i * 4 + 3] + keep[i * 4 + 3];
        xv[2 + i].x = (float)xc[i * 4 + 0] + keep[8 + i * 4 + 0]; xv[2 + i].y = (float)xc[i * 4 + 1] + keep[8 + i * 4 + 1];
        xv[2 + i].z = (float)xc[i * 4 + 2] + keep[8 + i * 4 + 2]; xv[2 + i].w = (float)xc[i * 4 + 3] + keep[8 + i * 4 + 3];
        ya[i * 4 + 0] = (bf16)xv[i].x; ya[i * 4 + 1] = (bf16)xv[i].y; ya[i * 4 + 2] = (bf16)xv[i].z; ya[i * 4 + 3] = (bf16)xv[i].w;
        yc[i * 4 + 0] = (bf16)xv[2 + i].x; yc[i * 4 + 1] = (bf16)xv[2 + i].y; yc[i * 4 + 2] = (bf16)xv[2 + i].z; yc[i * 4 + 3] = (bf16)xv[2 + i].w;
      }
#pragma unroll
      for (int i = 0; i < 4; ++i) ss += xv[i].x * xv[i].x + xv[i].y * xv[i].y + xv[i].z * xv[i].z + xv[i].w * xv[i].w;
      if (!DRY) { *(bf16x8*)xo = ya; *(bf16x8*)(xo + 8) = yc; }
    }
    ss = wave_sum(ss);
    const float rs = rsqrtf(ss * (1.f / DM) + 1e-6f);
    bf16x8 o0, o1;
    o0[0] = (bf16)(xv[0].x * rs * gpl[0].x); o0[1] = (bf16)(xv[0].y * rs * gpl[0].y); o0[2] = (bf16)(xv[0].z * rs * gpl[0].z); o0[3] = (bf16)(xv[0].w * rs * gpl[0].w);
    o0[4] = (bf16)(xv[1].x * rs * gpl[1].x); o0[5] = (bf16)(xv[1].y * rs * gpl[1].y); o0[6] = (bf16)(xv[1].z * rs * gpl[1].z); o0[7] = (bf16)(xv[1].w * rs * gpl[1].w);
    o1[0] = (bf16)(xv[2].x * rs * gpl[2].x); o1[1] = (bf16)(xv[2].y * rs * gpl[2].y); o1[2] = (bf16)(xv[2].z * rs * gpl[2].z); o1[3] = (bf16)(xv[2].w * rs * gpl[2].w);
    o1[4] = (bf16)(xv[3].x * rs * gpl[3].x); o1[5] = (bf16)(xv[3].y * rs * gpl[3].y); o1[6] = (bf16)(xv[3].z * rs * gpl[3].z); o1[7] = (bf16)(xv[3].w * rs * gpl[3].w);
    *(bf16x8*)(H3 + (size_t)t * DM + ocol) = o0;
    *(bf16x8*)(H3 + (size_t)t * DM + ocol + 8) = o1;
    xa = xan; xc = xcn;
  }
#undef PISSUE
}

struct EpiX3 {
  static constexpr bool PERM = true, AFTER_DRAIN = false;
  const bf16* pps; bf16* xb;
  DEVI void operator()(PgAcc acc, const pg8::Unit& u, int wr, int wc, int fr, int fq) const {
    bf16x4 lp[2][4]; bf16x4 lx[2][4];
    PG_EPI_PIPELINED(
      lp[slot][c] = *(const bf16x4*)(pps + off); lx[slot][c] = *(const bf16x4*)(xb + off); ,
      const bf16x4 pp = lp[slot][c];
      const bf16x4 xi = lx[slot][c];
      bf16x4 xo;
      xo[0] = (bf16)((float)xi[0] + sigmoid_f(v.x) * (float)pp[0]); xo[1] = (bf16)((float)xi[1] + sigmoid_f(v.y) * (float)pp[1]);
      xo[2] = (bf16)((float)xi[2] + sigmoid_f(v.z) * (float)pp[2]); xo[3] = (bf16)((float)xi[3] + sigmoid_f(v.w) * (float)pp[3]);
      *(bf16x4*)(xb + off) = xo;
    )
  }
};
DEVI void phase10(const ParamsG& p, unsigned char* smem) {
  bf16* PPS = (bf16*)(gp(p.ws) + OFF_H2);
  { EpiMix<0> e; e.D = PPS; e.S = nullptr; run_gemm(smem, (const bf16*)(gp(p.ws) + OFF_PBF), (const bf16*)(gp(p.ws) + OFF_PP_T), T_TOK, DM, 256, e); }
  { EpiX3 e; e.pps = PPS; e.xb = (bf16*)(gp(p.ws) + OFF_XB); run_gemm(smem, (const bf16*)(gp(p.ws) + OFF_H3), (const bf16*)(gp(p.ws) + OFF_PG_T), T_TOK, DM, DM, e); }
}

DEVI void phase11(const ParamsG& p) {
  int tid_ = threadIdx.x; asm volatile("" : "+v"(tid_));
  const int lane = tid_ & 63;
  const int gw = blockIdx.x * NWAVES + (tid_ >> 6), nw = gridDim.x * NWAVES;
  f32x4 gn[4];
#pragma unroll
  for (int i = 0; i < 4; ++i) gn[i] = *(const f32x4*)(gp(p.norm_final) + i * 256 + lane * 4);
  for (int t = gw; t < T_TOK; t += nw) {
    float* xr = gp(p.out) + (size_t)t * DM;
    const bf16* xs = (const bf16*)(gp(p.ws) + OFF_XB) + (size_t)t * DM;
    f32x4 v[4];
    float ss = 0.f;
#pragma unroll
    for (int i = 0; i < 4; ++i) {
      const bf16x4 b4 = *(const bf16x4*)(xs + i * 256 + lane * 4);
      v[i].x = (float)b4[0]; v[i].y = (float)b4[1]; v[i].z = (float)b4[2]; v[i].w = (float)b4[3];
      ss += v[i].x * v[i].x + v[i].y * v[i].y + v[i].z * v[i].z + v[i].w * v[i].w;
    }
    ss = wave_sum(ss);
    const float rs = rsqrtf(ss * (1.f / DM) + 1e-6f);
#pragma unroll
    for (int i = 0; i < 4; ++i) {
      f32x4 o;
      o.x = v[i].x * rs * gn[i].x; o.y = v[i].y * rs * gn[i].y; o.z = v[i].z * rs * gn[i].z; o.w = v[i].w * rs * gn[i].w;
      *(f32x4*)(xr + i * 256 + lane * 4) = o;
    }
  }
}

constexpr int N_PHASES = 16;
__global__ void __launch_bounds__(NTHREADS, 2) hybrid_block_kernel(Params p_arg, int ph0, int ph1) {
  extern __shared__ __attribute__((aligned(1024))) unsigned char smem[];
  cg::grid_group grid = cg::this_grid();
  Params* ptab = (Params*)(p_arg.ws + OFF_PTAB) + blockIdx.x;
  if (threadIdx.x == 0) *ptab = p_arg;
  __syncthreads();
  const ParamsG& p = *(const ParamsG*)ptab;
#ifndef DUP_PHASE
#define DUP_PHASE -1
#endif
  volatile LAS unsigned* xst = (volatile LAS unsigned*)(smem + LDS_BYTES - 256);
  if (threadIdx.x == 0) { xst[0] = 0u; xst[1] = 0u; }
  __syncthreads();
#define GSYNC(K) { if ((K) == 0) { grid.sync(); (void)xcd_barrier_post((unsigned*)(gp(p.ws) + OFF_BAR), xst); } else { XcdBarrier xb_; xb_.bar = (unsigned*)(gp(p.ws) + OFF_BAR); xb_.x = xb_xcc_id(); xb_.st = xst; xcd_barrier(xb_); } }
#define RUN_PHASE(K, CALL) if (ph0 <= (K) && (K) < ph1) { \
    if (DUP_PHASE == (K)) { CALL; GSYNC(1) } \
    CALL; if ((K) + 1 < ph1) GSYNC(K) }
  RUN_PHASE(0, phase0(p, smem))
  RUN_PHASE(1, phase1(p, smem))
  RUN_PHASE(2, phase2a(p))
  RUN_PHASE(3, phase2b(p, smem))
#ifdef SEQ_SCAN
  RUN_PHASE(4, { phase3a(p, smem); __syncthreads(); phase3b(p, smem); })
  RUN_PHASE(5, { })
  RUN_PHASE(6, { })
#else
  RUN_PHASE(4, phase3b(p, smem))
  RUN_PHASE(5, phase3A(p, smem))
  RUN_PHASE(6, phase3B(p, smem))
#endif
  RUN_PHASE(7, phase3c(p))
  RUN_PHASE(8, phase4(p, smem))
  RUN_PHASE(9, phase5(p, smem))
  RUN_PHASE(10, phase7(p, smem))
  RUN_PHASE(11, phase7b(p, smem))
  RUN_PHASE(12, phase8a(p))
  RUN_PHASE(13, phase8<false>(p))
  RUN_PHASE(14, phase10(p, smem))
  RUN_PHASE(15, phase11(p))
#undef RUN_PHASE
}

extern "C" void kernel_launch(void* const* d_in, const int* in_sizes, int n_in, void* d_out, int out_size, void* d_ws,
                              size_t ws_size, hipStream_t stream) {
  static int grid_blocks = 0;
  if (!grid_blocks) {
    int dev = 0, cus = 0, per_cu = 0;
    hipGetDevice(&dev);
    hipDeviceGetAttribute(&cus, hipDeviceAttributeMultiprocessorCount, dev);
    hipFuncSetAttribute((const void*)hybrid_block_kernel, hipFuncAttributeMaxDynamicSharedMemorySize, LDS_BYTES);
    hipOccupancyMaxActiveBlocksPerMultiprocessor(&per_cu, hybrid_block_kernel, NTHREADS, LDS_BYTES);
    if (per_cu > 1) per_cu = 1;
    if (per_cu < 1) per_cu = 1;
    grid_blocks = cus * per_cu;
  }
  Params p{};
  const float** fp = (const float**)&p;
  for (int i = 0; i < 32; ++i) fp[i] = (const float*)d_in[i];
  p.pos = (const int*)d_in[2];
  p.out = (float*)d_out;
  p.ws = (unsigned char*)d_ws;
#ifndef MULTI_LAUNCH
  int ph0 = 0, ph1 = N_PHASES;
  void* args[] = {&p, &ph0, &ph1};
  hipError_t e = hipLaunchCooperativeKernel((void*)hybrid_block_kernel, dim3(grid_blocks), dim3(NTHREADS), args, LDS_BYTES, stream);
  if (e != hipSuccess) fprintf(stderr, "cooperative launch failed: %s (grid %d)\n", hipGetErrorString(e), grid_blocks);
#else
  for (int ph = 0; ph < N_PHASES; ++ph)
    hipLaunchKernelGGL(hybrid_block_kernel, dim3(grid_blocks), dim3(NTHREADS), LDS_BYTES, stream, p, ph, ph + 1);
#endif
}
```

```cpp
#include <hip/hip_runtime.h>
#include <hip/hip_cooperative_groups.h>
#include <stdint.h>
#include <stdio.h>
namespace cg = cooperative_groups;

typedef __bf16 bf16;
typedef __attribute__((ext_vector_type(8))) __bf16 bf16x8;
typedef __attribute__((ext_vector_type(4))) __bf16 bf16x4;
typedef __attribute__((ext_vector_type(2))) __bf16 bf16x2;
typedef __attribute__((ext_vector_type(16))) float f32x16;
typedef __attribute__((ext_vector_type(4))) float f32x4;
typedef __attribute__((ext_vector_type(2))) float f32x2;
typedef __attribute__((ext_vector_type(4))) unsigned u32x4;
typedef __attribute__((ext_vector_type(2))) unsigned u32x2;
typedef __attribute__((ext_vector_type(4))) int i32x4;

#define DEVI __device__ __forceinline__
#ifndef ABL
#define ABL 0
#endif

constexpr int T_TOK = 32768;
constexpr int SEQ = 4096;
constexpr int DM = 1024;
constexpr int IN_COLS = 4512;
constexpr int RWC = 1792;
constexpr int MLC = 672;
constexpr int NTHREADS = 512;
constexpr int NWAVES = 8;
constexpr int LDS_BYTES = 148480;

constexpr size_t MiB = 1ull << 20;
constexpr size_t OFF_WIN_T = 0;
constexpr size_t OFF_WG_T = 5 * MiB;
constexpr size_t OFF_WLORA_T = 9 * MiB;
constexpr size_t OFF_RWO_T = 10 * MiB;
constexpr size_t OFF_MLO_T = 11 * MiB;
constexpr size_t OFF_WUQ_T = 12 * MiB;
constexpr size_t OFF_WUKV_T = 13 * MiB;
constexpr size_t OFF_PP_T = 13 * MiB + 524288;
constexpr size_t OFF_WOUT_T = 14 * MiB;
constexpr size_t OFF_PG_T = 16 * MiB;
constexpr size_t OFF_WQ_T = 18 * MiB;
constexpr size_t OFF_SK = 22 * MiB;
constexpr size_t OFF_CNT = 22 * MiB + 524288;
constexpr size_t OFF_BAR = 22 * MiB + 524288 + 65536;
constexpr size_t OFF_PTAB = 22 * MiB + 524288 + 131072;
constexpr size_t OFF_CS = 23 * MiB;
constexpr size_t OFF_SN = 25 * MiB;
constexpr size_t OFF_RK = 27 * MiB;
constexpr size_t OFF_PBF = 28 * MiB;
constexpr size_t OFF_U8 = 44 * MiB;
constexpr size_t OFF_V8 = 60 * MiB;
constexpr size_t OFF_IUS = 76 * MiB;
constexpr size_t OFF_IVS = 76 * MiB + 65536;
constexpr size_t OFF_H1 = 108 * MiB;
constexpr size_t OFF_ZRW = 172 * MiB;
constexpr size_t OFF_ZMLA = 284 * MiB;
constexpr size_t OFF_LORA = 326 * MiB;
constexpr size_t OFF_CQ = 342 * MiB;
constexpr size_t OFF_CKV = 366 * MiB;
constexpr size_t OFF_E = 382 * MiB;
constexpr size_t OFF_ICLR = 446 * MiB;
constexpr size_t OFF_G = 478 * MiB;
constexpr size_t OFF_O = 284 * MiB;
constexpr size_t OFF_YRAW = 326 * MiB;
constexpr size_t OFF_YAPRE = 358 * MiB;
constexpr size_t OFF_M = 172 * MiB;
constexpr size_t OFF_M2 = 390 * MiB;
constexpr size_t OFF_H2 = 382 * MiB;
constexpr size_t OFF_TOPK = 236 * MiB;
constexpr size_t OFF_IDX = 446 * MiB;
constexpr size_t OFF_GATE = 462 * MiB;
constexpr size_t OFF_H3 = 172 * MiB;
constexpr size_t OFF_DD = 326 * MiB;
constexpr size_t OFF_XB = 108 * MiB;
constexpr size_t OFF_Q = 0;
constexpr size_t OFF_K = 48 * MiB;
constexpr size_t OFF_VT = 96 * MiB;

struct Params {
  const float* x; const float* p; const int* pos; const float* norm_mix; const float* w_in; const float* rw_mu;
  const float* rw_w0; const float* rw_w2; const float* rw_a0; const float* rw_a2; const float* rw_g2; const float* rw_k_k;
  const float* rw_k_a; const float* rw_r_k; const float* rw_gn_w; const float* rw_gn_b; const float* rw_w_o;
  const float* mla_q_norm; const float* mla_w_uq; const float* mla_kv_norm; const float* mla_w_ukv; const float* mla_w_o;
  const float* w_out; const float* norm_ffn; const float* peer_w_q; const float* peer_sub_keys; const float* peer_u;
  const float* peer_v; const float* norm_ple; const float* ple_w_gate; const float* ple_w_proj; const float* norm_final;
  float* out; unsigned char* ws;
};
#define GLB __attribute__((address_space(1)))
struct ParamsG {
  const GLB float* x; const GLB float* p; const GLB int* pos; const GLB float* norm_mix; const GLB float* w_in; const GLB float* rw_mu;
  const GLB float* rw_w0; const GLB float* rw_w2; const GLB float* rw_a0; const GLB float* rw_a2; const GLB float* rw_g2; const GLB float* rw_k_k;
  const GLB float* rw_k_a; const GLB float* rw_r_k; const GLB float* rw_gn_w; const GLB float* rw_gn_b; const GLB float* rw_w_o;
  const GLB float* mla_q_norm; const GLB float* mla_w_uq; const GLB float* mla_kv_norm; const GLB float* mla_w_ukv; const GLB float* mla_w_o;
  const GLB float* w_out; const GLB float* norm_ffn; const GLB float* peer_w_q; const GLB float* peer_sub_keys; const GLB float* peer_u;
  const GLB float* peer_v; const GLB float* norm_ple; const GLB float* ple_w_gate; const GLB float* ple_w_proj; const GLB float* norm_final;
  GLB float* out; GLB unsigned char* ws;
};
template <class T> DEVI T* gp(GLB T* q) { return (T*)q; }

DEVI u32x4 mk_u4(unsigned a, unsigned b, unsigned c, unsigned d) { u32x4 v; v.x = a; v.y = b; v.z = c; v.w = d; return v; }
DEVI u32x2 mk_u2(unsigned a, unsigned b) { u32x2 v; v.x = a; v.y = b; return v; }
DEVI f32x4 mk_f4(float a, float b, float c, float d) { f32x4 v; v.x = a; v.y = b; v.z = c; v.w = d; return v; }
DEVI i32x4 mk_i4(int a, int b, int c, int d) { i32x4 v; v.x = a; v.y = b; v.z = c; v.w = d; return v; }
DEVI float wave_sum(float v) {
#pragma unroll
  for (int o = 32; o > 0; o >>= 1) v += __shfl_xor(v, o, 64);
  return v;
}
template <int CTRL> DEVI float dpp_f(float v) {
  return __int_as_float(__builtin_amdgcn_update_dpp(0, __float_as_int(v), CTRL, 0xf, 0xf, true));
}
DEVI float row16_allsum(float v) {
  v += dpp_f<0xB1>(v);
  v += dpp_f<0x4E>(v);
  v += dpp_f<0x141>(v);
  v += dpp_f<0x140>(v);
  return v;
}
DEVI float row8_allsum(float v) {
  v += dpp_f<0xB1>(v);
  v += dpp_f<0x4E>(v);
  v += dpp_f<0x141>(v);
  return v;
}
DEVI float sigmoid_f(float x) { return __builtin_amdgcn_rcpf(1.f + __expf(-x)); }
DEVI float bflo(unsigned u) { return __uint_as_float(u << 16); }
DEVI float bfhi(unsigned u) { return __uint_as_float(u & 0xffff0000u); }
DEVI unsigned pack2(float a, float b) {
  bf16x2 v; v[0] = (bf16)a; v[1] = (bf16)b;
  return __builtin_bit_cast(unsigned, v);
}
DEVI float dot2bf(unsigned a, unsigned b, float c) {
  return __builtin_amdgcn_fdot2_f32_bf16(__builtin_bit_cast(bf16x2, a), __builtin_bit_cast(bf16x2, b), c, false);
}


#define XB_TMO      128
#define XB_XCNT(j)  (256  + 64 * (j))
#define XB_XSUB(j)  (1280 + 64 * (j))
#define XB_XGEN(j)  (2304 + 64 * (j))
#define XB_TOP      3328
#define XB_TOPGEN   3392
#define XCD_BAR_WORDS 3456
#define XB_SPIN_CAP (1u << 22)
#define LAS __attribute__((address_space(3)))
DEVI unsigned xb_ld(unsigned* p) { return __hip_atomic_load(p, __ATOMIC_RELAXED, __HIP_MEMORY_SCOPE_AGENT); }
DEVI unsigned xb_add(unsigned* p, unsigned v) { return __hip_atomic_fetch_add(p, v, __ATOMIC_RELAXED, __HIP_MEMORY_SCOPE_AGENT); }
DEVI unsigned xb_xcc_id() { return (unsigned)__builtin_amdgcn_s_getreg((3 << 11) | 20) & 0xFu; }
#define XB_SPIN(cond, bar) do { unsigned _sp = 0; while (cond) { __builtin_amdgcn_s_sleep(1); \
    if ((++_sp & 255u) == 0u) { if (xb_ld(&(bar)[XB_TMO])) break; if (_sp > XB_SPIN_CAP) { atomicAdd(&(bar)[XB_TMO], 1u); break; } } } } while (0)
struct XcdBarrier { unsigned* bar; unsigned x; volatile LAS unsigned* st; };
DEVI XcdBarrier xcd_barrier_post(unsigned* bar, volatile LAS unsigned* st) {
  XcdBarrier b; b.bar = bar; b.x = xb_xcc_id(); b.st = st;
  if (threadIdx.x == 0) (void)xb_add(&bar[XB_XCNT(b.x)], 1u);
  return b;
}
DEVI void xcd_barrier_complete(unsigned* bar, unsigned x, unsigned& nloc, unsigned& nx) {
  const unsigned G = gridDim.x * gridDim.y * gridDim.z;
  unsigned sum, cnt, mine, sp = 0u;
  for (;;) {
    sum = 0u; cnt = 0u; mine = 0u;
#pragma unroll
    for (unsigned j = 0; j < 16; ++j) { const unsigned c = xb_ld(&bar[XB_XCNT(j)]); sum += c; cnt += (c > 0u) ? 1u : 0u; mine = (j == x) ? c : mine; }
    if (sum == G) break;
    __builtin_amdgcn_s_sleep(1);
    if ((++sp & 255u) == 0u) { if (xb_ld(&bar[XB_TMO])) break; if (sp > XB_SPIN_CAP) { atomicAdd(&bar[XB_TMO], 1u); break; } }
  }
  nloc = mine > 0u ? mine : 1u; nx = cnt > 0u ? cnt : 1u;
}
DEVI void xcd_barrier(const XcdBarrier& b) {
  asm volatile("s_waitcnt vmcnt(0)" ::: "memory");
  __syncthreads();
  if (threadIdx.x == 0) {
    unsigned* bar = b.bar;
    __builtin_amdgcn_s_waitcnt(0);
    unsigned nloc = b.st[0], nx = b.st[1];
    if (nloc == 0u) { xcd_barrier_complete(bar, b.x, nloc, nx); b.st[0] = nloc; b.st[1] = nx; }
    const unsigned old = xb_add(&bar[XB_XSUB(b.x)], 1u);
    const unsigned gen = old / nloc;
    if (old + 1u == (gen + 1u) * nloc) {
      __builtin_amdgcn_fence(__ATOMIC_RELEASE, "agent");
      asm volatile("s_waitcnt vmcnt(0)" ::: "memory");
      const unsigned og = xb_add(&bar[XB_TOP], 1u);
      const unsigned tg = og / nx;
      if (og + 1u == (tg + 1u) * nx) xb_add(&bar[XB_TOPGEN], 1u);
      else XB_SPIN(xb_ld(&bar[XB_TOPGEN]) == tg, bar);
      __builtin_amdgcn_fence(__ATOMIC_ACQUIRE, "agent");
      xb_add(&bar[XB_XGEN(b.x)], 1u);
      asm volatile("s_waitcnt vmcnt(0)" ::: "memory");
    } else {
      XB_SPIN(xb_ld(&bar[XB_XGEN(b.x)]) == gen, bar);
      __builtin_amdgcn_fence(__ATOMIC_ACQUIRE, "agent");
      asm volatile("s_waitcnt vmcnt(0)" ::: "memory");
    }
  }
  __syncthreads();
}

namespace pg8 {
#define PG8_LAS __attribute__((address_space(3)))
typedef unsigned short bf16_t;
typedef short bf16x8 __attribute__((ext_vector_type(8)));
typedef float f32x4 __attribute__((ext_vector_type(4)));
typedef unsigned u32x4 __attribute__((ext_vector_type(4)));
constexpr int BM = 256, BK = 64, HALF = 128, HTB = HALF * BK * 2  , STAGE_BYTES = 8 * HTB, NXCD = 8, WGM = 8;

__host__ __device__ __forceinline__ int lds_byte(int r, int c) { const int st = (r >> 4) * 2 + (c >> 5), rr = r & 15, cc = c & 31, ob = rr * 64 + cc * 2; return st * 1024 + (ob ^ (((ob >> 9) & 1) << 5)); }
__host__ __device__ __forceinline__ void stage_rc(int b, int& R, int& C) { const int st = b / 1024, sb = b % 1024, swz = sb ^ (((sb >> 9) & 1) << 5); R = (st >> 1) * 16 + swz / 64; C = (st & 1) * 32 + (swz % 64) / 2; }
__host__ __device__ __forceinline__ int perm32(int rho) { const int n = rho >> 4, i = rho & 15; return 8 * (i >> 2) + 4 * n + (i & 3); }

struct Unit { int pm, pn; };
struct Gemm { const bf16_t* A; const bf16_t* Bt; int M, N, K; };

struct StaticOrder {
    int nM, nN, nwg, G, c;
    __host__ __device__ void init(int M, int N, int G_, int c_) { nM = M / BM; nN = N / BM; nwg = nM * nN; G = G_; c = c_; }
    __host__ __device__ bool next(int i, Unit& u) const {
        const long L = (long)i * G + c; if (L >= nwg) return false;
        int wgid = (int)L; { const int q = nwg / NXCD, r = nwg % NXCD, xcd = wgid % NXCD, off = wgid / NXCD; wgid = (xcd < r ? xcd * (q + 1) : r * (q + 1) + (xcd - r) * q) + off; }
        const int nig = WGM * nN, gid = wgid / nig, fm = gid * WGM, gsz = (nM - fm) < WGM ? (nM - fm) : WGM;
        u.pm = fm + ((wgid % nig) % gsz); u.pn = (wgid % nig) / gsz; return true;
    }
    __device__ __forceinline__ void a_ready(const Unit&) const {}
    __device__ __forceinline__ void done(const Unit&) const {}
};

template <class Epi, class Sched, bool STAMP = false>
__device__ __forceinline__ void gemm_phase(PG8_LAS unsigned char* lds, const Gemm g, const Sched& S, const Epi& E, unsigned long long* stamps) {
    int tid_ = threadIdx.x; asm volatile("" : "+v"(tid_));
    const int tid = tid_, wid = __builtin_amdgcn_readfirstlane(tid >> 6), lane = tid & 63, wr = wid >> 2, wc = wid & 3, fr = lane & 15, fq = lane >> 4;
    const int K = g.K, nt = K / BK;
    int ts_lo = 0, ts_hi = 0, nts = 0; const unsigned long long rt_entry = STAMP ? (unsigned long long)wall_clock64() : 0ull;
#define PG8_STAMP() do { if (STAMP && wid == 0 && nts < 64) { const unsigned long long _c = (unsigned long long)clock64(); \
        ts_lo = (lane == nts) ? (int)(unsigned)_c : ts_lo; ts_hi = (lane == nts) ? (int)(unsigned)(_c >> 32) : ts_hi; ++nts; } } while (0)
    PG8_STAMP();
    unsigned voffA[2], voffB[2];
#pragma unroll
    for (int i = 0; i < 2; ++i) { int R, C; stage_rc(tid * 16 + i * 8192, R, C); const int Rb = Epi::PERM ? ((R & ~31) + perm32(R & 31)) : R;
        voffA[i] = (unsigned)(R * K + C) * 2u; voffB[i] = (unsigned)(Rb * K + C) * 2u; }
    const size_t kstep = (size_t)(BK * 2);
    const size_t hstep = (size_t)HALF * K * 2;
    const size_t tstep = 2 * hstep;
    const unsigned ldsw = (unsigned)wid * 1024u;
    const int aoff = lds_byte(wr * 64 + fr, fq * 8), boff = lds_byte(wc * 32 + fr, fq * 8);
#define PG8_SA(b, h) (((b) * 2 + (h)) * HTB)
#define PG8_SB(b, h) ((4 + (b) * 2 + (h)) * HTB)
#define PG8_STAGE(bufoff, gbase, voff) do { _Pragma("unroll") for (int _i = 0; _i < 2; ++_i) \
        __builtin_amdgcn_global_load_lds((const unsigned*)((const char*)(gbase) + (voff)[_i]), (PG8_LAS unsigned*)(lds + (bufoff) + ldsw + _i * 8192), 16, 0, 0); } while (0)
#define PG8_LDA(dst, b, h) do { _Pragma("unroll") for (int m = 0; m < 4; ++m) _Pragma("unroll") for (int k = 0; k < 2; ++k) dst[m][k] = *(const PG8_LAS bf16x8*)(lds + PG8_SA(b, h) + aoff + m * 2048 + k * 1024); } while (0)
#define PG8_LDB(dst, b, h) do { _Pragma("unroll") for (int n = 0; n < 2; ++n) _Pragma("unroll") for (int k = 0; k < 2; ++k) dst[n][k] = *(const PG8_LAS bf16x8*)(lds + PG8_SB(b, h) + boff + n * 2048 + k * 1024); } while (0)
#define PG8_MMA(ai, bj, At, Bt) do { __builtin_amdgcn_s_setprio(1); _Pragma("unroll") for (int m = 0; m < 4; ++m) _Pragma("unroll") for (int n = 0; n < 2; ++n) _Pragma("unroll") for (int k = 0; k < 2; ++k) \
        acc[ai][bj][m][n] = __builtin_amdgcn_mfma_f32_16x16x32_bf16(Bt[n][k], At[m][k], acc[ai][bj][m][n], 0, 0, 0); __builtin_amdgcn_s_setprio(0); } while (0)
#define PG8_WAIT_V(n) asm volatile("s_waitcnt vmcnt(" #n ")" ::: "memory")
#define PG8_WAIT_L(n) asm volatile("s_waitcnt lgkmcnt(" #n ")" ::: "memory")
#define PG8_BAR __builtin_amdgcn_s_barrier()
#define PG8_SCHED __builtin_amdgcn_sched_barrier(0)
    Unit cur, nxt; int ui = 0;
    if (!S.next(0, cur)) return;
    f32x4 acc[2][2][4][2];
#pragma unroll
    for (int a = 0; a < 2; ++a)
#pragma unroll
        for (int b = 0; b < 2; ++b)
#pragma unroll
            for (int m = 0; m < 4; ++m)
#pragma unroll
                for (int n = 0; n < 2; ++n) acc[a][b][m][n] = (f32x4){0.f, 0.f, 0.f, 0.f};
    bf16x8 At[4][2], B0[2][2], B1[2][2];
    const char* cA = (const char*)g.A + (size_t)cur.pm * tstep; const char* cB = (const char*)g.Bt + (size_t)cur.pn * tstep;
    S.a_ready(cur);
    PG8_STAGE(PG8_SB(0, 0), cB, voffB); PG8_STAGE(PG8_SA(0, 0), cA, voffA); PG8_STAGE(PG8_SB(0, 1), cB + hstep, voffB); PG8_STAGE(PG8_SA(0, 1), cA + hstep, voffA);
    if (wr == 1) PG8_BAR;
    PG8_WAIT_V(4); PG8_BAR;
    PG8_STAGE(PG8_SB(1, 0), cB + kstep, voffB); PG8_STAGE(PG8_SA(1, 0), cA + kstep, voffA); PG8_STAGE(PG8_SB(1, 1), cB + hstep + kstep, voffB);
    PG8_WAIT_V(6); PG8_BAR;
    PG8_STAMP();
    for (;;) {
        const bool has_next = S.next(ui + 1, nxt);
        const char* nA = has_next ? (const char*)g.A + (size_t)nxt.pm * tstep : cA; const char* nB = has_next ? (const char*)g.Bt + (size_t)nxt.pn * tstep : cB;
        for (int t = 0; t < nt; t += 2) {
            const bool last = (t == nt - 2);
            const char* a1 = cA + (size_t)(t + 1) * kstep;
            const char* a2 = last ? nA : cA + (size_t)(t + 2) * kstep; const char* b2 = last ? nB : cB + (size_t)(t + 2) * kstep;
            const char* a3 = a2 + kstep; const char* b3 = b2 + kstep;
            if (last && has_next) S.a_ready(nxt);
            PG8_LDB(B0, 0, 0); PG8_SCHED; PG8_LDA(At, 0, 0); PG8_STAGE(PG8_SA(1, 1), a1 + hstep, voffA);
            PG8_WAIT_L(8); PG8_BAR; PG8_WAIT_L(0); PG8_MMA(0, 0, At, B0); PG8_BAR; PG8_SCHED;
            PG8_LDB(B1, 0, 1); PG8_STAGE(PG8_SB(0, 0), b2, voffB);
            PG8_BAR; PG8_WAIT_L(0); PG8_MMA(0, 1, At, B1); PG8_BAR;
            PG8_LDA(At, 0, 1); PG8_STAGE(PG8_SA(0, 0), a2, voffA);
            PG8_BAR; PG8_WAIT_L(0); PG8_MMA(1, 0, At, B0); PG8_BAR; PG8_SCHED;
            PG8_STAGE(PG8_SB(0, 1), b2 + hstep, voffB);
            PG8_WAIT_V(6); PG8_BAR; PG8_MMA(1, 1, At, B1); PG8_BAR;
            PG8_LDB(B0, 1, 0); PG8_SCHED; PG8_LDA(At, 1, 0); PG8_STAGE(PG8_SA(0, 1), a2 + hstep, voffA);
            PG8_WAIT_L(8); PG8_BAR; PG8_WAIT_L(0); PG8_MMA(0, 0, At, B0); PG8_BAR; PG8_SCHED;
            PG8_LDB(B1, 1, 1); PG8_STAGE(PG8_SB(1, 0), b3, voffB);
            PG8_BAR; PG8_WAIT_L(0); PG8_MMA(0, 1, At, B1); PG8_BAR;
            PG8_LDA(At, 1, 1); PG8_STAGE(PG8_SA(1, 0), a3, voffA);
            PG8_BAR; PG8_WAIT_L(0); PG8_MMA(1, 0, At, B0); PG8_BAR; PG8_SCHED;
            PG8_STAGE(PG8_SB(1, 1), b3 + hstep, voffB);
            PG8_WAIT_V(6); PG8_BAR; PG8_MMA(1, 1, At, B1); PG8_BAR;
        }
        PG8_STAMP();
        if constexpr (!Epi::AFTER_DRAIN) { E(acc, cur, wr, wc, fr, fq); S.done(cur); }
        PG8_STAMP();
        if (!has_next) break;
#pragma unroll
        for (int a = 0; a < 2; ++a)
#pragma unroll
            for (int b = 0; b < 2; ++b)
#pragma unroll
                for (int m = 0; m < 4; ++m)
#pragma unroll
                    for (int n = 0; n < 2; ++n) acc[a][b][m][n] = (f32x4){0.f, 0.f, 0.f, 0.f};
        cur = nxt; cA = nA; cB = nB; ++ui;
    }
    PG8_WAIT_V(0);
    if (wr == 0) PG8_BAR;
    PG8_BAR;
    if constexpr (Epi::AFTER_DRAIN) { E.fused(acc, cur, wr, wc, fr, fq, lds, wid, lane); S.done(cur); }
    PG8_STAMP();
    if (STAMP && wid == 0) { stamps[lane] = lane < nts ? (((unsigned long long)(unsigned)ts_hi << 32) | (unsigned)ts_lo) : 0ull;
        if (lane == 62) stamps[62] = rt_entry; if (lane == 63) stamps[63] = (unsigned long long)wall_clock64(); }
#undef PG8_STAMP
#undef PG8_SA
#undef PG8_SB
#undef PG8_STAGE
#undef PG8_LDA
#undef PG8_LDB
#undef PG8_MMA
#undef PG8_WAIT_V
#undef PG8_WAIT_L
#undef PG8_BAR
#undef PG8_SCHED
}
}


#define PG_EPI_ROWS(ROWBODY)                                                                     \
  _Pragma("unroll") for (int ai = 0; ai < 2; ++ai) _Pragma("unroll") for (int m = 0; m < 4; ++m) { \
    int row = u.pm * 256 + ai * 128 + wr * 64 + m * 16 + fr;                                      \
    asm volatile("" : "+v"(row));                                                                 \
    ROWBODY                                                                                       \
    asm volatile("" ::: "memory"); }
#define PG_EPI_COLS(COLBODY)                                                                      \
  _Pragma("unroll") for (int bj = 0; bj < 2; ++bj) _Pragma("unroll") for (int n = 0; n < 2; ++n) { \
    const int col = u.pn * 256 + bj * 128 + wc * 32 + 8 * fq + 4 * n;                             \
    const f32x4 v = acc[ai][bj][m][n];                                                            \
    COLBODY }
typedef const f32x4 (&PgAcc)[2][2][4][2];
#define PG_ROW_OF(r) (u.pm * 256 + ((r) >> 2) * 128 + wr * 64 + ((r) & 3) * 16 + fr)
#define PG_EPI_PIPELINED(LOADS, USE)                                                            \
  {                                                                                             \
    const int colb = u.pn * 256 + wc * 32 + 8 * fq;                                             \
    int row = PG_ROW_OF(0);                                                                     \
    asm volatile("" : "+v"(row));                                                               \
    { const int lrow = row; _Pragma("unroll") for (int c = 0; c < 4; ++c) { const int slot = 0; const unsigned off = (unsigned)(lrow * DM + colb + (c >> 1) * 128 + (c & 1) * 4); LOADS } } \
    _Pragma("unroll") for (int r = 0; r < 8; ++r) {                                             \
      int rown = PG_ROW_OF((r + 1) & 7);                                                        \
      asm volatile("" : "+v"(rown));                                                            \
      if (r < 7) { const int lrow = rown; _Pragma("unroll") for (int c = 0; c < 4; ++c) { const int slot = (r + 1) & 1; const unsigned off = (unsigned)(lrow * DM + colb + (c >> 1) * 128 + (c & 1) * 4); LOADS } } \
      _Pragma("unroll") for (int c = 0; c < 4; ++c) {                                           \
        const int slot = r & 1;                                                                 \
        const unsigned off = (unsigned)(row * DM + colb + (c >> 1) * 128 + (c & 1) * 4);       \
        const f32x4 v = acc[r >> 2][c >> 1][r & 3][c & 1];                                      \
        USE }                                                                                   \
      asm volatile("" ::: "memory");                                                            \
      row = rown;                                                                               \
    }                                                                                           \
  }
DEVI bf16x4 to_bf4(f32x4 v) { bf16x4 o; o[0] = (bf16)v.x; o[1] = (bf16)v.y; o[2] = (bf16)v.z; o[3] = (bf16)v.w; return o; }
template <class Epi> DEVI void run_gemm(unsigned char* smem, const bf16* A, const bf16* Bt, int M, int N, int K, const Epi& E) {
  pg8::Gemm g; g.A = (const pg8::bf16_t*)A; g.Bt = (const pg8::bf16_t*)Bt; g.M = M; g.N = N; g.K = K;
  pg8::StaticOrder S; S.init(M, N, (int)gridDim.x, (int)blockIdx.x);
  pg8::gemm_phase<Epi, pg8::StaticOrder, false>((PG8_LAS unsigned char*)smem, g, S, E, nullptr);
}

template <int MTILES, int NTILES, int R>
DEVI bool tile_map(int it, int& mt, int& nt) {
  const int xcd = blockIdx.x & 7, slot = blockIdx.x >> 3, nslots = gridDim.x >> 3;
  const int L = it * nslots + slot;
  if (L >= (MTILES / 8) * NTILES) return false;
  const int group = L / (R * NTILES), rem = L % (R * NTILES);
  nt = rem / R;
  mt = (group * R + (rem % R)) * 8 + xcd;
  return true;
}

DEVI void transpose_job(const float* __restrict__ src, int ld, int n0, int nvalid, int npad, int K, bf16* __restrict__ dst, float* smf, const float* __restrict__ kscale = nullptr) {
  const int vb = threadIdx.x >> 8, tid = threadIdx.x & 255;
  float* sm = smf + vb * (64 * 65);
  const int ktiles = K >> 6, ntiles = (npad >> 6) * ktiles;
  const int ty = tid >> 4, tx = tid & 15;
  for (int base = blockIdx.x * 2; base < ntiles; base += gridDim.x * 2) {
    const int tile = base + vb;
    const bool ok = tile < ntiles;
    const int nb = (tile / ktiles) << 6, kb = (tile % ktiles) << 6;
    if (ok) {
#pragma unroll
      for (int i = 0; i < 4; ++i) {
        const int k = kb + ty + 16 * i, n = nb + tx * 4;
        f32x4 v = mk_f4(0.f, 0.f, 0.f, 0.f);
        if (n < nvalid) v = *(const f32x4*)(src + (size_t)k * ld + n0 + n);
        if (kscale) v = v * kscale[k];
        float* q = sm + (ty + 16 * i) * 65 + tx * 4;
        q[0] = v.x; q[1] = v.y; q[2] = v.z; q[3] = v.w;
      }
    }
    __syncthreads();
    if (ok) {
      const int n = tid >> 2, kq = tid & 3;
      bf16x8 o0, o1;
#pragma unroll
      for (int j = 0; j < 8; ++j) {
        o0[j] = (bf16)sm[(kq * 16 + j) * 65 + n];
        o1[j] = (bf16)sm[(kq * 16 + 8 + j) * 65 + n];
      }
      bf16* d = dst + (size_t)(nb + n) * K + kb + kq * 16;
      *(bf16x8*)d = o0;
      *(bf16x8*)(d + 8) = o1;
    }
    __syncthreads();
  }
}

DEVI void convert_job(const float* __restrict__ src, bf16* __restrict__ dst, size_t n) {
  const size_t n4 = n >> 2;
  for (size_t i = (size_t)blockIdx.x * NTHREADS + threadIdx.x; i < n4; i += (size_t)gridDim.x * NTHREADS) {
    const f32x4 v = ((const f32x4*)src)[i];
    bf16x4 o; o[0] = (bf16)v.x; o[1] = (bf16)v.y; o[2] = (bf16)v.z; o[3] = (bf16)v.w;
    ((bf16x4*)dst)[i] = o;
  }
}


DEVI void fp4_rows_job(const float* __restrict__ src, unsigned char* __restrict__ dst, float* __restrict__ inv, const float* __restrict__ cscale = nullptr) {
  const int lane = threadIdx.x & 63;
  const int gw = blockIdx.x * NWAVES + (threadIdx.x >> 6), nw = gridDim.x * NWAVES;
  for (int r = gw; r < 16384; r += nw) {
    const float* sp = src + (size_t)r * 1024 + lane * 16;
    f32x4 v[4];
    float mx = 0.f;
#pragma unroll
    for (int i = 0; i < 4; ++i) {
      v[i] = *(const f32x4*)(sp + i * 4);
      if (cscale) v[i] = v[i] * *(const f32x4*)(cscale + lane * 16 + i * 4);
      mx = fmaxf(mx, fmaxf(fmaxf(fabsf(v[i].x), fabsf(v[i].y)), fmaxf(fabsf(v[i].z), fabsf(v[i].w))));
    }
#pragma unroll
    for (int o = 32; o > 0; o >>= 1) mx = fmaxf(mx, __shfl_xor(mx, o, 64));
    const float sc = (mx > 0.f) ? 6.f / mx : 1.f;
    u32x2 o2;
#pragma unroll
    for (int d = 0; d < 2; ++d) {
      unsigned w = 0u;
      w = __builtin_amdgcn_cvt_scalef32_pk_fp4_f32(w, v[2 * d].x * sc, v[2 * d].y * sc, 1.0f, 0);
      w = __builtin_amdgcn_cvt_scalef32_pk_fp4_f32(w, v[2 * d].z * sc, v[2 * d].w * sc, 1.0f, 1);
      w = __builtin_amdgcn_cvt_scalef32_pk_fp4_f32(w, v[2 * d + 1].x * sc, v[2 * d + 1].y * sc, 1.0f, 2);
      w = __builtin_amdgcn_cvt_scalef32_pk_fp4_f32(w, v[2 * d + 1].z * sc, v[2 * d + 1].w * sc, 1.0f, 3);
      o2[d] = w;
    }
    *(u32x2*)(dst + (size_t)r * 512 + lane * 8) = o2;
    if (lane == 0) inv[r] = 1.f / sc;
  }
}

DEVI void rmsnorm_rows_bf16(const float* src, const float* __restrict__ gain, bf16* __restrict__ dst) {
  const int lane = threadIdx.x & 63;
  const int gw = blockIdx.x * NWAVES + (threadIdx.x >> 6), nw = gridDim.x * NWAVES;
  f32x4 gn[4];
#pragma unroll
  for (int i = 0; i < 4; ++i) gn[i] = *(const f32x4*)(gain + i * 256 + lane * 4);
  for (int t = gw; t < T_TOK; t += nw) {
    const float* xr = src + (size_t)t * DM;
    f32x4 v[4];
    float ss = 0.f;
#pragma unroll
    for (int i = 0; i < 4; ++i) {
      v[i] = *(const f32x4*)(xr + i * 256 + lane * 4);
      ss += v[i].x * v[i].x + v[i].y * v[i].y + v[i].z * v[i].z + v[i].w * v[i].w;
    }
    ss = wave_sum(ss);
    const float rs = rsqrtf(ss * (1.f / DM) + 1e-6f);
#pragma unroll
    for (int i = 0; i < 4; ++i) {
      bf16x4 o;
      o[0] = (bf16)(v[i].x * rs * gn[i].x); o[1] = (bf16)(v[i].y * rs * gn[i].y);
      o[2] = (bf16)(v[i].z * rs * gn[i].z); o[3] = (bf16)(v[i].w * rs * gn[i].w);
      *(bf16x4*)(dst + (size_t)t * DM + i * 256 + lane * 4) = o;
    }
  }
}

DEVI void rmsnorm_rows_bf16_from_bf16(const bf16* __restrict__ src, const float* __restrict__ gain, bf16* __restrict__ dst) {
  const int lane = threadIdx.x & 63;
  const int gw = blockIdx.x * NWAVES + (threadIdx.x >> 6), nw = gridDim.x * NWAVES;
  f32x4 gn[4];
#pragma unroll
  for (int i = 0; i < 4; ++i) gn[i] = *(const f32x4*)(gain + i * 256 + lane * 4);
  for (int t = gw; t < T_TOK; t += nw) {
    const bf16* xr = src + (size_t)t * DM;
    bf16x4 v[4];
    float ss = 0.f;
#pragma unroll
    for (int i = 0; i < 4; ++i) {
      v[i] = *(const bf16x4*)(xr + i * 256 + lane * 4);
#pragma unroll
      for (int j = 0; j < 4; ++j) ss += (float)v[i][j] * (float)v[i][j];
    }
    ss = wave_sum(ss);
    const float rs = rsqrtf(ss * (1.f / DM) + 1e-6f);
#pragma unroll
    for (int i = 0; i < 4; ++i) {
      bf16x4 o;
      o[0] = (bf16)((float)v[i][0] * rs * gn[i].x); o[1] = (bf16)((float)v[i][1] * rs * gn[i].y);
      o[2] = (bf16)((float)v[i][2] * rs * gn[i].z); o[3] = (bf16)((float)v[i][3] * rs * gn[i].w);
      *(bf16x4*)(dst + (size_t)t * DM + i * 256 + lane * 4) = o;
    }
  }
}

DEVI void phase0(const ParamsG& p, unsigned char* smem) {
  unsigned char* ws = gp(p.ws);
  float* smf = (float*)smem;
#define TJOB(SRC, LD, N0, NVALID, NPAD, KK, OFF) transpose_job((SRC), (LD), (N0), (NVALID), (NPAD), (KK), (bf16*)(ws + (OFF)), smf);
  TJOB(gp(p.w_in), IN_COLS, 0, 2464, 2560, 1024, OFF_WIN_T)
  TJOB(gp(p.w_in), IN_COLS, 2464, 2048, 2048, 1024, OFF_WG_T)
  TJOB(gp(p.rw_w_o), 1024, 0, 1024, 1024, 512, OFF_RWO_T)
  TJOB(gp(p.mla_w_o), 1024, 0, 1024, 1024, 512, OFF_MLO_T)
  TJOB(gp(p.mla_w_uq), 768, 0, 768, 768, 384, OFF_WUQ_T)
  TJOB(gp(p.mla_w_ukv), 1024, 0, 1024, 1024, 256, OFF_WUKV_T)
  TJOB(gp(p.w_out), 1024, 0, 1024, 1024, 1024, OFF_WOUT_T)
  transpose_job(gp(p.peer_w_q), 2048, 0, 2048, 2048, 1024, (bf16*)(ws + OFF_WQ_T), smf, gp(p.norm_ffn));
  TJOB(gp(p.ple_w_gate), 1024, 0, 1024, 1024, 1024, OFF_PG_T)
  TJOB(gp(p.ple_w_proj), 1024, 0, 1024, 1024, 256, OFF_PP_T)
#undef TJOB
  {
    bf16* wl = (bf16*)(ws + OFF_WLORA_T);
    for (int i = blockIdx.x * NTHREADS + threadIdx.x; i < 1536 * 256; i += gridDim.x * NTHREADS) {
      const int n = i >> 8, k = i & 255;
      float v = 0.f;
      if (n < 512) { if (k < 64) v = gp(p.rw_w2)[k * 512 + n]; }
      else if (n < 1024) { if (k >= 64 && k < 128) v = gp(p.rw_a2)[(k - 64) * 512 + (n - 512)]; }
      else { if (k >= 128) v = gp(p.rw_g2)[(k - 128) * 512 + (n - 1024)]; }
      wl[i] = (bf16)v;
    }
  }
  convert_job(gp(p.peer_sub_keys), (bf16*)(ws + OFF_SK), (size_t)8 * 2 * 128 * 128);
  fp4_rows_job(gp(p.peer_u), ws + OFF_U8, (float*)(ws + OFF_IUS), gp(p.norm_ffn));
  fp4_rows_job(gp(p.peer_v), ws + OFF_V8, (float*)(ws + OFF_IVS));
  convert_job(gp(p.p), (bf16*)(ws + OFF_PBF), (size_t)T_TOK * 256);
  rmsnorm_rows_bf16(gp(p.x), gp(p.norm_mix), (bf16*)(ws + OFF_H1));
  {
    float* cs = (float*)(ws + OFF_CS);
    float* sn = (float*)(ws + OFF_SN);
    for (int i = blockIdx.x * NTHREADS + threadIdx.x; i < T_TOK * 16; i += gridDim.x * NTHREADS) {
      const int t = i >> 4, f = i & 15;
      const float inv = powf(10000.f, -(float)(2 * f) / 32.f);
      const float ang = (float)gp(p.pos)[t] * inv;
      double s, c;
      sincos((double)ang, &s, &c);
      cs[i] = (float)c; sn[i] = (float)s;
    }
  }
  if (blockIdx.x == 0 && threadIdx.x < 64) ((unsigned*)(ws + OFF_CNT))[threadIdx.x] = 0u;
  if (blockIdx.x == 0) for (int i = threadIdx.x; i < XCD_BAR_WORDS; i += NTHREADS) ((unsigned*)(ws + OFF_BAR))[i] = 0u;
}

struct EpiZ {
  static constexpr bool PERM = true, AFTER_DRAIN = false;
  bf16* zrw; bf16* zmla;
  DEVI void operator()(PgAcc acc, const pg8::Unit& u, int wr, int wc, int fr, int fq) const {
    PG_EPI_ROWS(PG_EPI_COLS(
      if (col < RWC) *(bf16x4*)(zrw + (unsigned)(row * RWC + col)) = to_bf4(v);
      else if (col < RWC + MLC) *(bf16x4*)(zmla + (unsigned)(row * MLC + (col - RWC))) = to_bf4(v);
    ))
  }
};
DEVI void phase1(const ParamsG& p, unsigned char* smem) {
  EpiZ e; e.zrw = (bf16*)(gp(p.ws) + OFF_ZRW); e.zmla = (bf16*)(gp(p.ws) + OFF_ZMLA);
  run_gemm(smem, (const bf16*)(gp(p.ws) + OFF_H1), (const bf16*)(gp(p.ws) + OFF_WIN_T), T_TOK, 2560, DM, e);
}

DEVI void phase2a(const ParamsG& p) {
  const int lane = threadIdx.x & 63;
  const int gw = blockIdx.x * NWAVES + (threadIdx.x >> 6), nw = gridDim.x * NWAVES;
  const bf16* zrw = (const bf16*)(gp(p.ws) + OFF_ZRW);
  const bf16* zmla = (const bf16*)(gp(p.ws) + OFF_ZMLA);
  bf16* lora = (bf16*)(gp(p.ws) + OFF_LORA);
  bf16* cq = (bf16*)(gp(p.ws) + OFF_CQ);
  bf16* ckv = (bf16*)(gp(p.ws) + OFF_CKV);
  bf16* Kd = (bf16*)((unsigned char*)gp(p.out) + OFF_K);
  const float* cs = (const float*)(gp(p.ws) + OFF_CS);
  const float* sn = (const float*)(gp(p.ws) + OFF_SN);
  const f32x4 mu = *(const f32x4*)(gp(p.rw_mu) + 1536 + lane * 4);
  const f32x4 qg0 = *(const f32x4*)(gp(p.mla_q_norm) + lane * 4);
  const f32x2 qg1 = *(const f32x2*)(gp(p.mla_q_norm) + 256 + lane * 2);
  const f32x4 kg = *(const f32x4*)(gp(p.mla_kv_norm) + lane * 4);
  const float mua[4] = {mu.x, mu.y, mu.z, mu.w};
  for (int t = gw; t < T_TOK; t += nw) {
    const int s = t & (SEQ - 1), b = t >> 12;
    {
      const bf16* zp = zrw + (size_t)t * RWC + 1536 + lane * 4;
      const bf16x4 zc = *(const bf16x4*)zp;
      bf16x4 zv;
      if (s > 0) zv = *(const bf16x4*)(zp - RWC);
      else { zv[0] = (bf16)0.f; zv[1] = (bf16)0.f; zv[2] = (bf16)0.f; zv[3] = (bf16)0.f; }
      bf16x4 o;
#pragma unroll
      for (int j = 0; j < 4; ++j) {
        const float c = (float)zc[j], pv = (float)zv[j];
        const float zs = c + mua[j] * (pv - c);
        float val;
        if (lane < 16) val = tanhf(zs);
        else if (lane < 32) val = zs;
        else val = sigmoid_f(zs);
        o[j] = (bf16)val;
      }
      *(bf16x4*)(lora + (size_t)t * 256 + lane * 4) = o;
    }
    {
      const bf16* zq = zmla + (size_t)t * MLC;
      const bf16x4 q0 = *(const bf16x4*)(zq + lane * 4);
      const bf16x2 q1 = *(const bf16x2*)(zq + 256 + lane * 2);
      float f[6] = {(float)q0[0], (float)q0[1], (float)q0[2], (float)q0[3], (float)q1[0], (float)q1[1]};
      float ss = 0.f;
#pragma unroll
      for (int j = 0; j < 6; ++j) ss += f[j] * f[j];
      ss = wave_sum(ss);
      const float rs = rsqrtf(ss * (1.f / 384.f) + 1e-6f);
      bf16x4 o0; bf16x2 o1;
      o0[0] = (bf16)(f[0] * rs * qg0.x); o0[1] = (bf16)(f[1] * rs * qg0.y);
      o0[2] = (bf16)(f[2] * rs * qg0.z); o0[3] = (bf16)(f[3] * rs * qg0.w);
      o1[0] = (bf16)(f[4] * rs * qg1.x); o1[1] = (bf16)(f[5] * rs * qg1.y);
      *(bf16x4*)(cq + (size_t)t * 384 + lane * 4) = o0;
      *(bf16x2*)(cq + (size_t)t * 384 + 256 + lane * 2) = o1;
    }
    {
      const bf16x4 k0 = *(const bf16x4*)(zmla + (size_t)t * MLC + 384 + lane * 4);
      float f[4] = {(float)k0[0], (float)k0[1], (float)k0[2], (float)k0[3]};
      float ss = f[0] * f[0] + f[1] * f[1] + f[2] * f[2] + f[3] * f[3];
      ss = wave_sum(ss);
      const float rs = rsqrtf(ss * (1.f / 256.f) + 1e-6f);
      bf16x4 o;
      o[0] = (bf16)(f[0] * rs * kg.x); o[1] = (bf16)(f[1] * rs * kg.y);
      o[2] = (bf16)(f[2] * rs * kg.z); o[3] = (bf16)(f[3] * rs * kg.w);
      *(bf16x4*)(ckv + (size_t)t * 256 + lane * 4) = o;
    }
    {
      const float xr = (float)zmla[(size_t)t * MLC + 640 + (lane & 31)];
      const float xp = __shfl_xor(xr, 16, 64);
      const int f = lane & 15;
      const float c = cs[t * 16 + f], sv = sn[t * 16 + f];
      const float o = (lane & 16) ? (xr * c + xp * sv) : (xr * c - xp * sv);
      if (lane < 32) {
        const bf16 ob = (bf16)o;
#pragma unroll
        for (int h = 0; h < 8; ++h) Kd[((size_t)(b * 8 + h) * SEQ + s) * 96 + 64 + lane] = ob;
      }
    }
  }
}

constexpr float QSCALE = 0.14724444f;
template <bool SSQ = false>
DEVI void route_mainloop(f32x16 (&acc)[4], const bf16* __restrict__ A, int lda, const bf16* __restrict__ B, int ldb, int nk, unsigned char* base,
                         const bf16* __restrict__ sk = nullptr, float* ssq = nullptr) {
  const int tid = threadIdx.x, lane = tid & 63, w = tid >> 6;
  unsigned ao[2], bo[4];
#pragma unroll
  for (int i = 0; i < 2; ++i) { const int r = (w + 8 * i) * 8 + (lane >> 3); ao[i] = (unsigned)(r * lda + (((lane & 7) ^ ((r >> 1) & 7)) * 8)) * 2u; }
#pragma unroll
  for (int i = 0; i < 4; ++i) { const int r = (w + 8 * i) * 8 + (lane >> 3); bo[i] = (unsigned)(r * ldb + (((lane & 7) ^ ((r >> 1) & 7)) * 8)) * 2u; }
  const int sw = (lane >> 1) & 7, hh = lane >> 5;
  const int arow = (lane & 31) * 128, brow = (w * 32 + (lane & 31)) * 128;
  auto issue = [&](int kt, int slot) {
    unsigned char* nb = base + slot * 49152;
#pragma unroll
    for (int i = 0; i < 2; ++i)
      __builtin_amdgcn_global_load_lds((const unsigned*)((const char*)A + (ao[i] + (unsigned)kt * 128u)), (__attribute__((address_space(3))) unsigned*)(nb + (w + 8 * i) * 1024), 16, 0, 0);
#pragma unroll
    for (int i = 0; i < 4; ++i)
      __builtin_amdgcn_global_load_lds((const unsigned*)((const char*)B + (bo[i] + (unsigned)kt * 128u)), (__attribute__((address_space(3))) unsigned*)(nb + 16384 + (w + 8 * i) * 1024), 16, 0, 0);
  };
  float ss0 = 0.f, ss1 = 0.f;
  __syncthreads();
  issue(0, 0);
  issue(1, 1);
  int cur = 0;
  for (int kt = 0; kt < nk; ++kt) {
    if (kt + 1 < nk) asm volatile("s_waitcnt vmcnt(6)" ::: "memory");
    else if (sk) asm volatile("s_waitcnt vmcnt(4)" ::: "memory");
    else asm volatile("s_waitcnt vmcnt(0)" ::: "memory");
    __syncthreads();
    int nx2 = cur + 2; if (nx2 >= 3) nx2 -= 3;
    if (kt + 2 < nk) issue(kt + 2, nx2);
    else if (kt + 2 == nk && sk) {
#pragma unroll
      for (int i = 0; i < 4; ++i) {
        const int r = (w * 4 + i) * 4 + (lane >> 4);
        const int ch = (lane & 15) ^ (r & 15);
        __builtin_amdgcn_global_load_lds((const unsigned*)((const char*)sk + (unsigned)(r * 128 + ch * 8) * 2u), (__attribute__((address_space(3))) unsigned*)(base + nx2 * 49152 + (w * 4 + i) * 1024), 16, 0, 0);
      }
    }
    const unsigned char* cb = base + cur * 49152;
    cur = (cur == 2) ? 0 : cur + 1;
#pragma unroll
    for (int ks = 0; ks < 4; ++ks) {
      const int co = ((ks * 2 + hh) ^ sw) * 16;
      const bf16x8 bfr = *(const bf16x8*)(cb + 16384 + brow + co);
      if (SSQ) {
        const u32x4 bu = __builtin_bit_cast(u32x4, bfr);
        ss0 = dot2bf(bu.x, bu.x, ss0); ss1 = dot2bf(bu.y, bu.y, ss1);
        ss0 = dot2bf(bu.z, bu.z, ss0); ss1 = dot2bf(bu.w, bu.w, ss1);
      }
#pragma unroll
      for (int mt = 0; mt < 4; ++mt) {
        const bf16x8 af = *(const bf16x8*)(cb + arow + mt * 4096 + co);
        acc[mt] = __builtin_amdgcn_mfma_f32_32x32x16_bf16(af, bfr, acc[mt], 0, 0, 0);
      }
    }
  }
  if (SSQ) *ssq = ss0 + ss1;
  if (sk) { asm volatile("s_waitcnt vmcnt(0)" ::: "memory"); __syncthreads(); }
}
DEVI void phase2b(const ParamsG& p, unsigned char* smem) {
  unsigned char* ws = gp(p.ws);
  const bf16* LORA = (const bf16*)(ws + OFF_LORA);
  const bf16* CQ = (const bf16*)(ws + OFF_CQ);
  const bf16* CKV = (const bf16*)(ws + OFF_CKV);
  bf16* E = (bf16*)(ws + OFF_E);
  bf16* ICLR = (bf16*)(ws + OFF_ICLR);
  bf16* G = (bf16*)(ws + OFF_G);
  bf16* Qd = (bf16*)((unsigned char*)gp(p.out) + OFF_Q);
  bf16* Kd = (bf16*)((unsigned char*)gp(p.out) + OFF_K);
  bf16* Vd = (bf16*)((unsigned char*)gp(p.out) + OFF_VT);
  const int lane = threadIdx.x & 63, w = threadIdx.x >> 6, hh = lane >> 5;
  for (int it = 0;; ++it) {
    int tm, j;
    if (!tile_map<128, 26, 2>(it, tm, j)) break;
    const int m0 = tm * 256;
    const bf16* A; const bf16* Bm; int K, kind, n0;
    if (j < 12) { kind = 0; n0 = j * 128; K = 256; A = (const bf16*)(ws + OFF_WLORA_T) + (size_t)n0 * 256; Bm = LORA + (size_t)m0 * 256; }
    else if (j < 18) { kind = 1; n0 = (j - 12) * 128; K = 384; A = (const bf16*)(ws + OFF_WUQ_T) + (size_t)n0 * 384; Bm = CQ + (size_t)m0 * 384; }
    else { kind = 2; n0 = (j - 18) * 128; K = 256; A = (const bf16*)(ws + OFF_WUKV_T) + (size_t)n0 * 256; Bm = CKV + (size_t)m0 * 256; }
    f32x16 acc[4];
#pragma unroll
    for (int mt = 0; mt < 4; ++mt)
#pragma unroll
      for (int r = 0; r < 16; ++r) acc[mt][r] = 0.f;
    route_mainloop(acc, A, K, Bm, K, K >> 6, smem);
    {
      bf16* wb = (bf16*)(smem + w * 8704);
      __syncthreads();
#pragma unroll
      for (int mt = 0; mt < 4; ++mt)
#pragma unroll
        for (int rg = 0; rg < 4; ++rg) {
          f32x4 v; v.x = acc[mt][4 * rg + 0]; v.y = acc[mt][4 * rg + 1]; v.z = acc[mt][4 * rg + 2]; v.w = acc[mt][4 * rg + 3];
          if (kind == 1) v = v * QSCALE;
          *(bf16x4*)(wb + (lane & 31) * 136 + mt * 32 + 8 * rg + 4 * hh) = to_bf4(v);
        }
      __builtin_amdgcn_fence(__ATOMIC_RELEASE, "wavefront");
#pragma unroll
      for (int ps = 0; ps < 8; ++ps) {
        const int tl = ps * 4 + (lane >> 4), f0 = (lane & 15) * 8;
        const u32x4 v = *(const u32x4*)(wb + tl * 136 + f0);
        const size_t tok = (size_t)m0 + w * 32 + tl;
        const size_t bb = tok >> 12, ss = tok & (SEQ - 1);
        if (kind == 0) {
          bf16* D = (n0 < 512) ? E : ((n0 < 1024) ? ICLR : G);
          *(u32x4*)(D + tok * 512 + (n0 & 511) + f0) = v;
        } else if (kind == 1) {
          const int f = n0 + f0, head = f / 96, d = f - head * 96;
          *(u32x4*)(Qd + ((bb * 8 + head) * SEQ + ss) * 96 + d) = v;
        } else {
          const int head = n0 >> 7;
          if (f0 < 64) *(u32x4*)(Kd + ((bb * 8 + head) * SEQ + ss) * 96 + f0) = v;
          else *(u32x4*)(Vd + ((bb * 8 + head) * SEQ + ss) * 64 + (f0 - 64)) = v;
        }
      }
    }
  }
}

struct ScanBuf { float A[16][64], B[16][64], W[16][64], K2[16][64], R[16][64]; float V[16][16]; };
DEVI void phase3a(const ParamsG& p, unsigned char* smem) {
  ScanBuf* sb = (ScanBuf*)smem;
  const bf16* zrw = (const bf16*)(gp(p.ws) + OFF_ZRW);
  const bf16* E = (const bf16*)(gp(p.ws) + OFF_E);
  const bf16* ICLR = (const bf16*)(gp(p.ws) + OFF_ICLR);
  bf16* YRAW = (bf16*)(gp(p.ws) + OFF_YRAW);
  float* RK = (float*)(gp(p.ws) + OFF_RK);
  const int role = threadIdx.x >> 8;
  const int tid = threadIdx.x & 255, lane = tid & 63, w = tid >> 6;
  const int pi = tid >> 4, kq = tid & 15;
  const int rloc = 4 * w + (lane >> 4), kg = lane & 15;
  if (role == 0) __builtin_amdgcn_s_setprio(3);
  for (int item = blockIdx.x; item < 256; item += gridDim.x) {
    const int bh = item >> 2, quarter = item & 3, b = bh >> 3, h = bh & 7;
    const int c0 = h * 64 + 4 * kq;
    if (role == 1) {
      const f32x4 mur = *(const f32x4*)(gp(p.rw_mu) + c0);
      const f32x4 muk = *(const f32x4*)(gp(p.rw_mu) + 512 + c0);
      const f32x4 muv = *(const f32x4*)(gp(p.rw_mu) + 1024 + c0);
      const f32x4 kkw = *(const f32x4*)(gp(p.rw_k_k) + c0);
      const f32x4 kaw = *(const f32x4*)(gp(p.rw_k_a) + c0);
      const f32x4 rkw = *(const f32x4*)(gp(p.rw_r_k) + c0);
      const f32x4 w0v = *(const f32x4*)(gp(p.rw_w0) + c0);
      const f32x4 a0v = *(const f32x4*)(gp(p.rw_a0) + c0);
      const float w0_[4] = {w0v.x, w0v.y, w0v.z, w0v.w}, a0_[4] = {a0v.x, a0v.y, a0v.z, a0v.w};
      const float mur_[4] = {mur.x, mur.y, mur.z, mur.w}, muk_[4] = {muk.x, muk.y, muk.z, muk.w},
                  muv_[4] = {muv.x, muv.y, muv.z, muv.w}, kkw_[4] = {kkw.x, kkw.y, kkw.z, kkw.w},
                  kaw_[4] = {kaw.x, kaw.y, kaw.z, kaw.w}, rkw_[4] = {rkw.x, rkw.y, rkw.z, rkw.w};
      bf16x4 zr, zk, zv, pr, pk, pv, ic;
      f32x4 ee;
      auto load_raw = [&](int c) {
        const int s = c * 16 + pi;
        const size_t t = (size_t)b * SEQ + s;
        const bf16* zp = zrw + t * RWC + c0;
        zr = *(const bf16x4*)zp; zk = *(const bf16x4*)(zp + 512); zv = *(const bf16x4*)(zp + 1024);
        if (s > 0) {
          pr = *(const bf16x4*)(zp - RWC); pk = *(const bf16x4*)(zp - RWC + 512); pv = *(const bf16x4*)(zp - RWC + 1024);
        } else {
#pragma unroll
          for (int j = 0; j < 4; ++j) { pr[j] = (bf16)0.f; pk[j] = (bf16)0.f; pv[j] = (bf16)0.f; }
        }
        { const bf16x4 e4 = *(const bf16x4*)(E + t * 512 + c0); ee = mk_f4((float)e4[0], (float)e4[1], (float)e4[2], (float)e4[3]); }
        ic = *(const bf16x4*)(ICLR + t * 512 + c0);
      };
      auto prep = [&](int c) {
        ScanBuf& bf = sb[c & 1];
        const float ee_[4] = {ee.x, ee.y, ee.z, ee.w};
        float r[4], k[4], v[4], kx[4], icl[4];
        float n2 = 0.f;
#pragma unroll
        for (int j = 0; j < 4; ++j) {
          const float zrj = (float)zr[j], zkj = (float)zk[j], zvj = (float)zv[j];
          r[j] = zrj + mur_[j] * ((float)pr[j] - zrj);
          k[j] = zkj + muk_[j] * ((float)pk[j] - zkj);
          v[j] = zvj + muv_[j] * ((float)pv[j] - zvj);
          kx[j] = k[j] * kkw_[j];
          n2 += kx[j] * kx[j];
          icl[j] = sigmoid_f(a0_[j] + (float)ic[j]);
        }
        n2 = row16_allsum(n2);
        const float inv = 1.f / fmaxf(sqrtf(n2), 1e-12f);
        float av[4], bv[4], wv[4], k2[4];
        float rkp = 0.f;
#pragma unroll
        for (int j = 0; j < 4; ++j) {
          const float kkn = kx[j] * inv;
          k2[j] = k[j] * (1.f + (icl[j] - 1.f) * kaw_[j]);
          av[j] = -kkn;
          bv[j] = kkn * icl[j];
          wv[j] = __expf(-0.60653066f * sigmoid_f(w0_[j] + ee_[j]));
          rkp += r[j] * k2[j] * rkw_[j];
        }
        rkp = row16_allsum(rkp);
        *(f32x4*)&bf.A[pi][4 * kq] = mk_f4(av[0], av[1], av[2], av[3]);
        *(f32x4*)&bf.B[pi][4 * kq] = mk_f4(bv[0], bv[1], bv[2], bv[3]);
        *(f32x4*)&bf.W[pi][4 * kq] = mk_f4(wv[0], wv[1], wv[2], wv[3]);
        *(f32x4*)&bf.K2[pi][4 * kq] = mk_f4(k2[0], k2[1], k2[2], k2[3]);
        *(f32x4*)&bf.R[pi][4 * kq] = mk_f4(r[0], r[1], r[2], r[3]);
        if ((kq >> 2) == quarter) *(f32x4*)&bf.V[pi][(kq & 3) * 4] = mk_f4(v[0], v[1], v[2], v[3]);
        if (quarter == 0 && kq == 0) RK[((size_t)b * SEQ + c * 16 + pi) * 8 + h] = rkp;
      };
      load_raw(0);
      prep(0);
      load_raw(1);
      __syncthreads();
      for (int c = 0; c < 256; ++c) {
        if (c + 1 < 256) prep(c + 1);
        if (c + 2 < 256) load_raw(c + 2);
        __syncthreads();
      }
    } else {
      float s0 = 0.f, s1 = 0.f, s2 = 0.f, s3 = 0.f;
      __syncthreads();
      for (int c = 0; c < 256; ++c) {
        const ScanBuf& bf = sb[c & 1];
        float yv = 0.f;
#pragma unroll
        for (int i = 0; i < 16; ++i) {
          const f32x4 A4 = *(const f32x4*)&bf.A[i][4 * kg];
          const f32x4 B4 = *(const f32x4*)&bf.B[i][4 * kg];
          const f32x4 W4 = *(const f32x4*)&bf.W[i][4 * kg];
          const f32x4 K4 = *(const f32x4*)&bf.K2[i][4 * kg];
          const f32x4 R4 = *(const f32x4*)&bf.R[i][4 * kg];
          const float vv = bf.V[i][rloc];
          float pd = s0 * A4.x + s1 * A4.y + s2 * A4.z + s3 * A4.w;
          const float sa = row16_allsum(pd);
          s0 = s0 * W4.x + vv * K4.x + sa * B4.x;
          s1 = s1 * W4.y + vv * K4.y + sa * B4.y;
          s2 = s2 * W4.z + vv * K4.z + sa * B4.z;
          s3 = s3 * W4.w + vv * K4.w + sa * B4.w;
          float yp = s0 * R4.x + s1 * R4.y + s2 * R4.z + s3 * R4.w;
          const float y = row16_allsum(yp);
          yv = (kg == i) ? y : yv;
        }
        YRAW[((size_t)b * SEQ + c * 16 + kg) * 512 + h * 64 + quarter * 16 + rloc] = (bf16)yv;
        __syncthreads();
      }
    }
    __syncthreads();
  }
  __builtin_amdgcn_s_setprio(0);
}

struct AttnSmem { bf16 k[2][64][104]; bf16 v[2][64][68]; int tile; };
DEVI void phase3b(const ParamsG& p, unsigned char* smem) {
  AttnSmem& sm = *(AttnSmem*)smem;
  const bf16* Qd = (const bf16*)((const unsigned char*)gp(p.out) + OFF_Q);
  const bf16* Kd = (const bf16*)((const unsigned char*)gp(p.out) + OFF_K);
  const bf16* Vd = (const bf16*)((const unsigned char*)gp(p.out) + OFF_VT);
  bf16* O = (bf16*)(gp(p.ws) + OFF_O);
  unsigned* cnt = (unsigned*)(gp(p.ws) + OFF_CNT);
  const int tid = threadIdx.x, lane = tid & 63, w = tid >> 6;
  const int q = lane & 31, hh = lane >> 5;
  for (;;) {
    __syncthreads();
    if (tid == 0) sm.tile = (int)atomicAdd(cnt, 1u);
    __syncthreads();
    const int tile = sm.tile;
    if (tile >= 1024) break;
    const int qt = 15 - (tile >> 6), bh = tile & 63;
    const int s0 = qt * 256;
    const int nkt = 4 * qt + 4;
    const int my_nkt = 4 * qt + 1 + (w >> 1);
    bf16x8 qf[6];
    {
      const bf16* qp = Qd + ((size_t)bh * SEQ + s0 + w * 32 + q) * 96 + hh * 8;
#pragma unroll
      for (int ks = 0; ks < 6; ++ks) qf[ks] = *(const bf16x8*)(qp + ks * 16);
      const size_t trow = (size_t)(bh >> 3) * SEQ + s0 + w * 32 + q;
      const float* cp = (const float*)(gp(p.ws) + OFF_CS) + trow * 16 + hh * 8;
      const float* sp = (const float*)(gp(p.ws) + OFF_SN) + trow * 16 + hh * 8;
#pragma unroll
      for (int j = 0; j < 8; ++j) {
        const float c = cp[j], sv = sp[j];
        const float x1 = (float)qf[4][j], x2 = (float)qf[5][j];
        qf[4][j] = (bf16)(x1 * c - x2 * sv);
        qf[5][j] = (bf16)(x2 * c + x1 * sv);
      }
    }
    f32x16 ot[2];
#pragma unroll
    for (int vb = 0; vb < 2; ++vb)
#pragma unroll
      for (int r = 0; r < 16; ++r) ot[vb][r] = 0.f;
    float mref = 0.f, lsum = 0.f;
    u32x4 kr0, kr1, vr;
    kr1 = mk_u4(0u, 0u, 0u, 0u);
    auto gload = [&](int kt) {
      const bf16* kb = Kd + ((size_t)bh * SEQ + kt * 64) * 96;
      kr0 = *(const u32x4*)(kb + (size_t)tid * 8);
      if (tid < 256) kr1 = *(const u32x4*)(kb + (size_t)(tid + 512) * 8);
      const bf16* vb = Vd + ((size_t)bh * SEQ + kt * 64) * 64;
      vr = *(const u32x4*)(vb + (size_t)tid * 8);
    };
    auto lwrite = [&](int buf) {
      const int row = tid / 12, cc = tid % 12;
      *(u32x4*)&sm.k[buf][row][cc * 8] = kr0;
      if (tid < 256) { const int id = tid + 512; *(u32x4*)&sm.k[buf][id / 12][(id % 12) * 8] = kr1; }
      const int key = tid >> 3, vd0 = (tid & 7) * 8;
      unsigned short* vs = (unsigned short*)&sm.v[buf][0][0];
#pragma unroll
      for (int j = 0; j < 4; ++j) {
        vs[(vd0 + 2 * j) * 68 + key] = (unsigned short)(vr[j] & 0xffffu);
        vs[(vd0 + 2 * j + 1) * 68 + key] = (unsigned short)(vr[j] >> 16);
      }
    };
    gload(0);
    lwrite(0);
    if (nkt > 1) gload(1);
    __syncthreads();
    for (int kt = 0; kt < nkt; ++kt) {
      const int cb_ = kt & 1;
      if (kt + 1 < nkt) lwrite(cb_ ^ 1);
      if (kt + 2 < nkt) gload(kt + 2);
      if (kt < my_nkt) {
        f32x16 st[2];
        const float nmref = -mref;
#pragma unroll
        for (int kb2 = 0; kb2 < 2; ++kb2) {
#pragma unroll
          for (int r = 0; r < 16; ++r) st[kb2][r] = nmref;
#pragma unroll
          for (int ks = 0; ks < 6; ++ks) {
            const bf16x8 a = *(const bf16x8*)&sm.k[cb_][kb2 * 32 + q][ks * 16 + hh * 8];
            st[kb2] = __builtin_amdgcn_mfma_f32_32x32x16_bf16(a, qf[ks], st[kb2], 0, 0, 0);
          }
        }
        float mx = st[0][0];
#pragma unroll
        for (int kb2 = 0; kb2 < 2; ++kb2)
#pragma unroll
          for (int r = 0; r < 16; ++r) mx = fmaxf(mx, st[kb2][r]);
        mx = fmaxf(mx, __shfl_xor(mx, 32, 64));
        if (kt == 0) {
          mref = mx;
#pragma unroll
          for (int kb2 = 0; kb2 < 2; ++kb2)
#pragma unroll
            for (int r = 0; r < 16; ++r) st[kb2][r] -= mx;
        } else if (__builtin_amdgcn_ballot_w64(mx > 8.f) != 0ull) {
          const float delta = fmaxf(mx, 0.f);
          const float alpha = __builtin_amdgcn_exp2f(-delta);
          mref += delta;
          lsum *= alpha;
#pragma unroll
          for (int kb2 = 0; kb2 < 2; ++kb2)
#pragma unroll
            for (int r = 0; r < 16; ++r) st[kb2][r] -= delta;
#pragma unroll
          for (int vb = 0; vb < 2; ++vb)
#pragma unroll
            for (int r = 0; r < 16; ++r) ot[vb][r] *= alpha;
        }
        float ps = 0.f;
#pragma unroll
        for (int kb2 = 0; kb2 < 2; ++kb2)
#pragma unroll
          for (int r = 0; r < 16; ++r) {
            const float pv = __builtin_amdgcn_exp2f(st[kb2][r]);
            st[kb2][r] = pv;
            ps += pv;
          }
        lsum += ps;
#pragma unroll
        for (int kb2 = 0; kb2 < 2; ++kb2)
#pragma unroll
          for (int s2 = 0; s2 < 2; ++s2) {
            bf16x8 pf;
#pragma unroll
            for (int j = 0; j < 8; ++j) pf[j] = (bf16)st[kb2][8 * s2 + j];
#pragma unroll
            for (int vb = 0; vb < 2; ++vb) {
              const bf16x4 lo = *(const bf16x4*)&sm.v[cb_][vb * 32 + q][kb2 * 32 + 16 * s2 + 4 * hh];
              const bf16x4 hi = *(const bf16x4*)&sm.v[cb_][vb * 32 + q][kb2 * 32 + 16 * s2 + 8 + 4 * hh];
              bf16x8 a;
              a[0] = lo[0]; a[1] = lo[1]; a[2] = lo[2]; a[3] = lo[3];
              a[4] = hi[0]; a[5] = hi[1]; a[6] = hi[2]; a[7] = hi[3];
              ot[vb] = __builtin_amdgcn_mfma_f32_32x32x16_bf16(a, pf, ot[vb], 0, 0, 0);
            }
          }
      }
      __syncthreads();
    }
    const float ltot = lsum + __shfl_xor(lsum, 32, 64);
    const float inv = 1.f / ltot;
    const int b = bh >> 3, h = bh & 7;
    bf16* op = O + ((size_t)b * SEQ + s0 + w * 32 + q) * 512 + h * 64;
#pragma unroll
    for (int vb = 0; vb < 2; ++vb)
#pragma unroll
      for (int rg = 0; rg < 4; ++rg) {
        bf16x4 o;
        o[0] = (bf16)(ot[vb][4 * rg + 0] * inv); o[1] = (bf16)(ot[vb][4 * rg + 1] * inv);
        o[2] = (bf16)(ot[vb][4 * rg + 2] * inv); o[3] = (bf16)(ot[vb][4 * rg + 3] * inv);
        *(bf16x4*)(op + vb * 32 + 8 * rg + 4 * hh) = o;
      }
  }
}

constexpr int CS_LD = 72;
constexpr int CS_SLOT = 64 * CS_LD * 2;
constexpr size_t CS_ITEM = 64 * 64;
constexpr size_t OFF_CS_PH = 0;
constexpr size_t OFF_CS_PL = 32 * MiB;
constexpr size_t OFF_CS_QA = 64 * MiB;
constexpr size_t OFF_CS_SL = 96 * MiB;
constexpr size_t OFF_CS_YL1 = 358 * MiB;
constexpr size_t OFF_CS_YL2 = 316 * MiB;
DEVI size_t cs_yl_off(int item) { return (item < 3072) ? OFF_CS_YL1 + (size_t)item * CS_ITEM * 2 : OFF_CS_YL2 + (size_t)(item - 3072) * CS_ITEM * 2; }

DEVI f32x4 mfma16(bf16x8 a, bf16x8 b, f32x4 c) { return __builtin_amdgcn_mfma_f32_16x16x32_bf16(a, b, c, 0, 0, 0); }
DEVI f32x4 cs_block(const bf16* X, const bf16* Y, int rb, int cb, int lane, f32x4 acc) {
  const int r = lane & 15, g = lane >> 4;
#pragma unroll
  for (int ks = 0; ks < 2; ++ks) {
    const bf16x8 a = *(const bf16x8*)(X + (rb * 16 + r) * CS_LD + ks * 32 + g * 8);
    const bf16x8 b = *(const bf16x8*)(Y + (cb * 16 + r) * CS_LD + ks * 32 + g * 8);
    acc = mfma16(a, b, acc);
  }
  return acc;
}
DEVI void cs_store_rowmajor(bf16* D, int rb, int cb, int lane, f32x4 v) {
  const int row0 = rb * 16 + 4 * (lane >> 4), col = cb * 16 + (lane & 15);
  D[(row0 + 0) * CS_LD + col] = (bf16)v.x; D[(row0 + 1) * CS_LD + col] = (bf16)v.y;
  D[(row0 + 2) * CS_LD + col] = (bf16)v.z; D[(row0 + 3) * CS_LD + col] = (bf16)v.w;
}
DEVI void cs_store_transposed(bf16* DT, int rb, int cb, int lane, f32x4 v) {
  const int row0 = rb * 16 + 4 * (lane >> 4), col = cb * 16 + (lane & 15);
  *(bf16x4*)(DT + col * CS_LD + row0) = to_bf4(v);
}

DEVI void phase3A(const ParamsG& p, unsigned char* smem) {
  const bf16* zrw = (const bf16*)(gp(p.ws) + OFF_ZRW);
  const bf16* E = (const bf16*)(gp(p.ws) + OFF_E);
  const bf16* ICLR = (const bf16*)(gp(p.ws) + OFF_ICLR);
  float* RK = (float*)(gp(p.ws) + OFF_RK);
  bf16* gPH = (bf16*)((unsigned char*)gp(p.out) + OFF_CS_PH);
  bf16* gPL = (bf16*)((unsigned char*)gp(p.out) + OFF_CS_PL);
  bf16* gQA = (bf16*)((unsigned char*)gp(p.out) + OFF_CS_QA);
  bf16* gSL = (bf16*)((unsigned char*)gp(p.out) + OFF_CS_SL);
  bf16* SLOT[14];
#pragma unroll
  for (int i = 0; i < 14; ++i) SLOT[i] = (bf16*)(smem + i * CS_SLOT);
  float* GL = (float*)smem;
  bf16* RAWA = SLOT[2]; bf16* RAWB = SLOT[3]; bf16* RAWK = SLOT[4]; bf16* RAWV = SLOT[5];
  bf16* At = SLOT[6]; bf16* Rt = SLOT[7]; bf16* Bt = SLOT[8]; bf16* Kt = SLOT[9];
  bf16* AT = SLOT[10]; bf16* BH = SLOT[11]; bf16* KH = SLOT[12]; bf16* VT = SLOT[13];
  float* BTOT = (float*)(smem + 14 * CS_SLOT);
  float* G63 = BTOT + 8 * 64;
  bf16* Lm = SLOT[0]; bf16* LmT = SLOT[1]; bf16* Lak = SLOT[2]; bf16* Mrb = SLOT[3]; bf16* Mrk = SLOT[4];
  const int tid = threadIdx.x, lane = tid & 63, w = tid >> 6;
  const int rb = w >> 1, cb0 = 2 * (w & 1);
  bf16x8 zr, zk, zv, pr, pk, pv, ic, e8;
  auto fetch = [&](int item) {
    const int bh = item >> 6, ch = item & 63, b = bh >> 3, h = bh & 7;
    const int tt = tid >> 3, kc = (tid & 7) * 8;
    const int s = ch * 64 + tt;
    const size_t t = (size_t)b * SEQ + s;
    const int c0 = h * 64 + kc;
    const bf16* zp = zrw + t * RWC + c0;
    zr = *(const bf16x8*)zp; zk = *(const bf16x8*)(zp + 512); zv = *(const bf16x8*)(zp + 1024);
    if (s > 0) { pr = *(const bf16x8*)(zp - RWC); pk = *(const bf16x8*)(zp - RWC + 512); pv = *(const bf16x8*)(zp - RWC + 1024); }
    else {
#pragma unroll
      for (int j = 0; j < 8; ++j) { pr[j] = (bf16)0.f; pk[j] = (bf16)0.f; pv[j] = (bf16)0.f; }
    }
    e8 = *(const bf16x8*)(E + t * 512 + c0);
    ic = *(const bf16x8*)(ICLR + t * 512 + c0);
  };
  if ((int)blockIdx.x < 4096) fetch(blockIdx.x);
  for (int item = blockIdx.x; item < 4096; item += gridDim.x) {
    const int bh = item >> 6, ch = item & 63, b = bh >> 3, h = bh & 7;
    const int tbase = ch * 64;
    float a_[8], b_[8], k2_[8], r_[8];
    {
      const int tt = tid >> 3, kc = (tid & 7) * 8;
      const int s = tbase + tt;
      const size_t t = (size_t)b * SEQ + s;
      const int c0 = h * 64 + kc;
      const float ee[8] = {(float)e8[0], (float)e8[1], (float)e8[2], (float)e8[3], (float)e8[4], (float)e8[5], (float)e8[6], (float)e8[7]};
      float k_[8], v_[8], kx[8], icl[8], lw[8];
      float n2 = 0.f;
#pragma unroll
      for (int j = 0; j < 8; ++j) {
        const float zrj = (float)zr[j], zkj = (float)zk[j], zvj = (float)zv[j];
        r_[j] = zrj + gp(p.rw_mu)[c0 + j] * ((float)pr[j] - zrj);
        k_[j] = zkj + gp(p.rw_mu)[512 + c0 + j] * ((float)pk[j] - zkj);
        v_[j] = zvj + gp(p.rw_mu)[1024 + c0 + j] * ((float)pv[j] - zvj);
        kx[j] = k_[j] * gp(p.rw_k_k)[c0 + j];
        n2 += kx[j] * kx[j];
        icl[j] = sigmoid_f(gp(p.rw_a0)[c0 + j] + (float)ic[j]);
        lw[j] = -0.60653066f * sigmoid_f(gp(p.rw_w0)[c0 + j] + ee[j]);
      }
      n2 = row8_allsum(n2);
      const float inv = 1.f / fmaxf(sqrtf(n2), 1e-12f);
      float rkp = 0.f;
#pragma unroll
      for (int j = 0; j < 8; ++j) {
        const float kkn = kx[j] * inv;
        k2_[j] = k_[j] * (1.f + (icl[j] - 1.f) * gp(p.rw_k_a)[c0 + j]);
        a_[j] = -kkn;
        b_[j] = kkn * icl[j];
        rkp += r_[j] * k2_[j] * gp(p.rw_r_k)[c0 + j];
      }
      rkp = row8_allsum(rkp);
      if ((tid & 7) == 0) RK[t * 8 + h] = rkp;
      *(f32x4*)&GL[tt * 64 + kc] = mk_f4(lw[0], lw[1], lw[2], lw[3]);
      *(f32x4*)&GL[tt * 64 + kc + 4] = mk_f4(lw[4], lw[5], lw[6], lw[7]);
      bf16x8 oa, ob, ok, ov;
#pragma unroll
      for (int j = 0; j < 8; ++j) { oa[j] = (bf16)a_[j]; ob[j] = (bf16)b_[j]; ok[j] = (bf16)k2_[j]; ov[j] = (bf16)v_[j]; }
      *(bf16x8*)(RAWA + tt * CS_LD + kc) = oa; *(bf16x8*)(RAWB + tt * CS_LD + kc) = ob;
      *(bf16x8*)(RAWK + tt * CS_LD + kc) = ok; *(bf16x8*)(RAWV + tt * CS_LD + kc) = ov;
    }
    if (item + (int)gridDim.x < 4096) fetch(item + gridDim.x);
    __syncthreads();
    {
      const int kch = tid & 63, tb = tid >> 6;
      float run = 0.f;
#pragma unroll
      for (int i = 0; i < 8; ++i) { run += GL[(tb * 8 + i) * 64 + kch]; GL[(tb * 8 + i) * 64 + kch] = run; }
      BTOT[tb * 64 + kch] = run;
    }
    __syncthreads();
    {
      const int kch = tid & 63, tb = tid >> 6;
      float off = 0.f;
      for (int i = 0; i < tb; ++i) off += BTOT[i * 64 + kch];
#pragma unroll
      for (int i = 0; i < 8; ++i) GL[(tb * 8 + i) * 64 + kch] += off;
    }
    __syncthreads();
    {
      const int tt = tid >> 3, kc = (tid & 7) * 8;
      bf16x8 oA, oR, oB, oK;
#pragma unroll
      for (int j = 0; j < 8; ++j) {
        const float g = GL[tt * 64 + kc + j];
        const float gm = (tt > 0) ? GL[(tt - 1) * 64 + kc + j] : 0.f;
        const float ig = __expf(-g);
        oA[j] = (bf16)(a_[j] * __expf(gm));
        oR[j] = (bf16)(r_[j] * __expf(g));
        oB[j] = (bf16)(b_[j] * ig);
        oK[j] = (bf16)(k2_[j] * ig);
      }
      *(bf16x8*)(At + tt * CS_LD + kc) = oA; *(bf16x8*)(Rt + tt * CS_LD + kc) = oR;
      *(bf16x8*)(Bt + tt * CS_LD + kc) = oB; *(bf16x8*)(Kt + tt * CS_LD + kc) = oK;
    }
    {
      const int kch = tid & 63, tb = tid >> 6;
      const float g63 = GL[63 * 64 + kch];
      bf16x8 oAT, oBH, oKH, oVT;
#pragma unroll
      for (int i = 0; i < 8; ++i) {
        const int t = tb * 8 + i;
        const float g = GL[t * 64 + kch];
        const float gm = (t > 0) ? GL[(t - 1) * 64 + kch] : 0.f;
        const float sc = __expf(g63 - g);
        oAT[i] = (bf16)((float)RAWA[t * CS_LD + kch] * __expf(gm));
        oBH[i] = (bf16)((float)RAWB[t * CS_LD + kch] * sc);
        oKH[i] = (bf16)((float)RAWK[t * CS_LD + kch] * sc);
        oVT[i] = RAWV[t * CS_LD + kch];
      }
      *(bf16x8*)(AT + kch * CS_LD + tb * 8) = oAT; *(bf16x8*)(BH + kch * CS_LD + tb * 8) = oBH;
      *(bf16x8*)(KH + kch * CS_LD + tb * 8) = oKH; *(bf16x8*)(VT + kch * CS_LD + tb * 8) = oVT;
      if (tb == 0) G63[kch] = __expf(g63);
    }
    __syncthreads();
    f32x4 tacc[2];
#pragma unroll
    for (int q = 0; q < 2; ++q) {
      const int cb = cb0 + q;
      const f32x4 z4 = mk_f4(0.f, 0.f, 0.f, 0.f);
      f32x4 dab = cs_block(At, Bt, rb, cb, lane, z4);
      f32x4 dak = cs_block(At, Kt, rb, cb, lane, z4);
      f32x4 drb = cs_block(Rt, Bt, rb, cb, lane, z4);
      f32x4 drk = cs_block(Rt, Kt, rb, cb, lane, z4);
      const int row0 = rb * 16 + 4 * (lane >> 4), col = cb * 16 + (lane & 15);
#pragma unroll
      for (int i = 0; i < 4; ++i) {
        const int row = row0 + i;
        if (col >= row) { dab[i] = 0.f; dak[i] = 0.f; }
        if (col > row) { drb[i] = 0.f; drk[i] = 0.f; }
      }
      tacc[q] = dab;
#pragma unroll
      for (int i = 0; i < 4; ++i) if (col == row0 + i) tacc[q][i] += 1.f;
      asm volatile("" ::: "memory");
      cs_store_rowmajor(Lm, rb, cb, lane, dab);
      cs_store_transposed(LmT, rb, cb, lane, dab);
      cs_store_rowmajor(Lak, rb, cb, lane, dak);
      cs_store_rowmajor(Mrb, rb, cb, lane, drb);
      cs_store_rowmajor(Mrk, rb, cb, lane, drk);
      cs_store_transposed(SLOT[5], rb, cb, lane, tacc[q]);
    }
    __syncthreads();
    {
      bf16* Pc = Lm; bf16* PcT = LmT; bf16* Pn = At; bf16* PnT = Bt;
      bf16* TTc = SLOT[5]; bf16* TTn = Kt;
#pragma unroll 1
      for (int it = 0; it < 5; ++it) {
        f32x4 pp[2];
#pragma unroll
        for (int q = 0; q < 2; ++q) pp[q] = cs_block(Pc, PcT, rb, cb0 + q, lane, mk_f4(0.f, 0.f, 0.f, 0.f));
#pragma unroll
        for (int q = 0; q < 2; ++q) { cs_store_rowmajor(Pn, rb, cb0 + q, lane, pp[q]); cs_store_transposed(PnT, rb, cb0 + q, lane, pp[q]); }
        __syncthreads();
#pragma unroll
        for (int q = 0; q < 2; ++q) tacc[q] = cs_block(Pn, TTc, rb, cb0 + q, lane, tacc[q]);
#pragma unroll
        for (int q = 0; q < 2; ++q) cs_store_transposed(TTn, rb, cb0 + q, lane, tacc[q]);
        __syncthreads();
        bf16* t1 = Pc; Pc = Pn; Pn = t1; t1 = PcT; PcT = PnT; PnT = t1; t1 = TTc; TTc = TTn; TTn = t1;
      }
    }
    bf16* Tm = SLOT[0]; bf16* WT = SLOT[1]; bf16* TAT = SLOT[5]; bf16* ULT = SLOT[6];
#pragma unroll
    for (int q = 0; q < 2; ++q) cs_store_rowmajor(Tm, rb, cb0 + q, lane, tacc[q]);
#pragma unroll
    for (int q = 0; q < 2; ++q) cs_store_transposed(WT, rb, cb0 + q, lane, cs_block(Lak, VT, rb, cb0 + q, lane, mk_f4(0.f, 0.f, 0.f, 0.f)));
    __syncthreads();
#pragma unroll
    for (int q = 0; q < 2; ++q) {
      cs_store_transposed(TAT, rb, cb0 + q, lane, cs_block(Tm, AT, rb, cb0 + q, lane, mk_f4(0.f, 0.f, 0.f, 0.f)));
      cs_store_transposed(ULT, rb, cb0 + q, lane, cs_block(Tm, WT, rb, cb0 + q, lane, mk_f4(0.f, 0.f, 0.f, 0.f)));
    }
    __syncthreads();
    {
      bf16* oQA = SLOT[2]; bf16* oYL = SLOT[8]; bf16* oPH = SLOT[9];
      f32x4 pm_[2], sl_[2];
#pragma unroll
      for (int q = 0; q < 2; ++q) {
        const int cb = cb0 + q;
        const int row0 = rb * 16 + 4 * (lane >> 4), col = cb * 16 + (lane & 15);
        f32x4 qa;
#pragma unroll
        for (int i = 0; i < 4; ++i) qa[i] = (float)Rt[(row0 + i) * CS_LD + col];
        qa = cs_block(Mrb, TAT, rb, cb, lane, qa);
        f32x4 yl = cs_block(Mrb, ULT, rb, cb, lane, mk_f4(0.f, 0.f, 0.f, 0.f));
        yl = cs_block(Mrk, VT, rb, cb, lane, yl);
        f32x4 pm = cs_block(BH, TAT, rb, cb, lane, mk_f4(0.f, 0.f, 0.f, 0.f));
#pragma unroll
        for (int i = 0; i < 4; ++i) if (col == row0 + i) pm[i] += G63[col];
        f32x4 sl = cs_block(BH, ULT, rb, cb, lane, mk_f4(0.f, 0.f, 0.f, 0.f));
        sl = cs_block(KH, VT, rb, cb, lane, sl);
        cs_store_rowmajor(oQA, rb, cb, lane, qa);
        cs_store_rowmajor(oYL, rb, cb, lane, yl);
        cs_store_rowmajor(oPH, rb, cb, lane, pm);
        pm_[q] = pm; sl_[q] = sl;
      }
      __syncthreads();
      bf16* oPL = SLOT[0]; bf16* oSL = SLOT[1];
#pragma unroll
      for (int q = 0; q < 2; ++q) {
        const int cb = cb0 + q;
        const int row0 = rb * 16 + 4 * (lane >> 4), col = cb * 16 + (lane & 15);
        f32x4 lo;
#pragma unroll
        for (int i = 0; i < 4; ++i) lo[i] = pm_[q][i] - (float)oPH[(row0 + i) * CS_LD + col];
        cs_store_rowmajor(oPL, rb, cb, lane, lo);
        cs_store_rowmajor(oSL, rb, cb, lane, sl_[q]);
      }
      __syncthreads();
      const size_t ib = (size_t)item * CS_ITEM + (size_t)tid * 8;
      const int row = tid >> 3, cc = (tid & 7) * 8;
      *(u32x4*)(gQA + ib) = *(const u32x4*)(oQA + row * CS_LD + cc);
      *(u32x4*)((bf16*)(gp(p.ws) + cs_yl_off(item)) + (size_t)tid * 8) = *(const u32x4*)(oYL + row * CS_LD + cc);
      *(u32x4*)(gPH + ib) = *(const u32x4*)(oPH + row * CS_LD + cc);
      *(u32x4*)(gPL + ib) = *(const u32x4*)(oPL + row * CS_LD + cc);
      *(u32x4*)(gSL + ib) = *(const u32x4*)(oSL + row * CS_LD + cc);
    }
    __syncthreads();
  }
}

struct CsStage { bf16 ph[64 * CS_LD]; bf16 pl[64 * CS_LD]; bf16 qa[64 * CS_LD]; bf16 sl[64 * 16]; bf16 yl[64 * 16]; bf16 zh[16 * CS_LD]; bf16 zl[16 * CS_LD]; };
DEVI void phase3B(const ParamsG& p, unsigned char* smem) {
  const bf16* gPH = (const bf16*)((const unsigned char*)gp(p.out) + OFF_CS_PH);
  const bf16* gPL = (const bf16*)((const unsigned char*)gp(p.out) + OFF_CS_PL);
  const bf16* gQA = (const bf16*)((const unsigned char*)gp(p.out) + OFF_CS_QA);
  const bf16* gSL = (const bf16*)((const unsigned char*)gp(p.out) + OFF_CS_SL);
  bf16* YRAW = (bf16*)(gp(p.ws) + OFF_YRAW);
  CsStage* st = (CsStage*)smem;
  const int tid = threadIdx.x, lane = tid & 63, w = tid >> 6;
  const int r = lane & 15, g = lane >> 4;
  for (int item = blockIdx.x; item < 256; item += gridDim.x) {
    const int bh = item >> 2, vb = item & 3, b = bh >> 3, h = bh & 7;
    u32x4 rPH[2], rPL[2], rQA[2]; unsigned rSL[2], rYL[2];
    auto gload = [&](int ch, int sl) {
      const int it2 = bh * 64 + ch;
      const size_t ib = (size_t)it2 * CS_ITEM;
      rPH[sl] = *(const u32x4*)(gPH + ib + (size_t)tid * 8);
      rPL[sl] = *(const u32x4*)(gPL + ib + (size_t)tid * 8);
      rQA[sl] = *(const u32x4*)(gQA + ib + (size_t)tid * 8);
      const size_t o = (size_t)(tid >> 3) * 64 + vb * 16 + (tid & 7) * 2;
      rSL[sl] = *(const unsigned*)(gSL + ib + o);
      rYL[sl] = *(const unsigned*)((const bf16*)(gp(p.ws) + cs_yl_off(it2)) + o);
    };
    auto stage_write = [&](int ch, int sl) {
      CsStage& s2 = st[ch & 1];
      const int row = tid >> 3, cc = (tid & 7) * 8;
      *(u32x4*)(s2.ph + row * CS_LD + cc) = rPH[sl];
      *(u32x4*)(s2.pl + row * CS_LD + cc) = rPL[sl];
      *(u32x4*)(s2.qa + row * CS_LD + cc) = rQA[sl];
      *(unsigned*)(s2.sl + row * 16 + (tid & 7) * 2) = rSL[sl];
      *(unsigned*)(s2.yl + row * 16 + (tid & 7) * 2) = rYL[sl];
    };
    gload(0, 0);
    gload(1, 1);
    __syncthreads();
    for (int i = tid; i < 16 * CS_LD; i += NTHREADS) { st[0].zh[i] = (bf16)0.f; st[0].zl[i] = (bf16)0.f; }
    stage_write(0, 0);
    gload(2, 0);
    __syncthreads();
#pragma unroll 2
    for (int ch = 0; ch < 64; ++ch) {
      if (ch + 1 < 64) stage_write(ch + 1, (ch + 1) & 1);
      if (ch + 3 < 64) gload(ch + 3, (ch + 1) & 1);
      const CsStage& c = st[ch & 1];
      CsStage& n = st[(ch + 1) & 1];
      if (w < 4) {
        f32x4 acc;
#pragma unroll
        for (int i = 0; i < 4; ++i) acc[i] = (float)c.sl[(w * 16 + 4 * g + i) * 16 + r];
#pragma unroll
        for (int ks = 0; ks < 2; ++ks) {
          const bf16x8 ah = *(const bf16x8*)(c.ph + (w * 16 + r) * CS_LD + ks * 32 + g * 8);
          const bf16x8 al = *(const bf16x8*)(c.pl + (w * 16 + r) * CS_LD + ks * 32 + g * 8);
          const bf16x8 bh8 = *(const bf16x8*)(c.zh + r * CS_LD + ks * 32 + g * 8);
          const bf16x8 bl8 = *(const bf16x8*)(c.zl + r * CS_LD + ks * 32 + g * 8);
          acc = mfma16(ah, bh8, acc);
          acc = mfma16(ah, bl8, acc);
          acc = mfma16(al, bh8, acc);
        }
        const bf16x4 hi4 = to_bf4(acc);
        f32x4 res;
#pragma unroll
        for (int i = 0; i < 4; ++i) res[i] = acc[i] - (float)hi4[i];
        *(bf16x4*)(n.zh + r * CS_LD + w * 16 + 4 * g) = hi4;
        *(bf16x4*)(n.zl + r * CS_LD + w * 16 + 4 * g) = to_bf4(res);
      } else {
        const int tb = w - 4;
        f32x4 acc;
#pragma unroll
        for (int i = 0; i < 4; ++i) acc[i] = (float)c.yl[(tb * 16 + 4 * g + i) * 16 + r];
#pragma unroll
        for (int ks = 0; ks < 2; ++ks) {
          const bf16x8 a = *(const bf16x8*)(c.qa + (tb * 16 + r) * CS_LD + ks * 32 + g * 8);
          const bf16x8 bh8 = *(const bf16x8*)(c.zh + r * CS_LD + ks * 32 + g * 8);
          const bf16x8 bl8 = *(const bf16x8*)(c.zl + r * CS_LD + ks * 32 + g * 8);
          acc = mfma16(a, bh8, acc);
          acc = mfma16(a, bl8, acc);
        }
#pragma unroll
        for (int i = 0; i < 4; ++i) {
          const size_t t = (size_t)b * SEQ + ch * 64 + tb * 16 + 4 * g + i;
          YRAW[t * 512 + h * 64 + vb * 16 + r] = (bf16)acc[i];
        }
      }
      __syncthreads();
    }
  }
}

DEVI void phase3c(const ParamsG& p) {
  const int lane = threadIdx.x & 63;
  const int gw = blockIdx.x * NWAVES + (threadIdx.x >> 6), nw = gridDim.x * NWAVES;
  const bf16* zrw = (const bf16*)(gp(p.ws) + OFF_ZRW);
  const bf16* YRAW = (const bf16*)(gp(p.ws) + OFF_YRAW);
  const bf16* G = (const bf16*)(gp(p.ws) + OFF_G);
  const float* RK = (const float*)(gp(p.ws) + OFF_RK);
  bf16* YA = (bf16*)(gp(p.ws) + OFF_YAPRE);
  const int c0 = lane * 8, head = lane >> 3;
  float gw_[8], gb_[8], mu_[8];
#pragma unroll
  for (int j = 0; j < 8; ++j) { gw_[j] = gp(p.rw_gn_w)[c0 + j]; gb_[j] = gp(p.rw_gn_b)[c0 + j]; mu_[j] = gp(p.rw_mu)[1024 + c0 + j]; }
  for (int t = gw; t < T_TOK; t += nw) {
    const int s = t & (SEQ - 1);
    const bf16x8 y8 = *(const bf16x8*)(YRAW + (size_t)t * 512 + c0);
    float y[8];
    float sm = 0.f;
#pragma unroll
    for (int j = 0; j < 8; ++j) { y[j] = (float)y8[j]; sm += y[j]; }
    const float mean = row8_allsum(sm) * (1.f / 64.f);
    float sq = 0.f;
#pragma unroll
    for (int j = 0; j < 8; ++j) { y[j] -= mean; sq += y[j] * y[j]; }
    const float var = row8_allsum(sq) * (1.f / 64.f);
    const float rstd = rsqrtf(var + 64e-5f);
    const bf16* vp = zrw + (size_t)t * RWC + 1024 + c0;
    const bf16x8 vc = *(const bf16x8*)vp;
    bf16x8 vq;
    if (s > 0) vq = *(const bf16x8*)(vp - RWC);
    else {
#pragma unroll
      for (int j = 0; j < 8; ++j) vq[j] = (bf16)0.f;
    }
    const bf16x8 g8 = *(const bf16x8*)(G + (size_t)t * 512 + c0);
    const float rk = RK[(size_t)t * 8 + head];
    bf16x8 o;
#pragma unroll
    for (int j = 0; j < 8; ++j) {
      const float vcur = (float)vc[j];
      const float vs = vcur + mu_[j] * ((float)vq[j] - vcur);
      const float yn = y[j] * rstd * gw_[j] + gb_[j];
      o[j] = (bf16)((yn + rk * vs) * (float)g8[j]);
    }
    *(bf16x8*)(YA + (size_t)t * 512 + c0) = o;
  }
}

template <int MODE> struct EpiMix {
  static constexpr bool PERM = true, AFTER_DRAIN = false;
  bf16* D; const bf16* S;
  DEVI void operator()(PgAcc acc, const pg8::Unit& u, int wr, int wc, int fr, int fq) const {
    if constexpr (MODE == 1) {
      bf16x4 ly[2][4];
      PG_EPI_PIPELINED(
        ly[slot][c] = *(const bf16x4*)(D + off); ,
        const bf16x4 y = ly[slot][c];
        f32x4 o; o.x = (float)y[0] * sigmoid_f(v.x); o.y = (float)y[1] * sigmoid_f(v.y); o.z = (float)y[2] * sigmoid_f(v.z); o.w = (float)y[3] * sigmoid_f(v.w);
        *(bf16x4*)(D + off) = to_bf4(o);
      )
      return;
    }
    if constexpr (MODE == 3) {
      bf16x4 ly[2][4]; bf16x4 ls[2][4];
      PG_EPI_PIPELINED(
        ly[slot][c] = *(const bf16x4*)(D + off); ls[slot][c] = *(const bf16x4*)(S + off); ,
        const bf16x4 y = ly[slot][c]; const bf16x4 y2 = ls[slot][c];
        f32x4 o; o.x = (float)y[0] + (float)y2[0] * sigmoid_f(v.x); o.y = (float)y[1] + (float)y2[1] * sigmoid_f(v.y);
        o.z = (float)y[2] + (float)y2[2] * sigmoid_f(v.z); o.w = (float)y[3] + (float)y2[3] * sigmoid_f(v.w);
        *(bf16x4*)(D + off) = to_bf4(o);
      )
      return;
    }
    PG_EPI_ROWS(PG_EPI_COLS(
      bf16* q = D + (unsigned)(row * DM + col);
      if (MODE == 0) *(bf16x4*)q = to_bf4(v);
      else if (MODE == 1) {
        const bf16x4 y = *(const bf16x4*)q;
        f32x4 o; o.x = (float)y[0] * sigmoid_f(v.x); o.y = (float)y[1] * sigmoid_f(v.y); o.z = (float)y[2] * sigmoid_f(v.z); o.w = (float)y[3] * sigmoid_f(v.w);
        *(bf16x4*)q = to_bf4(o);
      } else {
        const bf16x4 y = *(const bf16x4*)q; const bf16x4 y2 = *(const bf16x4*)(S + (unsigned)(row * DM + col));
        f32x4 o; o.x = (float)y[0] + (float)y2[0] * sigmoid_f(v.x); o.y = (float)y[1] + (float)y2[1] * sigmoid_f(v.y);
        o.z = (float)y[2] + (float)y2[2] * sigmoid_f(v.z); o.w = (float)y[3] + (float)y2[3] * sigmoid_f(v.w);
        *(bf16x4*)q = to_bf4(o);
      }
    ))
  }
};
DEVI void phase4(const ParamsG& p, unsigned char* smem) {
  unsigned char* ws = gp(p.ws);
  const bf16* H1 = (const bf16*)(ws + OFF_H1);
  const bf16* WG = (const bf16*)(ws + OFF_WG_T);
  bf16* M = (bf16*)(ws + OFF_M);
  bf16* M2 = (bf16*)(ws + OFF_M2);
  { EpiMix<0> e; e.D = M; e.S = nullptr; run_gemm(smem, (const bf16*)(ws + OFF_YAPRE), (const bf16*)(ws + OFF_RWO_T), T_TOK, DM, 512, e); }
  { EpiMix<1> e; e.D = M; e.S = nullptr; run_gemm(smem, H1, WG, T_TOK, DM, DM, e); }
  { EpiMix<0> e; e.D = M2; e.S = nullptr; run_gemm(smem, (const bf16*)(ws + OFF_O), (const bf16*)(ws + OFF_MLO_T), T_TOK, DM, 512, e); }
  { EpiMix<3> e; e.D = M; e.S = M2; run_gemm(smem, H1, WG + (size_t)1024 * DM, T_TOK, DM, DM, e); }
}

struct EpiX1 {
  static constexpr bool PERM = true, AFTER_DRAIN = false;
  const float* x; bf16* xb;
  DEVI void operator()(PgAcc acc, const pg8::Unit& u, int wr, int wc, int fr, int fq) const {
    f32x4 lx[2][4];
    PG_EPI_PIPELINED(
      lx[slot][c] = *(const f32x4*)(x + off); ,
      const f32x4 s4 = lx[slot][c] + v;
      bf16x4 o; o[0] = (bf16)s4.x; o[1] = (bf16)s4.y; o[2] = (bf16)s4.z; o[3] = (bf16)s4.w;
      *(bf16x4*)(xb + off) = o;
    )
  }
};
DEVI void phase5(const ParamsG& p, unsigned char* smem) {
  EpiX1 e; e.x = gp(p.x); e.xb = (bf16*)(gp(p.ws) + OFF_XB);
  run_gemm(smem, (const bf16*)(gp(p.ws) + OFF_M), (const bf16*)(gp(p.ws) + OFF_WOUT_T), T_TOK, DM, DM, e);
}

DEVI unsigned pack_key(float s, int n) {
  unsigned u = __float_as_uint(s);
  u = (u & 0x80000000u) ? ~u : (u | 0x80000000u);
  return (u & 0xFFFFFF80u) | (unsigned)n;
}
DEVI float key_score(unsigned k) {
  unsigned u = k & 0xFFFFFF80u;
  u = (u & 0x80000000u) ? (u & 0x7FFFFFFFu) : ~u;
  return __uint_as_float(u);
}
template <int N> DEVI void bitonic_sort_desc(unsigned (&v)[N]) {
#pragma unroll
  for (int k = 2; k <= N; k <<= 1) {
#pragma unroll
    for (int j = k >> 1; j > 0; j >>= 1) {
#pragma unroll
      for (int i = 0; i < N; ++i) {
        const int l = i ^ j;
        if (l > i) {
          const bool desc = ((i & k) == 0);
          const unsigned a = v[i], b = v[l];
          const unsigned mx = a > b ? a : b, mn = a > b ? b : a;
          v[i] = desc ? mx : mn;
          v[l] = desc ? mn : mx;
        }
      }
    }
  }
}
template <int N> DEVI void bitonic_merge_desc(unsigned (&v)[N]) {
#pragma unroll
  for (int j = N >> 1; j > 0; j >>= 1) {
#pragma unroll
    for (int i = 0; i < N; ++i) {
      const int l = i ^ j;
      if (l > i) {
        const unsigned a = v[i], b = v[l];
        v[i] = a > b ? a : b;
        v[l] = a > b ? b : a;
      }
    }
  }
}

DEVI void phase7(const ParamsG& p, unsigned char* smem) {
  const bf16* H2 = (const bf16*)(gp(p.ws) + OFF_XB);
  const bf16* WQ = (const bf16*)(gp(p.ws) + OFF_WQ_T);
  const bf16* SK = (const bf16*)(gp(p.ws) + OFF_SK);
  unsigned* TOPK = (unsigned*)(gp(p.ws) + OFF_TOPK);
  const int lane = threadIdx.x & 63, w = threadIdx.x >> 6;
  const int hh = lane >> 5;
  for (int it = 0;; ++it) {
    int tm, hc;
    if (!tile_map<128, 16, 2>(it, tm, hc)) break;
    const int m0 = tm * 256;
    f32x16 acc[4];
#pragma unroll
    for (int mt = 0; mt < 4; ++mt)
#pragma unroll
      for (int r = 0; r < 16; ++r) acc[mt][r] = 0.f;
    float ssq;
    route_mainloop<true>(acc, WQ + (size_t)(hc * 128) * DM, DM, H2 + (size_t)m0 * DM, DM, 16, smem, SK + (size_t)hc * 128 * 128, &ssq);
    ssq += __shfl_xor(ssq, 32, 64);
    const float rstd = rsqrtf(ssq * (1.f / DM) + 1e-6f);
    bf16x8 qf[4][2];
#pragma unroll
    for (int db = 0; db < 4; ++db)
#pragma unroll
      for (int s2 = 0; s2 < 2; ++s2)
#pragma unroll
        for (int j = 0; j < 8; ++j) qf[db][s2][j] = (bf16)(acc[db][8 * s2 + j] * rstd);
    unsigned key[64];
    int hh4 = 4 * hh; asm volatile("" : "+v"(hh4));
    const unsigned char* skl = smem + (16 % 3) * 49152;
#pragma unroll
    for (int nb = 0; nb < 4; ++nb) {
      f32x16 sc;
#pragma unroll
      for (int r = 0; r < 16; ++r) sc[r] = 0.f;
      const int n = nb * 32 + (lane & 31);
      const unsigned char* rowp = skl + n * 256 + 8 * hh;
#pragma unroll
      for (int db = 0; db < 4; ++db)
#pragma unroll
        for (int s2 = 0; s2 < 2; ++s2) {
          const int c = db * 4 + 2 * s2;
          const bf16x4 lo = *(const bf16x4*)(rowp + ((c ^ (n & 15)) * 16));
          const bf16x4 hi = *(const bf16x4*)(rowp + (((c + 1) ^ (n & 15)) * 16));
          bf16x8 a;
          a[0] = lo[0]; a[1] = lo[1]; a[2] = lo[2]; a[3] = lo[3];
          a[4] = hi[0]; a[5] = hi[1]; a[6] = hi[2]; a[7] = hi[3];
          sc = __builtin_amdgcn_mfma_f32_32x32x16_bf16(a, qf[db][s2], sc, 0, 0, 0);
        }
#pragma unroll
      for (int r = 0; r < 16; ++r) key[nb * 16 + r] = pack_key(sc[r], nb * 32 + (r & 3) + 8 * (r >> 2) + hh4);
    }
    unsigned g0[16], g1[16], g2[16], g3[16];
#pragma unroll
    for (int i = 0; i < 16; ++i) { g0[i] = key[i]; g1[i] = key[16 + i]; g2[i] = key[32 + i]; g3[i] = key[48 + i]; }
    bitonic_sort_desc<16>(g0); bitonic_sort_desc<16>(g1); bitonic_sort_desc<16>(g2); bitonic_sort_desc<16>(g3);
#pragma unroll
    for (int i = 0; i < 16; ++i) { g0[i] = g0[i] > g1[15 - i] ? g0[i] : g1[15 - i]; g2[i] = g2[i] > g3[15 - i] ? g2[i] : g3[15 - i]; }
    bitonic_merge_desc<16>(g0); bitonic_merge_desc<16>(g2);
#pragma unroll
    for (int i = 0; i < 16; ++i) g0[i] = g0[i] > g2[15 - i] ? g0[i] : g2[15 - i];
    bitonic_merge_desc<16>(g0);
    unsigned top[16];
#pragma unroll
    for (int i = 0; i < 16; ++i) {
      const unsigned o = (unsigned)__shfl_xor((int)g0[15 - i], 32, 64);
      top[i] = g0[i] > o ? g0[i] : o;
    }
    bitonic_merge_desc<16>(top);
    if (hh == 0) {
      const int t = m0 + w * 32 + (lane & 31);
      u32x4* dst = (u32x4*)(TOPK + ((size_t)t * 16 + hc) * 16);
      dst[0] = mk_u4(top[0], top[1], top[2], top[3]);
      dst[1] = mk_u4(top[4], top[5], top[6], top[7]);
      dst[2] = mk_u4(top[8], top[9], top[10], top[11]);
      dst[3] = mk_u4(top[12], top[13], top[14], top[15]);
    }
  }
}

DEVI void phase7b(const ParamsG& p, unsigned char* smem) {
  unsigned* ka = (unsigned*)smem;
  unsigned* kb = ka + 16 * 512;
  const unsigned* TOPK = (const unsigned*)(gp(p.ws) + OFF_TOPK);
  int* IDX = (int*)(gp(p.ws) + OFF_IDX);
  float* GATE = (float*)(gp(p.ws) + OFF_GATE);
  const int tid = threadIdx.x;
  for (int grp = blockIdx.x; grp < (T_TOK * 8) / NTHREADS; grp += gridDim.x) {
    const int item = grp * NTHREADS + tid;
    const u32x4* src = (const u32x4*)(TOPK + (size_t)item * 32);
#pragma unroll
    for (int i = 0; i < 4; ++i) {
      const u32x4 va = src[i], vb = src[4 + i];
      ka[(4 * i + 0) * 512 + tid] = va.x; ka[(4 * i + 1) * 512 + tid] = va.y;
      ka[(4 * i + 2) * 512 + tid] = va.z; ka[(4 * i + 3) * 512 + tid] = va.w;
      kb[(4 * i + 0) * 512 + tid] = vb.x; kb[(4 * i + 1) * 512 + tid] = vb.y;
      kb[(4 * i + 2) * 512 + tid] = vb.z; kb[(4 * i + 3) * 512 + tid] = vb.w;
    }
    unsigned long long jp = 0ull;
    float sc[16];
    int ex[16];
#pragma unroll
    for (int r = 0; r < 16; ++r) {
      float best = -3.0e38f;
      int bi = 0, bj = 0;
      for (int i = 0; i <= r; ++i) {
        const int ji = (int)((jp >> (4 * i)) & 15ull);
        const float cand = key_score(ka[i * 512 + tid]) + key_score(kb[ji * 512 + tid]);
        if (cand > best) { best = cand; bi = i; bj = ji; }
      }
      sc[r] = best;
      ex[r] = (int)(ka[bi * 512 + tid] & 127u) * 128 + (int)(kb[bj * 512 + tid] & 127u);
      jp += 1ull << (4 * bi);
    }
    float den = 0.f;
    const float smax = sc[0];
#pragma unroll
    for (int r = 0; r < 16; ++r) { sc[r] = __expf(sc[r] - smax); den += sc[r]; }
    const float inv = 1.f / den;
    i32x4* di = (i32x4*)(IDX + (size_t)item * 16);
    f32x4* dg = (f32x4*)(GATE + (size_t)item * 16);
#pragma unroll
    for (int i = 0; i < 4; ++i) {
      di[i] = mk_i4(ex[4 * i], ex[4 * i + 1], ex[4 * i + 2], ex[4 * i + 3]);
      dg[i] = mk_f4(sc[4 * i] * inv, sc[4 * i + 1] * inv, sc[4 * i + 2] * inv, sc[4 * i + 3] * inv);
    }
  }
}

struct PeerBuf { u32x4 uq[2]; u32x4 vq[2]; float ius; float gt; };
template <class T> DEVI const T* scalar_base(const T* q) {
  const unsigned long long v = (unsigned long long)q;
  const unsigned lo = (unsigned)__builtin_amdgcn_readfirstlane((int)(unsigned)v), hi = (unsigned)__builtin_amdgcn_readfirstlane((int)(unsigned)(v >> 32));
  return (const T*)(const GLB T*)(((unsigned long long)hi << 32) | lo);
}
DEVI float gelu_as(float d) {
  const float ax = fabsf(d);
  const float x = ax * 0.70710678f;
  const float t = __builtin_amdgcn_rcpf(fmaf(0.3275911f, x, 1.f));
  float pl = fmaf(t, 1.061405429f, -1.453152027f);
  pl = fmaf(pl, t, 1.421413741f); pl = fmaf(pl, t, -0.284496736f); pl = fmaf(pl, t, 0.254829592f);
  pl *= t;
  const float ex = __builtin_amdgcn_exp2f(x * x * -1.44269504f);
  const float erfa = fmaf(-pl, ex, 1.f);
  return 0.5f * fmaf(ax, erfa, d);
}
DEVI void peer_issue(PeerBuf& b, int it, int idxr, float iusr, float givr, const unsigned char* __restrict__ U8, const unsigned char* __restrict__ V8,
                     int g, int j, int lane) {
  const int srcl = (it * 4 + g) & 63;
  const int e = __shfl(idxr, srcl, 64);
  b.ius = __shfl(iusr, srcl, 64);
  b.gt = __shfl(givr, srcl, 64);
  const unsigned uo = (unsigned)(e * 512 + j * 16);
  b.uq[0] = *(const u32x4*)(U8 + uo);
  b.uq[1] = *(const u32x4*)(U8 + uo + 256u);
  const int hf = lane >> 5;
#pragma unroll
  for (int q = 0; q < 2; ++q) {
    const int ev = __shfl(idxr, (it * 4 + 2 * q + hf) & 63, 64);
    b.vq[q] = *(const u32x4*)(V8 + (unsigned)(ev * 512 + (lane & 31) * 16));
  }
}
#define FP4_BF16(W, S) __builtin_bit_cast(unsigned, __builtin_amdgcn_cvt_scalef32_pk_bf16_fp4((W), 1.0f, (S)))
DEVI void peer_compute(const PeerBuf& b, const unsigned (&hq)[32], float (&acc)[32], int lane) {
  float d0 = 0.f, d1 = 0.f, d2 = 0.f, d3 = 0.f;
#pragma unroll
  for (int i = 0; i < 2; ++i)
#pragma unroll
    for (int wi = 0; wi < 4; ++wi) {
      const unsigned w = b.uq[i][wi];
      d0 = dot2bf(hq[i * 16 + wi * 4 + 0], FP4_BF16(w, 0), d0);
      d1 = dot2bf(hq[i * 16 + wi * 4 + 1], FP4_BF16(w, 1), d1);
      d2 = dot2bf(hq[i * 16 + wi * 4 + 2], FP4_BF16(w, 2), d2);
      d3 = dot2bf(hq[i * 16 + wi * 4 + 3], FP4_BF16(w, 3), d3);
    }
  float d = (d0 + d1) + (d2 + d3);
  d = row16_allsum(d) * b.ius;
  const float act = gelu_as(d);
  const float cf = b.gt * act;
  const int hf = lane >> 5;
#pragma unroll
  for (int q = 0; q < 2; ++q) {
    const float cc = __shfl(cf, (2 * q + hf) * 16, 64);
#pragma unroll
    for (int wi = 0; wi < 4; ++wi) {
      const unsigned w = b.vq[q][wi];
      const f32x2 f0 = __builtin_amdgcn_cvt_scalef32_pk_f32_fp4(w, 1.0f, 0);
      const f32x2 f1 = __builtin_amdgcn_cvt_scalef32_pk_f32_fp4(w, 1.0f, 1);
      const f32x2 f2 = __builtin_amdgcn_cvt_scalef32_pk_f32_fp4(w, 1.0f, 2);
      const f32x2 f3 = __builtin_amdgcn_cvt_scalef32_pk_f32_fp4(w, 1.0f, 3);
      acc[wi * 8 + 0] += cc * f0.x; acc[wi * 8 + 1] += cc * f0.y;
      acc[wi * 8 + 2] += cc * f1.x; acc[wi * 8 + 3] += cc * f1.y;
      acc[wi * 8 + 4] += cc * f2.x; acc[wi * 8 + 5] += cc * f2.y;
      acc[wi * 8 + 6] += cc * f3.x; acc[wi * 8 + 7] += cc * f3.y;
    }
  }
}
struct PeerUBuf { u32x4 uq[2]; };
DEVI void peer_uissue(PeerUBuf& b, int it, int idxr, const unsigned char* __restrict__ U8, int g, int j) {
  const int e = __shfl(idxr, (it * 4 + g) & 63, 64);
  const unsigned uo = (unsigned)(e * 512 + j * 16);
  b.uq[0] = *(const u32x4*)(U8 + uo);
  b.uq[1] = *(const u32x4*)(U8 + uo + 256u);
}
DEVI float peer_udot(const PeerUBuf& b, const unsigned (&hq)[32]) {
  float d0 = 0.f, d1 = 0.f, d2 = 0.f, d3 = 0.f;
#pragma unroll
  for (int i = 0; i < 2; ++i)
#pragma unroll
    for (int wi = 0; wi < 4; ++wi) {
      const unsigned w = b.uq[i][wi];
      d0 = dot2bf(hq[i * 16 + wi * 4 + 0], FP4_BF16(w, 0), d0);
      d1 = dot2bf(hq[i * 16 + wi * 4 + 1], FP4_BF16(w, 1), d1);
      d2 = dot2bf(hq[i * 16 + wi * 4 + 2], FP4_BF16(w, 2), d2);
      d3 = dot2bf(hq[i * 16 + wi * 4 + 3], FP4_BF16(w, 3), d3);
    }
  return row16_allsum((d0 + d1) + (d2 + d3));
}
DEVI void phase8a(const ParamsG& p) {
  int tid_ = threadIdx.x; asm volatile("" : "+v"(tid_));
  const int lane = tid_ & 63;
  const int gw = blockIdx.x * NWAVES + (tid_ >> 6), nw = gridDim.x * NWAVES;
  const bf16* H2 = (const bf16*)(gp(p.ws) + OFF_XB);
  const unsigned char* U8 = scalar_base((const unsigned char*)(gp(p.ws) + OFF_U8));
  const float* IUS = (const float*)(gp(p.ws) + OFF_IUS);
  const int* IDX = (const int*)(gp(p.ws) + OFF_IDX);
  float* DD = (float*)(gp(p.ws) + OFF_DD);
  const int g = lane >> 4, j = lane & 15;
  const int srcg = (lane & 3) * 16;
#define U_LOADROW(DST, TT) _Pragma("unroll") for (int i = 0; i < 2; ++i) { const bf16* hp_ = H2 + (size_t)(TT) * DM + i * 512 + j * 32; \
    _Pragma("unroll") for (int c = 0; c < 4; ++c) { const u32x4 a_ = *(const u32x4*)(hp_ + c * 8); \
      DST[i * 16 + c * 4 + 0] = a_.x; DST[i * 16 + c * 4 + 1] = a_.y; DST[i * 16 + c * 4 + 2] = a_.z; DST[i * 16 + c * 4 + 3] = a_.w; } }
#define U_RSTD(SRC) ({ float q0_ = 0.f, q1_ = 0.f; _Pragma("unroll") for (int i = 0; i < 32; i += 2) { q0_ = dot2bf(SRC[i], SRC[i], q0_); q1_ = dot2bf(SRC[i + 1], SRC[i + 1], q1_); } \
    rsqrtf(row16_allsum(q0_ + q1_) * (1.f / DM) + 1e-6f); })
#define UISSUE(B, IT) peer_uissue(B, (IT), ((IT) < 16) ? idx0 : idx1, U8, g, j)
#define UTAKE(B, IT) { const float d_ = __shfl(peer_udot(B, hq), srcg, 64); const bool me_ = (lane >> 2) == ((IT) & 15); \
      if ((IT) < 16) dv0 = me_ ? d_ : dv0; else dv1 = me_ ? d_ : dv1; }
  unsigned hq[32];
  int idx0 = 0, idx1 = 0;
  float iu0 = 0.f, iu1 = 0.f;
  PeerUBuf ba, bb, bc;
#pragma unroll
  for (int i = 0; i < 32; ++i) hq[i] = 0u;
  if (gw < T_TOK) {
    U_LOADROW(hq, gw)
    idx0 = IDX[(size_t)gw * 128 + lane]; idx1 = IDX[(size_t)gw * 128 + 64 + lane];
    const float rstd = U_RSTD(hq);
    iu0 = IUS[idx0] * rstd; iu1 = IUS[idx1] * rstd;
    UISSUE(ba, 0);
    UISSUE(bb, 1);
  }
  for (int t = gw; t < T_TOK; t += nw) {
    const int tn = (t + nw < T_TOK) ? t + nw : t;
    unsigned hqn[32];
    U_LOADROW(hqn, tn)
    const int idxn0 = IDX[(size_t)tn * 128 + lane], idxn1 = IDX[(size_t)tn * 128 + 64 + lane];
    float iun0 = 0.f, iun1 = 0.f;
    float dv0 = 0.f, dv1 = 0.f;
#pragma unroll 1
    for (int it = 0; it < 30; it += 3) {
      UISSUE(bc, it + 2);
      UTAKE(ba, it)
      UISSUE(ba, it + 3);
      UTAKE(bb, it + 1)
      UISSUE(bb, it + 4);
      UTAKE(bc, it + 2)
      if (it == 15) { iun0 = IUS[idxn0]; iun1 = IUS[idxn1]; }
    }
    UTAKE(ba, 30)
    UTAKE(bb, 31)
    const float d0 = dv0 * iu0, d1 = dv1 * iu1;
    const float rstdn = U_RSTD(hqn);
#pragma unroll
    for (int i = 0; i < 32; ++i) hq[i] = hqn[i];
    idx0 = idxn0; idx1 = idxn1; iu0 = iun0 * rstdn; iu1 = iun1 * rstdn;
    if (t + nw < T_TOK) { UISSUE(ba, 0); UISSUE(bb, 1); }
    DD[(size_t)t * 128 + lane] = d0;
    DD[(size_t)t * 128 + 64 + lane] = d1;
  }
#undef UISSUE
#undef UTAKE
#undef U_LOADROW
#undef U_RSTD
}
struct PeerVBuf { u32x4 vq[2]; float cc[2]; };
DEVI void peer_vissue(PeerVBuf& b, int it, int idxr, float cfr, const unsigned char* __restrict__ V8, int lane) {
  const int hf = lane >> 5;
#pragma unroll
  for (int q = 0; q < 2; ++q) {
    const int src = (it * 4 + 2 * q + hf) & 63;
    const int ev = __shfl(idxr, src, 64);
    b.cc[q] = __shfl(cfr, src, 64);
    b.vq[q] = *(const u32x4*)(V8 + (unsigned)(ev * 512 + (lane & 31) * 16));
  }
}
DEVI void peer_vcompute(const PeerVBuf& b, float (&acc)[32]) {
#pragma unroll
  for (int q = 0; q < 2; ++q) {
    const float cc = b.cc[q];
#pragma unroll
    for (int wi = 0; wi < 4; ++wi) {
      const unsigned w = b.vq[q][wi];
      const f32x2 f0 = __builtin_amdgcn_cvt_scalef32_pk_f32_fp4(w, 1.0f, 0);
      const f32x2 f1 = __builtin_amdgcn_cvt_scalef32_pk_f32_fp4(w, 1.0f, 1);
      const f32x2 f2 = __builtin_amdgcn_cvt_scalef32_pk_f32_fp4(w, 1.0f, 2);
      const f32x2 f3 = __builtin_amdgcn_cvt_scalef32_pk_f32_fp4(w, 1.0f, 3);
      acc[wi * 8 + 0] += cc * f0.x; acc[wi * 8 + 1] += cc * f0.y;
      acc[wi * 8 + 2] += cc * f1.x; acc[wi * 8 + 3] += cc * f1.y;
      acc[wi * 8 + 4] += cc * f2.x; acc[wi * 8 + 5] += cc * f2.y;
      acc[wi * 8 + 6] += cc * f3.x; acc[wi * 8 + 7] += cc * f3.y;
    }
  }
}
template <bool DRY> DEVI void phase8(const ParamsG& p) {
  int tid_ = threadIdx.x; asm volatile("" : "+v"(tid_));
  const int lane = tid_ & 63;
  const int gw = blockIdx.x * NWAVES + (tid_ >> 6), nw = gridDim.x * NWAVES;
  const unsigned char* V8 = scalar_base((const unsigned char*)(gp(p.ws) + OFF_V8));
  const float* IVS = (const float*)(gp(p.ws) + OFF_IVS);
  const int* IDX = (const int*)(gp(p.ws) + OFF_IDX);
  const float* GATE = (const float*)(gp(p.ws) + OFF_GATE);
  const float* DD = (const float*)(gp(p.ws) + OFF_DD);
  bf16* H3 = (bf16*)(gp(p.ws) + OFF_H3);
  const int ocol = (lane & 31) * 32 + (lane >> 5) * 16;
  f32x4 gpl[4];
#pragma unroll
  for (int i = 0; i < 4; ++i) gpl[i] = *(const f32x4*)(gp(p.norm_ple) + ocol + i * 4);
  const bf16* XBr = (const bf16*)(gp(p.ws) + OFF_XB);
  int idx0 = 0, idx1 = 0; float gt0 = 0.f, gt1 = 0.f, dd0 = 0.f, dd1 = 0.f, iv0 = 0.f, iv1 = 0.f;
  bf16x8 xa, xc;
#pragma unroll
  for (int i = 0; i < 8; ++i) { xa[i] = (bf16)0.f; xc[i] = (bf16)0.f; }
  if (gw < T_TOK) {
    idx0 = IDX[(size_t)gw * 128 + lane]; idx1 = IDX[(size_t)gw * 128 + 64 + lane];
    gt0 = GATE[(size_t)gw * 128 + lane]; gt1 = GATE[(size_t)gw * 128 + 64 + lane];
    dd0 = DD[(size_t)gw * 128 + lane]; dd1 = DD[(size_t)gw * 128 + 64 + lane];
    xa = *(const bf16x8*)(XBr + (size_t)gw * DM + ocol); xc = *(const bf16x8*)(XBr + (size_t)gw * DM + ocol + 8);
    iv0 = IVS[idx0]; iv1 = IVS[idx1];
  }
  float cf0 = gt0 * iv0 * gelu_as(dd0), cf1 = gt1 * iv1 * gelu_as(dd1);
  PeerVBuf ba, bb, bc;
#define PISSUE(B, IT) peer_vissue(B, (IT), ((IT) < 16) ? idx0 : idx1, ((IT) < 16) ? cf0 : cf1, V8, lane)
  if (gw < T_TOK) { PISSUE(ba, 0); PISSUE(bb, 1); }
  for (int t = gw; t < T_TOK; t += nw) {
    const int tn = (t + nw < T_TOK) ? t + nw : t;
    const int idxn0 = IDX[(size_t)tn * 128 + lane], idxn1 = IDX[(size_t)tn * 128 + 64 + lane];
    const float gtn0 = GATE[(size_t)tn * 128 + lane], gtn1 = GATE[(size_t)tn * 128 + 64 + lane];
    const float ddn0 = DD[(size_t)tn * 128 + lane], ddn1 = DD[(size_t)tn * 128 + 64 + lane];
    const bf16x8 xan = *(const bf16x8*)(XBr + (size_t)tn * DM + ocol), xcn = *(const bf16x8*)(XBr + (size_t)tn * DM + ocol + 8);
    float acc[32];
#pragma unroll
    for (int i = 0; i < 32; ++i) acc[i] = 0.f;
    float ivn0 = 0.f, ivn1 = 0.f;
#pragma unroll 1
    for (int it = 0; it < 30; it += 3) {
      PISSUE(bc, it + 2);
      peer_vcompute(ba, acc);
      PISSUE(ba, it + 3);
      peer_vcompute(bb, acc);
      PISSUE(bb, it + 4);
      peer_vcompute(bc, acc);
      if (it == 15) { ivn0 = IVS[idxn0]; ivn1 = IVS[idxn1]; }
    }
    peer_vcompute(ba, acc);
    peer_vcompute(bb, acc);
    idx0 = idxn0; idx1 = idxn1;
    cf0 = gtn0 * ivn0 * gelu_as(ddn0); cf1 = gtn1 * ivn1 * gelu_as(ddn1);
    if (t + nw < T_TOK) { PISSUE(ba, 0); PISSUE(bb, 1); }
    float keep[16];
    const bool hi = (lane >> 5) != 0;
#pragma unroll
    for (int i = 0; i < 16; ++i) {
      const float mine = hi ? acc[16 + i] : acc[i];
      const float give = hi ? acc[i] : acc[16 + i];
      keep[i] = mine + __shfl_xor(give, 32, 64);
    }
    bf16* xo = (bf16*)(gp(p.ws) + OFF_XB) + (size_t)t * DM + ocol;
    f32x4 xv[4];
    float ss = 0.f;
    {
      bf16x8 ya, yc;
#pragma unroll
      for (int i = 0; i < 2; ++i) {
        xv[i].x = (float)xa[i * 4 + 0] + keep[i * 4 + 0]; xv[i].y = (float)xa[i * 4 + 1] + keep[i * 4 + 1];
        xv[i].z = (float)xa[i * 4 + 2] + keep[i * 4 + 2]; xv[i].w = (float)xa[i * 4 + 3] + keep[i * 4 + 3];
        xv[2 + i].x = (float)xc[i * 4 + 0] + keep[8 + i * 4 + 0]; xv[2 + i].y = (float)xc[i * 4 + 1] + keep[8 + i * 4 + 1];
        xv[2 + i].z = (float)xc[i * 4 + 2] + keep[8 + i * 4 + 2]; xv[2 + i].w = (float)xc[i * 4 + 3] + keep[8 + i * 4 + 3];
        ya[i * 4 + 0] = (bf16)xv[i].x; ya[i * 4 + 1] = (bf16)xv[i].y; ya[i * 4 + 2] = (bf16)xv[i].z; ya[i * 4 + 3] = (bf16)xv[i].w;
        yc[i * 4 + 0] = (bf16)xv[2 + i].x; yc[i * 4 + 1] = (bf16)xv[2 + i].y; yc[i * 4 + 2] = (bf16)xv[2 + i].z; yc[i * 4 + 3] = (bf16)xv[2 + i].w;
      }
#pragma unroll
      for (int i = 0; i < 4; ++i) ss += xv[i].x * xv[i].x + xv[i].y * xv[i].y + xv[i].z * xv[i].z + xv[i].w * xv[i].w;
      if (!DRY) { *(bf16x8*)xo = ya; *(bf16x8*)(xo + 8) = yc; }
    }
    ss = wave_sum(ss);
    const float rs = rsqrtf(ss * (1.f / DM) + 1e-6f);
    bf16x8 o0, o1;
    o0[0] = (bf16)(xv[0].x * rs * gpl[0].x); o0[1] = (bf16)(xv[0].y * rs * gpl[0].y); o0[2] = (bf16)(xv[0].z * rs * gpl[0].z); o0[3] = (bf16)(xv[0].w * rs * gpl[0].w);
    o0[4] = (bf16)(xv[1].x * rs * gpl[1].x); o0[5] = (bf16)(xv[1].y * rs * gpl[1].y); o0[6] = (bf16)(xv[1].z * rs * gpl[1].z); o0[7] = (bf16)(xv[1].w * rs * gpl[1].w);
    o1[0] = (bf16)(xv[2].x * rs * gpl[2].x); o1[1] = (bf16)(xv[2].y * rs * gpl[2].y); o1[2] = (bf16)(xv[2].z * rs * gpl[2].z); o1[3] = (bf16)(xv[2].w * rs * gpl[2].w);
    o1[4] = (bf16)(xv[3].x * rs * gpl[3].x); o1[5] = (bf16)(xv[3].y * rs * gpl[3].y); o1[6] = (bf16)(xv[3].z * rs * gpl[3].z); o1[7] = (bf16)(xv[3].w * rs * gpl[3].w);
    *(bf16x8*)(H3 + (size_t)t * DM + ocol) = o0;
    *(bf16x8*)(H3 + (size_t)t * DM + ocol + 8) = o1;
    xa = xan; xc = xcn;
  }
#undef PISSUE
}

struct EpiX3 {
  static constexpr bool PERM = true, AFTER_DRAIN = false;
  const bf16* pps; bf16* xb;
  DEVI void operator()(PgAcc acc, const pg8::Unit& u, int wr, int wc, int fr, int fq) const {
    bf16x4 lp[2][4]; bf16x4 lx[2][4];
    PG_EPI_PIPELINED(
      lp[slot][c] = *(const bf16x4*)(pps + off); lx[slot][c] = *(const bf16x4*)(xb + off); ,
      const bf16x4 pp = lp[slot][c];
      const bf16x4 xi = lx[slot][c];
      bf16x4 xo;
      xo[0] = (bf16)((float)xi[0] + sigmoid_f(v.x) * (float)pp[0]); xo[1] = (bf16)((float)xi[1] + sigmoid_f(v.y) * (float)pp[1]);
      xo[2] = (bf16)((float)xi[2] + sigmoid_f(v.z) * (float)pp[2]); xo[3] = (bf16)((float)xi[3] + sigmoid_f(v.w) * (float)pp[3]);
      *(bf16x4*)(xb + off) = xo;
    )
  }
};
DEVI void phase10(const ParamsG& p, unsigned char* smem) {
  bf16* PPS = (bf16*)(gp(p.ws) + OFF_H2);
  { EpiMix<0> e; e.D = PPS; e.S = nullptr; run_gemm(smem, (const bf16*)(gp(p.ws) + OFF_PBF), (const bf16*)(gp(p.ws) + OFF_PP_T), T_TOK, DM, 256, e); }
  { EpiX3 e; e.pps = PPS; e.xb = (bf16*)(gp(p.ws) + OFF_XB); run_gemm(smem, (const bf16*)(gp(p.ws) + OFF_H3), (const bf16*)(gp(p.ws) + OFF_PG_T), T_TOK, DM, DM, e); }
}

DEVI void phase11(const ParamsG& p) {
  int tid_ = threadIdx.x; asm volatile("" : "+v"(tid_));
  const int lane = tid_ & 63;
  const int gw = blockIdx.x * NWAVES + (tid_ >> 6), nw = gridDim.x * NWAVES;
  f32x4 gn[4];
#pragma unroll
  for (int i = 0; i < 4; ++i) gn[i] = *(const f32x4*)(gp(p.norm_final) + i * 256 + lane * 4);
  for (int t = gw; t < T_TOK; t += nw) {
    float* xr = gp(p.out) + (size_t)t * DM;
    const bf16* xs = (const bf16*)(gp(p.ws) + OFF_XB) + (size_t)t * DM;
    f32x4 v[4];
    float ss = 0.f;
#pragma unroll
    for (int i = 0; i < 4; ++i) {
      const bf16x4 b4 = *(const bf16x4*)(xs + i * 256 + lane * 4);
      v[i].x = (float)b4[0]; v[i].y = (float)b4[1]; v[i].z = (float)b4[2]; v[i].w = (float)b4[3];
      ss += v[i].x * v[i].x + v[i].y * v[i].y + v[i].z * v[i].z + v[i].w * v[i].w;
    }
    ss = wave_sum(ss);
    const float rs = rsqrtf(ss * (1.f / DM) + 1e-6f);
#pragma unroll
    for (int i = 0; i < 4; ++i) {
      f32x4 o;
      o.x = v[i].x * rs * gn[i].x; o.y = v[i].y * rs * gn[i].y; o.z = v[i].z * rs * gn[i].z; o.w = v[i].w * rs * gn[i].w;
      *(f32x4*)(xr + i * 256 + lane * 4) = o;
    }
  }
}

constexpr int N_PHASES = 16;
__global__ void __launch_bounds__(NTHREADS, 2) hybrid_block_kernel(Params p_arg, int ph0, int ph1) {
  extern __shared__ __attribute__((aligned(1024))) unsigned char smem[];
  cg::grid_group grid = cg::this_grid();
  Params* ptab = (Params*)(p_arg.ws + OFF_PTAB) + blockIdx.x;
  if (threadIdx.x == 0) *ptab = p_arg;
  __syncthreads();
  const ParamsG& p = *(const ParamsG*)ptab;
#ifndef DUP_PHASE
#define DUP_PHASE -1
#endif
  volatile LAS unsigned* xst = (volatile LAS unsigned*)(smem + LDS_BYTES - 256);
  if (threadIdx.x == 0) { xst[0] = 0u; xst[1] = 0u; }
  __syncthreads();
#define GSYNC(K) { if ((K) == 0) { grid.sync(); (void)xcd_barrier_post((unsigned*)(gp(p.ws) + OFF_BAR), xst); } else { XcdBarrier xb_; xb_.bar = (unsigned*)(gp(p.ws) + OFF_BAR); xb_.x = xb_xcc_id(); xb_.st = xst; xcd_barrier(xb_); } }
#define RUN_PHASE(K, CALL) if (ph0 <= (K) && (K) < ph1) { \
    if (DUP_PHASE == (K)) { CALL; GSYNC(1) } \
    CALL; if ((K) + 1 < ph1) GSYNC(K) }
  RUN_PHASE(0, phase0(p, smem))
  RUN_PHASE(1, phase1(p, smem))
  RUN_PHASE(2, phase2a(p))
  RUN_PHASE(3, phase2b(p, smem))
#ifdef SEQ_SCAN
  RUN_PHASE(4, { phase3a(p, smem); __syncthreads(); phase3b(p, smem); })
  RUN_PHASE(5, { })
  RUN_PHASE(6, { })
#else
  RUN_PHASE(4, phase3b(p, smem))
  RUN_PHASE(5, phase3A(p, smem))
  RUN_PHASE(6, phase3B(p, smem))
#endif
  RUN_PHASE(7, phase3c(p))
  RUN_PHASE(8, phase4(p, smem))
  RUN_PHASE(9, phase5(p, smem))
  RUN_PHASE(10, phase7(p, smem))
  RUN_PHASE(11, phase7b(p, smem))
  RUN_PHASE(12, phase8a(p))
  RUN_PHASE(13, phase8<false>(p))
  RUN_PHASE(14, phase10(p, smem))
  RUN_PHASE(15, phase11(p))
#undef RUN_PHASE
}

extern "C" void kernel_launch(void* const* d_in, const int* in_sizes, int n_in, void* d_out, int out_size, void* d_ws,
                              size_t ws_size, hipStream_t stream) {
  static int grid_blocks = 0;
  if (!grid_blocks) {
    int dev = 0, cus = 0, per_cu = 0;
    hipGetDevice(&dev);
    hipDeviceGetAttribute(&cus, hipDeviceAttributeMultiprocessorCount, dev);
    hipFuncSetAttribute((const void*)hybrid_block_kernel, hipFuncAttributeMaxDynamicSharedMemorySize, LDS_BYTES);
    hipOccupancyMaxActiveBlocksPerMultiprocessor(&per_cu, hybrid_block_kernel, NTHREADS, LDS_BYTES);
    if (per_cu > 1) per_cu = 1;
    if (per_cu < 1) per_cu = 1;
    grid_blocks = cus * per_cu;
  }
  Params p{};
  const float** fp = (const float**)&p;
  for (int i = 0; i < 32; ++i) fp[i] = (const float*)d_in[i];
  p.pos = (const int*)d_in[2];
  p.out = (float*)d_out;
  p.ws = (unsigned char*)d_ws;
#ifndef MULTI_LAUNCH
  int ph0 = 0, ph1 = N_PHASES;
  void* args[] = {&p, &ph0, &ph1};
  hipError_t e = hipLaunchCooperativeKernel((void*)hybrid_block_kernel, dim3(grid_blocks), dim3(NTHREADS), args, LDS_BYTES, stream);
  if (e != hipSuccess) fprintf(stderr, "cooperative launch failed: %s (grid %d)\n", hipGetErrorString(e), grid_blocks);
#else
  for (int ph = 0; ph < N_PHASES; ++ph)
    hipLaunchKernelGGL(hybrid_block_kernel, dim3(grid_blocks), dim3(NTHREADS), LDS_BYTES, stream, p, ph, ph + 1);
#endif
}
```
